# Optimizing an MI355X kernel written in HIP

```python
import math
import jax, jax.numpy as jnp
from jax import lax
import numpy as np

D_MODEL = 1024
BATCH = 16
SEQ = 2048
DEPTH = 1

HEAD_DIM = 64
ROPE_THETA = 500000.0
ROPE_FRACTION = 4
A_HEADS = 8
A_KV_HEADS = 2
A_REP = A_HEADS // A_KV_HEADS
A_WIDTH = A_HEADS * HEAD_DIM
A_KV_WIDTH = A_KV_HEADS * HEAD_DIM
IDX_HEADS = 8
IDX_DIM = 32
DSA_TOPK_MAX = 256
A_QBLOCK = 64
B_HEADS = 8
B_KV_HEADS = 2
B_REP = B_HEADS // B_KV_HEADS
B_WIDTH = B_HEADS * HEAD_DIM
B_KV_WIDTH = B_KV_HEADS * HEAD_DIM
CMP_BLOCK = 32
CMP_STRIDE = 16
CMP_HIDDEN = 256
SEL_BLOCK = 64
SEL_COUNT = 16
SEL_LOCAL = 2
WINDOW = 512
SEL_QBLOCK = 16
WIN_QBLOCK = 128
N_EXPERTS = 256
TOP_K = 8
N_GROUPS = 8
TOPK_GROUPS = 4
EXPERT_DIM = 256
SHARED_DIM = 256
ROUTED_SCALE = 2.5
MOE_BLOCK = 128
DN_ALPHA = (2 * DEPTH) ** 0.25
DN_BETA = (8 * DEPTH) ** -0.25
LN_EPS = 1e-5
NEG = -1e30
FORCE = 1e9

IN_WIDTHS = (A_WIDTH, A_KV_WIDTH, A_KV_WIDTH, IDX_HEADS * IDX_DIM, IDX_DIM, IDX_HEADS,
             B_WIDTH, B_KV_WIDTH, B_KV_WIDTH, B_KV_WIDTH, B_KV_WIDTH, B_KV_WIDTH, B_KV_WIDTH, 3 * B_HEADS,
             D_MODEL, D_MODEL)
VALUE_SLOTS = (2, 8, 10, 12)
N_IN = sum(IN_WIDTHS)

kernel_name = 'hybrid_dsa_nsa_moe_block'


def _layer_norm(x, g, b):
    xf = x.astype(jnp.float32)
    mu = xf.mean(-1, keepdims=True)
    var = jnp.square(xf - mu).mean(-1, keepdims=True)
    return ((xf - mu) * lax.rsqrt(var + LN_EPS) * g.astype(jnp.float32) + b.astype(jnp.float32)).astype(x.dtype)


def _masked_softmax(s, mask):
    s = jnp.where(mask, s.astype(jnp.float32), NEG)
    e = jnp.exp(s - s.max(-1, keepdims=True)) * mask
    return e / jnp.maximum(e.sum(-1, keepdims=True), 1e-30)


def _rope_partial(x, positions):
    d = x.shape[-1]
    rot = d // ROPE_FRACTION
    half = rot // 2
    inv = ROPE_THETA ** (-(jnp.arange(half, dtype=jnp.float32) * 2.0) / rot)
    ang = positions.astype(jnp.float32)[..., None] * inv
    ang = ang.reshape(ang.shape[:2] + (1,) * (x.ndim - 3) + (half,))
    cos, sin = jnp.cos(ang), jnp.sin(ang)
    x1 = x[..., :half].astype(jnp.float32)
    x2 = x[..., half:rot].astype(jnp.float32)
    return jnp.concatenate([(x1 * cos - x2 * sin).astype(x.dtype), (x2 * cos + x1 * sin).astype(x.dtype), x[..., rot:]], axis=-1)


def _blocks_to_seq(out):
    out = jnp.swapaxes(out, 0, 1)
    return out.reshape((out.shape[0], out.shape[1] * out.shape[2]) + out.shape[3:])


def _dsa_attention(q, k, v, q_idx, k_idx, w_idx, positions):
    bsz, seq, _ = q.shape
    q = _rope_partial(q.reshape(bsz, seq, A_HEADS, HEAD_DIM), positions).reshape(bsz, seq, A_KV_HEADS, A_REP, HEAD_DIM)
    k = _rope_partial(k.reshape(bsz, seq, A_KV_HEADS, HEAD_DIM), positions)
    v = v.reshape(bsz, seq, A_KV_HEADS, HEAD_DIM)
    qi = _rope_partial(q_idx.reshape(bsz, seq, IDX_HEADS, IDX_DIM), positions)
    ki = _rope_partial(k_idx, positions)
    wi = w_idx * IDX_HEADS ** -0.5
    n_keep = min(DSA_TOPK_MAX, seq // 4)
    key_pos = jnp.arange(seq)
    take = jax.vmap(lambda arr, idx: arr[idx])

    def block(i):
        start = i * A_QBLOCK
        qb = lax.dynamic_slice_in_dim(q, start, A_QBLOCK, axis=1)
        qib = lax.dynamic_slice_in_dim(qi, start, A_QBLOCK, axis=1)
        wib = lax.dynamic_slice_in_dim(wi, start, A_QBLOCK, axis=1)
        t_q = start + jnp.arange(A_QBLOCK)
        rel = jax.nn.relu(jnp.einsum('bqhd,bsd->bqhs', qib, ki) * IDX_DIM ** -0.5)
        score = jnp.einsum('bqhs,bqh->bqs', rel, wib).astype(jnp.float32)
        score = jnp.where(key_pos[None, None, :] <= t_q[None, :, None], score, -jnp.inf)
        _, idx = lax.top_k(score, n_keep)
        ks = take(k, idx)
        vs = take(v, idx)
        s = jnp.einsum('bqgrd,bqkgd->bqgrk', qb, ks) * HEAD_DIM ** -0.5
        valid = (idx <= t_q[None, :, None])[:, :, None, None, :]
        p = _masked_softmax(s, valid).astype(v.dtype)
        o = jnp.einsum('bqgrk,bqkgd->bqgrd', p, vs)
        return o.reshape(bsz, A_QBLOCK, A_WIDTH)

    return _blocks_to_seq(lax.map(block, jnp.arange(seq // A_QBLOCK)))


def _nsa_compress(a, pos_emb, w1, w2, tok):
    bsz = a.shape[0]
    blocks = a[:, tok] + pos_emb[None, None, :, None, :]
    flat = jnp.swapaxes(blocks, 2, 3).reshape(bsz, tok.shape[0], B_KV_HEADS, CMP_BLOCK * HEAD_DIM)
    return jax.nn.gelu(flat @ w1) @ w2


def _nsa_attention(q, k_cmp, v_cmp, k_sel, v_sel, k_win, v_win, g, positions,
                   cmp_pos_k, cmp_pos_v, cmp_k_w1, cmp_k_w2, cmp_v_w1, cmp_v_w2):
    bsz, seq, _ = q.shape
    dt = q.dtype
    scale = HEAD_DIM ** -0.5
    kv = lambda a: a.reshape(bsz, seq, B_KV_HEADS, HEAD_DIM)
    q = q.reshape(bsz, seq, B_HEADS, HEAD_DIM)
    q_raw = q.reshape(bsz, seq, B_KV_HEADS, B_REP, HEAD_DIM)
    q_rot = _rope_partial(q, positions).reshape(bsz, seq, B_KV_HEADS, B_REP, HEAD_DIM)
    t = np.arange(seq)

    n_c = (seq - CMP_BLOCK) // CMP_STRIDE + 1
    c_start = np.arange(n_c) * CMP_STRIDE
    tok = c_start[:, None] + np.arange(CMP_BLOCK)
    kc = _nsa_compress(kv(k_cmp), cmp_pos_k, cmp_k_w1, cmp_k_w2, tok)
    vc = _nsa_compress(kv(v_cmp), cmp_pos_v, cmp_v_w1, cmp_v_w2, tok)
    valid_c = (c_start[None, :] + CMP_BLOCK - 1) <= t[:, None]
    p_c = _masked_softmax(jnp.einsum('bsgrd,bcgd->bsgrc', q_raw, kc) * scale, valid_c[None, :, None, None, :])
    o_cmp = jnp.einsum('bsgrc,bcgd->bsgrd', p_c.astype(dt), vc)

    n_s = seq // SEL_BLOCK
    s_start = np.arange(n_s) * SEL_BLOCK
    overlap = ((c_start[:, None] <= s_start[None, :] + SEL_BLOCK - 1)
               & (c_start[:, None] + CMP_BLOCK - 1 >= s_start[None, :])).astype(np.float32)
    imp = jnp.einsum('bsgrc,cj->bsgj', p_c, overlap)
    blk = np.arange(n_s)
    cur = t // SEL_BLOCK
    forced = (blk[None, :] == 0) | ((cur[:, None] - blk[None, :] >= 0) & (cur[:, None] - blk[None, :] < SEL_LOCAL))
    causal = blk[None, :] * SEL_BLOCK <= t[:, None]
    imp = jnp.where(forced[None, :, None, :], FORCE, jnp.where(causal[None, :, None, :], imp, NEG))
    n_pick = min(SEL_COUNT, n_s)
    _, sel = lax.top_k(imp, n_pick)

    to_blocks = lambda a: a.reshape(bsz, n_s, SEL_BLOCK, B_KV_HEADS, HEAD_DIM).transpose(0, 3, 1, 2, 4)
    ksb = to_blocks(_rope_partial(kv(k_sel), positions))
    vsb = to_blocks(kv(v_sel))
    take2 = jax.vmap(jax.vmap(lambda arr, idx: arr[idx]))

    def sel_block(i):
        start = i * SEL_QBLOCK
        qb = lax.dynamic_slice_in_dim(q_rot, start, SEL_QBLOCK, axis=1)
        sb = lax.dynamic_slice_in_dim(sel, start, SEL_QBLOCK, axis=1)
        t_q = start + jnp.arange(SEL_QBLOCK)
        idx = sb.transpose(0, 2, 1, 3)
        kg = take2(ksb, idx)
        vg = take2(vsb, idx)
        s = jnp.einsum('bqgrd,bgqnld->bqgrnl', qb, kg) * scale
        tok_pos = sb[..., None] * SEL_BLOCK + jnp.arange(SEL_BLOCK)
        valid = (tok_pos <= t_q[None, :, None, None, None])[:, :, :, None]
        sh = s.shape
        p = _masked_softmax(s.reshape(sh[:4] + (-1,)), valid.reshape(valid.shape[:4] + (-1,))).reshape(sh)
        return jnp.einsum('bqgrnl,bgqnld->bqgrd', p.astype(dt), vg)

    o_sel = _blocks_to_seq(lax.map(sel_block, jnp.arange(seq // SEL_QBLOCK)))

    span = WINDOW + WIN_QBLOCK
    pad = ((0, 0), (WINDOW, 0), (0, 0), (0, 0))
    kwp = jnp.pad(_rope_partial(kv(k_win), positions), pad)
    vwp = jnp.pad(kv(v_win), pad)

    def win_block(i):
        start = i * WIN_QBLOCK
        qb = lax.dynamic_slice_in_dim(q_rot, start, WIN_QBLOCK, axis=1)
        kb = lax.dynamic_slice_in_dim(kwp, start, span, axis=1)
        vb = lax.dynamic_slice_in_dim(vwp, start, span, axis=1)
        t_q = start + jnp.arange(WIN_QBLOCK)
        s_pos = start - WINDOW + jnp.arange(span)
        diff = t_q[:, None] - s_pos[None, :]
        valid = (s_pos[None, :] >= 0) & (diff >= 0) & (diff < WINDOW)
        s = jnp.einsum('bqgrd,bkgd->bqgrk', qb, kb) * scale
        p = _masked_softmax(s, valid[None, :, None, None, :])
        return jnp.einsum('bqgrk,bkgd->bqgrd', p.astype(dt), vb)

    o_win = _blocks_to_seq(lax.map(win_block, jnp.arange(seq // WIN_QBLOCK)))

    gates = jax.nn.sigmoid(g.reshape(bsz, seq, B_KV_HEADS, B_REP, 3))
    o = gates[..., 0:1] * o_cmp + gates[..., 1:2] * o_sel + gates[..., 2:3] * o_win
    return o.reshape(bsz, seq, B_WIDTH)


def _token_mixer(u, positions, w_in, w_br_a, w_br_b, w_out,
                 cmp_pos_k, cmp_pos_v, cmp_k_w1, cmp_k_w2, cmp_v_w1, cmp_v_w2):
    z = u @ w_in
    offsets = np.cumsum(IN_WIDTHS)[:-1].tolist()
    (q_a, k_a, v_a, q_idx, k_idx, w_idx, q_b, k_cmp, v_cmp, k_sel, v_sel, k_win, v_win,
     g_nsa, gate_a, gate_b) = jnp.split(z, offsets, axis=-1)
    o_a = _dsa_attention(q_a, k_a, v_a, q_idx, k_idx, w_idx, positions)
    o_b = _nsa_attention(q_b, k_cmp, v_cmp, k_sel, v_sel, k_win, v_win, g_nsa, positions,
                         cmp_pos_k, cmp_pos_v, cmp_k_w1, cmp_k_w2, cmp_v_w1, cmp_v_w2)
    merged = jax.nn.sigmoid(gate_a) * (o_a @ w_br_a) + jax.nn.sigmoid(gate_b) * (o_b @ w_br_b)
    return merged @ w_out


def _routed_experts(h, idx, wts, w_gate, w_up, w_down):
    n_tok, _ = h.shape
    n_asg = n_tok * TOP_K
    e_flat = idx.reshape(-1)
    order = jnp.argsort(e_flat)
    e_sorted = e_flat[order]
    t_sorted = (order // TOP_K).astype(jnp.int32)
    w_sorted = wts.reshape(-1)[order].astype(h.dtype)
    counts = jnp.bincount(e_flat, length=N_EXPERTS)
    starts = jnp.cumsum(counts) - counts
    padded = (counts + MOE_BLOCK - 1) // MOE_BLOCK * MOE_BLOCK
    p_ends = jnp.cumsum(padded)
    dest = (p_ends - padded)[e_sorted] + jnp.arange(n_asg) - starts[e_sorted]
    n_blocks = -(-n_asg // MOE_BLOCK) + N_EXPERTS
    cap = n_blocks * MOE_BLOCK
    tok_buf = jnp.zeros((cap,), jnp.int32).at[dest].set(t_sorted)
    w_buf = jnp.zeros((cap,), h.dtype).at[dest].set(w_sorted)
    blk_e = jnp.minimum(jnp.searchsorted(p_ends, jnp.arange(n_blocks) * MOE_BLOCK, side='right'), N_EXPERTS - 1)

    def step(acc, xs):
        tb, wb, e = xs
        hb = h[tb]
        y = (jax.nn.silu(hb @ w_gate[e]) * (hb @ w_up[e])) @ w_down[e]
        return acc.at[tb].add(y * wb[:, None]), None

    out, _ = lax.scan(step, jnp.zeros_like(h),
                      (tok_buf.reshape(n_blocks, MOE_BLOCK), w_buf.reshape(n_blocks, MOE_BLOCK), blk_e))
    return out


def _moe_ffn(u, w_router, router_bias, w_exp_gate, w_exp_up, w_exp_down, w_sh_gate, w_sh_up, w_sh_down):
    bsz, seq, d = u.shape
    h = u.reshape(bsz * seq, d)
    n_tok = h.shape[0]
    scores = jax.nn.sigmoid((h @ w_router).astype(jnp.float32))
    choice = scores + router_bias.astype(jnp.float32)
    grp = choice.reshape(n_tok, N_GROUPS, N_EXPERTS // N_GROUPS)
    grp_score = lax.top_k(grp, 2)[0].sum(-1)
    _, top_g = lax.top_k(grp_score, TOPK_GROUPS)
    keep = jax.nn.one_hot(top_g, N_GROUPS, dtype=jnp.float32).sum(1) > 0
    masked = jnp.where(keep[:, :, None], grp, NEG).reshape(n_tok, N_EXPERTS)
    _, idx = lax.top_k(masked, TOP_K)
    w = jnp.take_along_axis(scores, idx, axis=-1)
    w = w / w.sum(-1, keepdims=True) * ROUTED_SCALE
    routed = _routed_experts(h, idx, w, w_exp_gate, w_exp_up, w_exp_down)
    shared = (jax.nn.silu(h @ w_sh_gate) * (h @ w_sh_up)) @ w_sh_down
    return (routed + shared).reshape(bsz, seq, d)


def setup_inputs(seed: int = 0) -> dict:
    key = jax.random.key(seed)
    ks = jax.random.split(key, 27)
    nrm = lambda k, shape, s: jax.random.normal(k, shape, jnp.float32) * s
    D = D_MODEL
    col_scale = np.concatenate([np.full((w,), DN_BETA if i in VALUE_SLOTS else 1.0, np.float32)
                                for i, w in enumerate(IN_WIDTHS)])
    offset = jax.random.randint(ks[2], (BATCH, 1), 0, 4096, dtype=jnp.int32)
    positions = offset + jnp.arange(SEQ, dtype=jnp.int32)[None, :]
    return {
        'x': nrm(ks[0], (BATCH, SEQ, D), 1.0),
        'c': nrm(ks[1], (BATCH, D), 1.0),
        'positions': positions,
        'w_ada': nrm(ks[3], (DEPTH, D, 6 * D), 0.5 * D ** -0.5),
        'b_ada': nrm(ks[4], (DEPTH, 6 * D), 0.02),
        'w_in': nrm(ks[5], (DEPTH, D, N_IN), D ** -0.5) * jnp.asarray(col_scale),
        'w_br_a': nrm(ks[6], (DEPTH, A_WIDTH, D), A_WIDTH ** -0.5),
        'w_br_b': nrm(ks[7], (DEPTH, B_WIDTH, D), B_WIDTH ** -0.5),
        'w_out': nrm(ks[8], (DEPTH, D, D), DN_BETA * D ** -0.5),
        'cmp_pos_k': nrm(ks[9], (DEPTH, CMP_BLOCK, HEAD_DIM), 0.1),
        'cmp_pos_v': nrm(ks[10], (DEPTH, CMP_BLOCK, HEAD_DIM), 0.1),
        'cmp_k_w1': nrm(ks[11], (DEPTH, CMP_BLOCK * HEAD_DIM, CMP_HIDDEN), (CMP_BLOCK * HEAD_DIM) ** -0.5),
        'cmp_k_w2': nrm(ks[12], (DEPTH, CMP_HIDDEN, HEAD_DIM), CMP_HIDDEN ** -0.5),
        'cmp_v_w1': nrm(ks[13], (DEPTH, CMP_BLOCK * HEAD_DIM, CMP_HIDDEN), (CMP_BLOCK * HEAD_DIM) ** -0.5),
        'cmp_v_w2': nrm(ks[14], (DEPTH, CMP_HIDDEN, HEAD_DIM), CMP_HIDDEN ** -0.5),
        'ln1_g': 1.0 + nrm(ks[15], (DEPTH, D), 0.02),
        'ln1_b': nrm(ks[16], (DEPTH, D), 0.02),
        'w_router': nrm(ks[17], (DEPTH, D, N_EXPERTS), D ** -0.5),
        'router_bias': nrm(ks[18], (DEPTH, N_EXPERTS), 0.01),
        'w_exp_gate': nrm(ks[19], (DEPTH, N_EXPERTS, D, EXPERT_DIM), D ** -0.5),
        'w_exp_up': nrm(ks[20], (DEPTH, N_EXPERTS, D, EXPERT_DIM), D ** -0.5),
        'w_exp_down': nrm(ks[21], (DEPTH, N_EXPERTS, EXPERT_DIM, D), DN_BETA * EXPERT_DIM ** -0.5),
        'w_sh_gate': nrm(ks[22], (DEPTH, D, SHARED_DIM), D ** -0.5),
        'w_sh_up': nrm(ks[23], (DEPTH, D, SHARED_DIM), D ** -0.5),
        'w_sh_down': nrm(ks[24], (DEPTH, SHARED_DIM, D), DN_BETA * SHARED_DIM ** -0.5),
        'ln2_g': 1.0 + nrm(ks[25], (DEPTH, D), 0.02),
        'ln2_b': nrm(ks[26], (DEPTH, D), 0.02),
    }


def reference(x, c, positions, w_ada, b_ada, w_in, w_br_a, w_br_b, w_out,
              cmp_pos_k, cmp_pos_v, cmp_k_w1, cmp_k_w2, cmp_v_w1, cmp_v_w2, ln1_g, ln1_b,
              w_router, router_bias, w_exp_gate, w_exp_up, w_exp_down,
              w_sh_gate, w_sh_up, w_sh_down, ln2_g, ln2_b):
    cond = jax.nn.silu(c)
    for l in range(DEPTH):
        mod = cond @ w_ada[l] + b_ada[l]
        shift1, scale1, gate1, shift2, scale2, gate2 = jnp.split(mod[:, None, :], 6, axis=-1)
        u = x * (1.0 + scale1) + shift1
        mix = _token_mixer(u, positions, w_in[l], w_br_a[l], w_br_b[l], w_out[l],
                           cmp_pos_k[l], cmp_pos_v[l], cmp_k_w1[l], cmp_k_w2[l], cmp_v_w1[l], cmp_v_w2[l])
        x = _layer_norm(DN_ALPHA * x + gate1 * mix, ln1_g[l], ln1_b[l])
        u = x * (1.0 + scale2) + shift2
        ffn = _moe_ffn(u, w_router[l], router_bias[l], w_exp_gate[l], w_exp_up[l], w_exp_down[l],
                       w_sh_gate[l], w_sh_up[l], w_sh_down[l])
        x = _layer_norm(DN_ALPHA * x + gate2 * ffn, ln2_g[l], ln2_b[l])
    return x
```

```cpp
#include <hip/hip_runtime.h>
#include <hip/hip_cooperative_groups.h>
#include <stdint.h>
#include <stdio.h>
namespace cg = cooperative_groups;

typedef unsigned short bf16;
typedef float f32x16 __attribute__((ext_vector_type(16)));
typedef float f32x4 __attribute__((ext_vector_type(4)));
typedef float f32x2 __attribute__((ext_vector_type(2)));
typedef short bf16x8 __attribute__((ext_vector_type(8)));
typedef __bf16 bf16x2_t __attribute__((ext_vector_type(2)));
typedef unsigned u32x4 __attribute__((ext_vector_type(4)));
#define NT_LD16(p_) __builtin_nontemporal_load((const u32x4*)(p_))
#define NT_ST16(v_, p_) { const uint4 t__ = (v_); u32x4 q__ = {t__.x, t__.y, t__.z, t__.w}; __builtin_nontemporal_store(q__, (u32x4*)(p_)); }
#define DI __device__ __forceinline__

constexpr int D = 1024, NB = 16, S = 2048, T = NB * S, NIN = 4416;
constexpr float DN_ALPHA = 1.189207115002721f;
constexpr float LN_EPS = 1e-5f;
constexpr float NEGF = -1e30f;

constexpr size_t MiB = 1ull << 20;
constexpr size_t O_CTL = 0;
constexpr size_t O_MOD = 1 * MiB;
constexpr size_t O_ROPEH = 2 * MiB;
constexpr size_t O_ROPEI = 4 * MiB;
constexpr size_t O_CMPB = 5 * MiB;
constexpr size_t O_SELM = 6 * MiB;
constexpr size_t O_DSAM = 8 * MiB;
constexpr size_t O_RIDX = 16 * MiB;
constexpr size_t O_RW = 17 * MiB;
constexpr size_t O_LIST = 18 * MiB;
constexpr size_t O_H1 = 50 * MiB;
constexpr size_t BASE = 64 * MiB;
constexpr size_t O_U = BASE + 0 * MiB;
constexpr size_t O_SGA = BASE + 64 * MiB;
constexpr size_t O_SGB = BASE + 128 * MiB;
constexpr size_t O_QA = BASE + 192 * MiB;
constexpr size_t O_QBR = BASE + 224 * MiB;
constexpr size_t O_QBT = BASE + 256 * MiB;
constexpr size_t O_QI = BASE + 288 * MiB;
constexpr size_t O_KA = BASE + 304 * MiB;
constexpr size_t O_VAT = BASE + 312 * MiB;
constexpr size_t O_KS = BASE + 320 * MiB;
constexpr size_t O_VST = BASE + 328 * MiB;
constexpr size_t O_KW = BASE + 336 * MiB;
constexpr size_t O_VWT = BASE + 344 * MiB;
constexpr size_t O_KC = BASE + 352 * MiB;
constexpr size_t O_VC = BASE + 361 * MiB;
constexpr size_t O_KI = BASE + 370 * MiB;
constexpr size_t O_WI = BASE + 372 * MiB;
constexpr size_t O_GN = BASE + 373 * MiB;
constexpr size_t O_KCC = BASE + 376 * MiB;
constexpr size_t O_VCCT = BASE + 377 * MiB;
constexpr size_t O_OA = BASE + 378 * MiB;
constexpr size_t O_OCMP = BASE + 410 * MiB;
constexpr size_t O_OB = BASE + 442 * MiB;
constexpr size_t O_OWIN = BASE + 826 * MiB;
constexpr size_t O_MERGED = BASE + 474 * MiB;
constexpr size_t O_SC = BASE + 538 * MiB;
constexpr size_t O_Y = O_SC;
constexpr size_t O_X1 = BASE + 0 * MiB;
constexpr size_t O_HHI = BASE + 128 * MiB;
constexpr size_t O_HLO = BASE + 192 * MiB;
constexpr size_t O_YSH = O_HLO;
constexpr size_t O_ACTSH = BASE + 256 * MiB;
constexpr size_t O_ACT = BASE + 272 * MiB;
constexpr size_t O_YK = BASE + 400 * MiB;
constexpr size_t O_LOGITS = O_YK;
constexpr size_t WS_NEED = BASE + 912 * MiB;
constexpr size_t O_WT = 976 * MiB;
constexpr size_t O_WT_IN = O_WT;
constexpr size_t O_WT_BRA = O_WT + 10 * MiB;
constexpr size_t O_WT_BRB = O_WT + 11 * MiB;
constexpr size_t O_WT_OUT = O_WT + 12 * MiB;
constexpr size_t O_WT_RT = O_WT + 14 * MiB;
constexpr size_t O_WT_SGU = O_WT + 15 * MiB;
constexpr size_t O_WT_SD = O_WT + 16 * MiB;
constexpr size_t O_WT_C1K = O_WT + 17 * MiB;
constexpr size_t O_WT_C1V = O_WT + 18 * MiB;
constexpr size_t O_WT_C2K = O_WT + 19 * MiB;
constexpr size_t O_WT_C2V = O_WT + 19 * MiB + 65536;
constexpr size_t WS_NEED2 = O_WT + 20 * MiB;

constexpr int CW_CNT = 16384, CNT_STRIDE = 32;
constexpr int CW_Q = 64;

constexpr int NPHASE = 15;
constexpr int LDS_ROW = 72;
constexpr int TILE_ELEMS = 128 * LDS_ROW;
constexpr int GEMM_LDS_BYTES = 4 * TILE_ELEMS * 2;
constexpr int MISC_OFF = GEMM_LDS_BYTES;
constexpr int LDS_BYTES = GEMM_LDS_BYTES + 4096;

struct P {
  const float *x, *c; const int* pos;
  const float *w_ada, *b_ada, *w_in, *w_br_a, *w_br_b, *w_out, *cmp_pos_k, *cmp_pos_v, *cmp_k_w1, *cmp_k_w2, *cmp_v_w1, *cmp_v_w2,
      *ln1_g, *ln1_b, *w_router, *router_bias, *w_exp_gate, *w_exp_up, *w_exp_down, *w_sh_gate, *w_sh_up, *w_sh_down, *ln2_g, *ln2_b;
  float* out; unsigned char* ws;
  int ph_lo, ph_hi;
};

typedef const __attribute__((address_space(4))) P& PR;

DI bf16 f2bf(float f) { unsigned u = __float_as_uint(f); u += 0x7fffu + ((u >> 16) & 1u); return (bf16)(u >> 16); }
DI float bf2f(bf16 h) { return __uint_as_float(((unsigned)h) << 16); }
DI unsigned pk2(float a, float b) { f32x2 v = {a, b}; bf16x2_t r = __builtin_convertvector(v, bf16x2_t); return __builtin_bit_cast(unsigned, r); }
DI size_t blk_off(int row, int k, int K) { return ((size_t)(row >> 7) * (K >> 5) + (k >> 5)) * 4096 + (row & 127) * 32 + (k & 31); }
DI float sigmoidf_(float v) { return 1.f / (1.f + __expf(-v)); }
DI float siluf_(float v) { return v / (1.f + __expf(-v)); }
DI float wave_sum(float v) {
#pragma unroll
  for (int o = 1; o < 64; o <<= 1) v += __shfl_xor(v, o);
  return v;
}
DI float wave_max(float v) {
#pragma unroll
  for (int o = 1; o < 64; o <<= 1) v = fmaxf(v, __shfl_xor(v, o));
  return v;
}
DI void grid_barrier(unsigned* bar, unsigned target) {
  asm volatile("s_waitcnt vmcnt(0)" ::: "memory");
  __syncthreads();
  if (threadIdx.x == 0) {
    __builtin_amdgcn_fence(__ATOMIC_RELEASE, "agent");
    asm volatile("s_waitcnt vmcnt(0)" ::: "memory");
    __hip_atomic_fetch_add(bar, 1u, __ATOMIC_RELAXED, __HIP_MEMORY_SCOPE_AGENT);
    while (__hip_atomic_load(bar, __ATOMIC_RELAXED, __HIP_MEMORY_SCOPE_AGENT) < target) __builtin_amdgcn_s_sleep(2);
    __builtin_amdgcn_fence(__ATOMIC_ACQUIRE, "agent");
    asm volatile("s_waitcnt vmcnt(0)" ::: "memory");
  }
  __syncthreads();
}
DI int xcc_id() { return (int)(__builtin_amdgcn_s_getreg((3 << 11) | 20) & 7u); }
template <class NSub>
DI bool shard_next(int* ctrs, int myx, int& off, NSub nsub, int* shv, int& x, int& idx) {
  __syncthreads();
  if (threadIdx.x == 0) {
    int o = off, rx = -1, ri = 0;
    while (o < 8) { const int xx = (myx + o) & 7; const int i = atomicAdd(&ctrs[xx * 32], 1); if (i < nsub(xx)) { rx = xx; ri = i; break; } ++o; }
    shv[0] = rx; shv[1] = ri; shv[2] = o;
  }
  __syncthreads();
  x = shv[0]; idx = shv[1]; off = shv[2];
  return x >= 0;
}

#define XB_TMO      128
#define XB_XCNT(j)  (256  + 64 * (j))
#define XB_XSUB(j)  (1280 + 64 * (j))
#define XB_XGEN(j)  (2304 + 64 * (j))
#define XB_TOP      3328
#define XB_TOPGEN   3392
#define XB_SPIN_CAP (1u << 22)
DI unsigned xb_ld(unsigned* p) { return __hip_atomic_load(p, __ATOMIC_RELAXED, __HIP_MEMORY_SCOPE_AGENT); }
DI unsigned xb_add(unsigned* p, unsigned v) { return __hip_atomic_fetch_add(p, v, __ATOMIC_RELAXED, __HIP_MEMORY_SCOPE_AGENT); }
#define XB_SPIN(cond, bar) do { unsigned _sp = 0; while (cond) { __builtin_amdgcn_s_sleep(1); \
    if ((++_sp & 255u) == 0u) { if (xb_ld(&(bar)[XB_TMO])) break; if (_sp > XB_SPIN_CAP) { atomicAdd(&(bar)[XB_TMO], 1u); break; } } } } while (0)
DI void xcd_barrier_complete(unsigned* bar, unsigned x, unsigned& nloc, unsigned& nx) {
  const unsigned G = gridDim.x;
  unsigned sum, cnt, mine, sp = 0u;
  for (;;) {
    sum = 0u; cnt = 0u; mine = 0u;
#pragma unroll
    for (unsigned j = 0; j < 16; ++j) { const unsigned c = xb_ld(&bar[XB_XCNT(j)]); sum += c; cnt += (c > 0u) ? 1u : 0u; mine = (j == x) ? c : mine; }
    if (sum == G) break;
    __builtin_amdgcn_s_sleep(1);
    if ((++sp & 255u) == 0u) { if (xb_ld(&bar[XB_TMO])) break; if (sp > XB_SPIN_CAP) { atomicAdd(&bar[XB_TMO], 1u); break; } }
  }
  nloc = mine > 0u ? mine : 1u; nx = cnt > 0u ? cnt : 1u;
}
DI void xcd_barrier(unsigned* bar, unsigned x, volatile unsigned* st) {
  asm volatile("s_waitcnt vmcnt(0)" ::: "memory");
  __syncthreads();
  if (threadIdx.x == 0) {
    __builtin_amdgcn_s_waitcnt(0);
    unsigned nloc = st[0], nx = st[1];
    if (nloc == 0u) { xcd_barrier_complete(bar, x, nloc, nx); st[0] = nloc; st[1] = nx; }
    const unsigned old = xb_add(&bar[XB_XSUB(x)], 1u);
    const unsigned gen = old / nloc;
    if (old + 1u == (gen + 1u) * nloc) {
      __builtin_amdgcn_fence(__ATOMIC_RELEASE, "agent");
      asm volatile("s_waitcnt vmcnt(0)" ::: "memory");
      const unsigned og = xb_add(&bar[XB_TOP], 1u);
      const unsigned tg = og / nx;
      if (og + 1u == (tg + 1u) * nx) xb_add(&bar[XB_TOPGEN], 1u);
      else XB_SPIN(xb_ld(&bar[XB_TOPGEN]) == tg, bar);
      __builtin_amdgcn_fence(__ATOMIC_ACQUIRE, "agent");
      xb_add(&bar[XB_XGEN(x)], 1u);
      asm volatile("s_waitcnt vmcnt(0)" ::: "memory");
    } else {
      XB_SPIN(xb_ld(&bar[XB_XGEN(x)]) == gen, bar);
      __builtin_amdgcn_fence(__ATOMIC_ACQUIRE, "agent");
      asm volatile("s_waitcnt vmcnt(0)" ::: "memory");
    }
  }
  __syncthreads();
}
DI int sched_next(int* ctr, int* shv) {
  __syncthreads();
  if (threadIdx.x == 0) *shv = atomicAdd(ctr, 1);
  __syncthreads();
  return *shv;
}

template <class AL, class BL>
DI void gemm_mainloop(f32x16 (&acc)[2][2], const AL& al, BL& bl, int ktiles, bf16* smem) {
  const int tid = threadIdx.x, lane = tid & 63, wave = tid >> 6, wm = wave >> 1, wn = wave & 1;
  const int arow = tid >> 3, akc = tid & 7, kg = tid >> 5, n4 = tid & 31;
  const bf16* ap0 = al.rowptr(arow) + akc * 8;
  const bf16* ap1 = al.rowptr(arow + 32) + akc * 8;
  const bf16* ap2 = al.rowptr(arow + 64) + akc * 8;
  const bf16* ap3 = al.rowptr(arow + 96) + akc * 8;
  bl.init(n4 * 4);
  uint4 ra0, ra1, ra2, ra3; f32x4 rb[8];
#define GLOAD(kt) { const int ko_ = al.koff(kt); ra0 = *(const uint4*)(ap0 + ko_); ra1 = *(const uint4*)(ap1 + ko_); ra2 = *(const uint4*)(ap2 + ko_); ra3 = *(const uint4*)(ap3 + ko_); \
    _Pragma("unroll") for (int r_ = 0; r_ < 8; ++r_) rb[r_] = bl.ld(kt, kg * 8 + r_); }
#define LSTORE(buf) { bf16* A_ = smem + (buf) * 2 * TILE_ELEMS; bf16* B_ = A_ + TILE_ELEMS; \
    *(uint4*)(A_ + (arow) * LDS_ROW + akc * 8) = ra0; *(uint4*)(A_ + (arow + 32) * LDS_ROW + akc * 8) = ra1; \
    *(uint4*)(A_ + (arow + 64) * LDS_ROW + akc * 8) = ra2; *(uint4*)(A_ + (arow + 96) * LDS_ROW + akc * 8) = ra3; \
    _Pragma("unroll") for (int c_ = 0; c_ < 4; ++c_) { uint4 v_; v_.x = pk2(rb[0][c_], rb[1][c_]); v_.y = pk2(rb[2][c_], rb[3][c_]); v_.z = pk2(rb[4][c_], rb[5][c_]); v_.w = pk2(rb[6][c_], rb[7][c_]); \
      *(uint4*)(B_ + (n4 * 4 + c_) * LDS_ROW + kg * 8) = v_; } }
  GLOAD(0); LSTORE(0); __syncthreads();
  const int aoff = (wm * 64 + (lane & 31)) * LDS_ROW + (lane >> 5) * 8;
  const int boff = (wn * 64 + (lane & 31)) * LDS_ROW + (lane >> 5) * 8;
  for (int kt = 0; kt < ktiles; ++kt) {
    if (kt + 1 < ktiles) GLOAD(kt + 1);
    const bf16* A = smem + (kt & 1) * 2 * TILE_ELEMS; const bf16* B = A + TILE_ELEMS;
    bf16x8 a0 = *(const bf16x8*)(A + aoff), a1 = *(const bf16x8*)(A + aoff + 32 * LDS_ROW);
    bf16x8 b0 = *(const bf16x8*)(B + boff), b1 = *(const bf16x8*)(B + boff + 32 * LDS_ROW);
#pragma unroll
    for (int ks = 0; ks < 4; ++ks) {
      bf16x8 na0 = a0, na1 = a1, nb0 = b0, nb1 = b1;
      if (ks < 3) { na0 = *(const bf16x8*)(A + aoff + (ks + 1) * 16); na1 = *(const bf16x8*)(A + aoff + 32 * LDS_ROW + (ks + 1) * 16);
        nb0 = *(const bf16x8*)(B + boff + (ks + 1) * 16); nb1 = *(const bf16x8*)(B + boff + 32 * LDS_ROW + (ks + 1) * 16); }
      acc[0][0] = __builtin_amdgcn_mfma_f32_32x32x16_bf16(a0, b0, acc[0][0], 0, 0, 0);
      acc[0][1] = __builtin_amdgcn_mfma_f32_32x32x16_bf16(a0, b1, acc[0][1], 0, 0, 0);
      acc[1][0] = __builtin_amdgcn_mfma_f32_32x32x16_bf16(a1, b0, acc[1][0], 0, 0, 0);
      acc[1][1] = __builtin_amdgcn_mfma_f32_32x32x16_bf16(a1, b1, acc[1][1], 0, 0, 0);
      __builtin_amdgcn_sched_barrier(0);
      a0 = na0; a1 = na1; b0 = nb0; b1 = nb1;
    }
    if (kt + 1 < ktiles) LSTORE((kt + 1) & 1);
    __syncthreads();
  }
#undef GLOAD
#undef LSTORE
}
template <class AL, class BLB>
DI void gemm_mainloop_bb(f32x16 (&acc)[2][2], const AL& al, const BLB& bl, int ktiles, bf16* smem) {
  const int tid = threadIdx.x, lane = tid & 63, wave = tid >> 6, wm = wave >> 1, wn = wave & 1;
  const int arow = tid >> 3, akc = tid & 7;
  const bf16* ap0 = al.rowptr(arow) + akc * 8;
  const bf16* ap1 = al.rowptr(arow + 32) + akc * 8;
  const bf16* ap2 = al.rowptr(arow + 64) + akc * 8;
  const bf16* ap3 = al.rowptr(arow + 96) + akc * 8;
  const bf16* bp0 = bl.rowptr(arow) + akc * 8;
  const bf16* bp1 = bl.rowptr(arow + 32) + akc * 8;
  const bf16* bp2 = bl.rowptr(arow + 64) + akc * 8;
  const bf16* bp3 = bl.rowptr(arow + 96) + akc * 8;
  uint4 ra0, ra1, ra2, ra3, rb0, rb1, rb2, rb3;
#define GLOAD(kt) { const int ko_ = al.koff(kt), kb_ = bl.koff(kt); ra0 = *(const uint4*)(ap0 + ko_); ra1 = *(const uint4*)(ap1 + ko_); ra2 = *(const uint4*)(ap2 + ko_); ra3 = *(const uint4*)(ap3 + ko_); \
    rb0 = *(const uint4*)(bp0 + kb_); rb1 = *(const uint4*)(bp1 + kb_); rb2 = *(const uint4*)(bp2 + kb_); rb3 = *(const uint4*)(bp3 + kb_); }
#define LSTORE(buf) { bf16* A_ = smem + (buf) * 2 * TILE_ELEMS; bf16* B_ = A_ + TILE_ELEMS; const int o_ = arow * LDS_ROW + akc * 8; \
    *(uint4*)(A_ + o_) = ra0; *(uint4*)(A_ + o_ + 32 * LDS_ROW) = ra1; *(uint4*)(A_ + o_ + 64 * LDS_ROW) = ra2; *(uint4*)(A_ + o_ + 96 * LDS_ROW) = ra3; \
    *(uint4*)(B_ + o_) = rb0; *(uint4*)(B_ + o_ + 32 * LDS_ROW) = rb1; *(uint4*)(B_ + o_ + 64 * LDS_ROW) = rb2; *(uint4*)(B_ + o_ + 96 * LDS_ROW) = rb3; }
  GLOAD(0); LSTORE(0); __syncthreads();
  const int aoff = (wm * 64 + (lane & 31)) * LDS_ROW + (lane >> 5) * 8;
  const int boff = (wn * 64 + (lane & 31)) * LDS_ROW + (lane >> 5) * 8;
  for (int kt = 0; kt < ktiles; ++kt) {
    if (kt + 1 < ktiles) GLOAD(kt + 1);
    const bf16* A = smem + (kt & 1) * 2 * TILE_ELEMS; const bf16* B = A + TILE_ELEMS;
#pragma unroll
    for (int ks = 0; ks < 4; ++ks) {
      const bf16x8 a0 = *(const bf16x8*)(A + aoff + ks * 16), a1 = *(const bf16x8*)(A + aoff + 32 * LDS_ROW + ks * 16);
      const bf16x8 b0 = *(const bf16x8*)(B + boff + ks * 16), b1 = *(const bf16x8*)(B + boff + 32 * LDS_ROW + ks * 16);
      acc[0][0] = __builtin_amdgcn_mfma_f32_32x32x16_bf16(a0, b0, acc[0][0], 0, 0, 0);
      acc[0][1] = __builtin_amdgcn_mfma_f32_32x32x16_bf16(a0, b1, acc[0][1], 0, 0, 0);
      acc[1][0] = __builtin_amdgcn_mfma_f32_32x32x16_bf16(a1, b0, acc[1][0], 0, 0, 0);
      acc[1][1] = __builtin_amdgcn_mfma_f32_32x32x16_bf16(a1, b1, acc[1][1], 0, 0, 0);
    }
    if (kt + 1 < ktiles) LSTORE((kt + 1) & 1);
    __syncthreads();
  }
#undef GLOAD
#undef LSTORE
}

#define WAIT_V(n) asm volatile("s_waitcnt vmcnt(%0)" ::"n"(n) : "memory")
#define RAW_BARRIER() do { asm volatile("s_waitcnt lgkmcnt(0)" ::: "memory"); __builtin_amdgcn_s_barrier(); } while (0)
template <class AL, class BLB>
DI void gemm_mainloop_dma(f32x16 (&acc)[2][2], const AL& al, const BLB& bl, int ktiles, unsigned char* lds) {
  const int tid = threadIdx.x, lane = tid & 63, wave = tid >> 6, wm = wave >> 1, wn = wave & 1;
  const int r0 = 16 * (wave * 2) + (lane >> 2), r1 = r0 + 16;
  const bf16* ga0 = al.rowptr(r0) + (((lane & 3) ^ ((r0 >> 2) & 3)) << 3);
  const bf16* ga1 = al.rowptr(r1) + (((lane & 3) ^ ((r1 >> 2) & 3)) << 3);
  const bf16* gb0 = bl.rowptr(r0) + (((lane & 3) ^ ((r0 >> 2) & 3)) << 3);
  const bf16* gb1 = bl.rowptr(r1) + (((lane & 3) ^ ((r1 >> 2) & 3)) << 3);
  unsigned char* dst = lds + wave * 2048;
#define DMA_STAGE(buf, kt) { const int kt_ = (kt) < ktiles ? (kt) : ktiles - 1; const int ka_ = al.koff32(kt_), kb_ = bl.koff32(kt_); unsigned char* d_ = dst + (buf) * 16384; \
    __builtin_amdgcn_global_load_lds((const unsigned*)(ga0 + ka_), (unsigned*)(d_), 16, 0, 0); \
    __builtin_amdgcn_global_load_lds((const unsigned*)(ga1 + ka_), (unsigned*)(d_ + 1024), 16, 0, 0); \
    __builtin_amdgcn_global_load_lds((const unsigned*)(gb0 + kb_), (unsigned*)(d_ + 8192), 16, 0, 0); \
    __builtin_amdgcn_global_load_lds((const unsigned*)(gb1 + kb_), (unsigned*)(d_ + 8192 + 1024), 16, 0, 0); }
  const int r = lane & 31, hh = lane >> 5, sw = (r >> 2) & 3;
  const int oa0 = (wm * 64 + r) * 64 + (((0 + hh) ^ sw) << 4), oa1 = (wm * 64 + r) * 64 + (((2 + hh) ^ sw) << 4);
  const int ob0 = 8192 + (wn * 64 + r) * 64 + (((0 + hh) ^ sw) << 4), ob1 = 8192 + (wn * 64 + r) * 64 + (((2 + hh) ^ sw) << 4);
  __syncthreads();
  DMA_STAGE(0, 0); DMA_STAGE(1, 1); DMA_STAGE(2, 2);
  for (int t = 0; t < ktiles; ++t) {
    WAIT_V(8);
    RAW_BARRIER();
    const unsigned char* S = lds + (t & 3) * 16384;
    {
      const bf16x8 a0 = *(const bf16x8*)(S + oa0), a1 = *(const bf16x8*)(S + oa0 + 2048), b0 = *(const bf16x8*)(S + ob0), b1 = *(const bf16x8*)(S + ob0 + 2048);
      const bf16x8 c0 = *(const bf16x8*)(S + oa1), c1 = *(const bf16x8*)(S + oa1 + 2048), d0 = *(const bf16x8*)(S + ob1), d1 = *(const bf16x8*)(S + ob1 + 2048);
      acc[0][0] = __builtin_amdgcn_mfma_f32_32x32x16_bf16(a0, b0, acc[0][0], 0, 0, 0);
      acc[0][1] = __builtin_amdgcn_mfma_f32_32x32x16_bf16(a0, b1, acc[0][1], 0, 0, 0);
      acc[1][0] = __builtin_amdgcn_mfma_f32_32x32x16_bf16(a1, b0, acc[1][0], 0, 0, 0);
      acc[1][1] = __builtin_amdgcn_mfma_f32_32x32x16_bf16(a1, b1, acc[1][1], 0, 0, 0);
      acc[0][0] = __builtin_amdgcn_mfma_f32_32x32x16_bf16(c0, d0, acc[0][0], 0, 0, 0);
      acc[0][1] = __builtin_amdgcn_mfma_f32_32x32x16_bf16(c0, d1, acc[0][1], 0, 0, 0);
      acc[1][0] = __builtin_amdgcn_mfma_f32_32x32x16_bf16(c1, d0, acc[1][0], 0, 0, 0);
      acc[1][1] = __builtin_amdgcn_mfma_f32_32x32x16_bf16(c1, d1, acc[1][1], 0, 0, 0);
    }
    __builtin_amdgcn_sched_barrier(0);
    DMA_STAGE((t + 3) & 3, t + 3);
    __builtin_amdgcn_sched_barrier(0);
  }
  WAIT_V(0);
  RAW_BARRIER();
#undef DMA_STAGE
}

constexpr int M2_A_ELEMS = 256 * 40, M2_STAGE_ELEMS = M2_A_ELEMS + 4 * 128 * 8;
template <class AL, class BL>
DI void gemm_mainloop_256(f32x16 (&acc)[4][2], const AL& al, BL& bl, int ktiles, bf16* smem) {
  const int tid = threadIdx.x, lane = tid & 63, wave = tid >> 6, wm = wave >> 1, wn = wave & 1;
  const int arow = tid >> 2, akc = tid & 3, kg = tid >> 5, n4 = tid & 31;
  const bf16* abase = al.base;
  const unsigned ao0 = al.rowoff(arow) + akc * 8, ao1 = al.rowoff(arow + 64) + akc * 8, ao2 = al.rowoff(arow + 128) + akc * 8, ao3 = al.rowoff(arow + 192) + akc * 8;
  bl.init(n4 * 4);
  uint4 ra0, ra1, ra2, ra3; f32x4 rb[4];
#define GLOAD(kt) { const bf16* ab_ = abase + (kt) * 32; ra0 = *(const uint4*)(ab_ + ao0); ra1 = *(const uint4*)(ab_ + ao1); ra2 = *(const uint4*)(ab_ + ao2); ra3 = *(const uint4*)(ab_ + ao3); \
    _Pragma("unroll") for (int r_ = 0; r_ < 4; ++r_) rb[r_] = bl.ld32(kt, kg * 4 + r_); }
#define LSTORE(buf) { bf16* A_ = smem + (buf) * M2_STAGE_ELEMS; bf16* B_ = A_ + M2_A_ELEMS; const int o_ = arow * 40 + akc * 8; \
    *(uint4*)(A_ + o_) = ra0; *(uint4*)(A_ + o_ + 64 * 40) = ra1; *(uint4*)(A_ + o_ + 128 * 40) = ra2; *(uint4*)(A_ + o_ + 192 * 40) = ra3; \
    _Pragma("unroll") for (int c_ = 0; c_ < 4; ++c_) { uint2 v_; v_.x = pk2(rb[0][c_], rb[1][c_]); v_.y = pk2(rb[2][c_], rb[3][c_]); const int n_ = n4 * 4 + c_; \
      *(uint2*)(B_ + ((kg >> 1) * 128 + (n_ ^ ((n_ >> 3) & 3))) * 8 + (kg & 1) * 4) = v_; } }
  GLOAD(0); LSTORE(0); __syncthreads();
  const int r = lane & 31, hh = lane >> 5;
  const int aoff = (wm * 128 + r) * 40 + hh * 8;
  const int nb0 = wn * 64 + r, nb1 = nb0 + 32;
  const int boff0 = M2_A_ELEMS + (hh * 128 + (nb0 ^ ((nb0 >> 3) & 3))) * 8, boff1 = M2_A_ELEMS + (hh * 128 + (nb1 ^ ((nb1 >> 3) & 3))) * 8;
  for (int kt = 0; kt < ktiles; ++kt) {
    if (kt + 1 < ktiles) GLOAD(kt + 1);
    const bf16* S = smem + (kt & 1) * M2_STAGE_ELEMS;
#pragma unroll
    for (int ks = 0; ks < 2; ++ks) {
      const bf16x8 b0 = *(const bf16x8*)(S + boff0 + ks * 2 * 128 * 8), b1 = *(const bf16x8*)(S + boff1 + ks * 2 * 128 * 8);
#pragma unroll
      for (int mi = 0; mi < 4; ++mi) { const bf16x8 a = *(const bf16x8*)(S + aoff + mi * 32 * 40 + ks * 16);
        acc[mi][0] = __builtin_amdgcn_mfma_f32_32x32x16_bf16(a, b0, acc[mi][0], 0, 0, 0);
        acc[mi][1] = __builtin_amdgcn_mfma_f32_32x32x16_bf16(a, b1, acc[mi][1], 0, 0, 0); }
      __builtin_amdgcn_sched_barrier(0);
    }
    if (kt + 1 < ktiles) LSTORE((kt + 1) & 1);
    __syncthreads();
  }
#undef GLOAD
#undef LSTORE
}

template <class AL, class BLB>
DI void gemm_mainloop_dma_m256(f32x16 (&acc)[4][2], const AL& al, const BLB& bl, int ktiles, unsigned char* lds) {
  const int tid = threadIdx.x, lane = tid & 63, wave = __builtin_amdgcn_readfirstlane(tid >> 6), wm = wave >> 1, wn = wave & 1;
  const int ra_ = 16 * (wave * 4) + (lane >> 2), rb_ = 16 * (wave * 2) + (lane >> 2);
  const bf16* abase = al.rowptr(0); const bf16* bbase = bl.rowptr(0);
  const unsigned ao0 = (unsigned)(al.rowptr(ra_) - abase) + (((lane & 3) ^ ((ra_ >> 2) & 3)) << 3);
  const unsigned ao1 = (unsigned)(al.rowptr(ra_ + 16) - abase) + (((lane & 3) ^ (((ra_ + 16) >> 2) & 3)) << 3);
  const unsigned ao2 = (unsigned)(al.rowptr(ra_ + 32) - abase) + (((lane & 3) ^ (((ra_ + 32) >> 2) & 3)) << 3);
  const unsigned ao3 = (unsigned)(al.rowptr(ra_ + 48) - abase) + (((lane & 3) ^ (((ra_ + 48) >> 2) & 3)) << 3);
  const unsigned bo0 = (unsigned)(bl.rowptr(rb_) - bbase) + (((lane & 3) ^ ((rb_ >> 2) & 3)) << 3);
  const unsigned bo1 = (unsigned)(bl.rowptr(rb_ + 16) - bbase) + (((lane & 3) ^ (((rb_ + 16) >> 2) & 3)) << 3);
  constexpr int STG = 24576;
#define DMA_STAGE3(buf, kt) { const int kt_ = (kt) < ktiles ? (kt) : ktiles - 1; const bf16* ap_ = abase + al.koff32(kt_); const bf16* bp_ = bbase + bl.koff32(kt_); unsigned char* d_ = lds + (buf) * STG; \
    __builtin_amdgcn_global_load_lds((const unsigned*)(ap_ + ao0), (unsigned*)(d_ + wave * 4096), 16, 0, 0); \
    __builtin_amdgcn_global_load_lds((const unsigned*)(ap_ + ao1), (unsigned*)(d_ + wave * 4096 + 1024), 16, 0, 0); \
    __builtin_amdgcn_global_load_lds((const unsigned*)(ap_ + ao2), (unsigned*)(d_ + wave * 4096 + 2048), 16, 0, 0); \
    __builtin_amdgcn_global_load_lds((const unsigned*)(ap_ + ao3), (unsigned*)(d_ + wave * 4096 + 3072), 16, 0, 0); \
    __builtin_amdgcn_global_load_lds((const unsigned*)(bp_ + bo0), (unsigned*)(d_ + 16384 + wave * 2048), 16, 0, 0); \
    __builtin_amdgcn_global_load_lds((const unsigned*)(bp_ + bo1), (unsigned*)(d_ + 16384 + wave * 2048 + 1024), 16, 0, 0); }
  const int r = lane & 31, hh = lane >> 5, sw = (r >> 2) & 3;
  const int oa0 = (wm * 128 + r) * 64 + (((0 + hh) ^ sw) << 4), oa1 = (wm * 128 + r) * 64 + (((2 + hh) ^ sw) << 4);
  const int ob0 = 16384 + (wn * 64 + r) * 64 + (((0 + hh) ^ sw) << 4), ob1 = 16384 + (wn * 64 + r) * 64 + (((2 + hh) ^ sw) << 4);
  __syncthreads();
  DMA_STAGE3(0, 0); DMA_STAGE3(1, 1);
  int buf = 0;
  for (int t = 0; t < ktiles; ++t) {
    WAIT_V(6);
    RAW_BARRIER();
    const unsigned char* S = lds + buf * STG;
#pragma unroll
    for (int ks = 0; ks < 2; ++ks) {
      const int oa = ks ? oa1 : oa0, ob = ks ? ob1 : ob0;
      const bf16x8 b0 = *(const bf16x8*)(S + ob), b1 = *(const bf16x8*)(S + ob + 2048);
#pragma unroll
      for (int mi = 0; mi < 4; ++mi) { const bf16x8 a = *(const bf16x8*)(S + oa + mi * 2048);
        acc[mi][0] = __builtin_amdgcn_mfma_f32_32x32x16_bf16(a, b0, acc[mi][0], 0, 0, 0);
        acc[mi][1] = __builtin_amdgcn_mfma_f32_32x32x16_bf16(a, b1, acc[mi][1], 0, 0, 0); }
    }
    __builtin_amdgcn_sched_barrier(0);
    { const int nb = buf == 0 ? 2 : buf - 1; DMA_STAGE3(nb, t + 2); }
    __builtin_amdgcn_sched_barrier(0);
    buf = buf == 2 ? 0 : buf + 1;
  }
  WAIT_V(0);
  RAW_BARRIER();
#undef DMA_STAGE3
}
struct ALBlk2 { const bf16* base; int kblocks; DI const bf16* rowptr(int r) const { return base + (size_t)(r >> 7) * kblocks * 4096 + (r & 127) * 32; } DI int koff32(int kt) const { return kt * 4096; } };
struct BLRouterB { const bf16* base; DI const bf16* rowptr(int r) const { return base + (size_t)r * 2048; }
  DI int koff(int kt) const { return kt < 16 ? kt * 64 : (kt < 32 ? (kt - 16) * 64 : 1024 + (kt - 32) * 64); }
  DI int koff32(int kt) const { return kt < 32 ? kt * 32 : (kt < 64 ? (kt - 32) * 32 : 1024 + (kt - 64) * 32); } };
template <class CM>
DI void transpose_block(const float* __restrict__ W, int N, bf16* __restrict__ WT, int ldt, int k0, int n0, float* scr, int lane, CM colmap) {
  const int sc = colmap(n0 + (lane & 31));
#pragma unroll 8
  for (int i = 0; i < 32; ++i) { const int kk = 2 * i + (lane >> 5); const float wv = __builtin_nontemporal_load(W + (size_t)(k0 + kk) * N + (sc >= 0 ? sc : 0)); scr[kk * 33 + (lane & 31)] = sc >= 0 ? wv : 0.f; }
  __builtin_amdgcn_wave_barrier();
  const int c = lane & 7;
#pragma unroll
  for (int j = 0; j < 4; ++j) { const int n = (lane >> 3) + 8 * j; const float* s = scr + (8 * c) * 33 + n;
    uint4 o; o.x = pk2(s[0 * 33], s[1 * 33]); o.y = pk2(s[2 * 33], s[3 * 33]); o.z = pk2(s[4 * 33], s[5 * 33]); o.w = pk2(s[6 * 33], s[7 * 33]);
    if (ldt < 0) *(uint4*)(WT + blk_off(n0 + n, k0 + 8 * c, -ldt)) = o; else *(uint4*)(WT + (size_t)(n0 + n) * ldt + k0 + 8 * c) = o; }
  __builtin_amdgcn_wave_barrier();
}
DI void acc_zero(f32x16 (&acc)[2][2]) {
#pragma unroll
  for (int i = 0; i < 2; ++i)
#pragma unroll
    for (int j = 0; j < 2; ++j)
#pragma unroll
      for (int r = 0; r < 16; ++r) acc[i][j][r] = 0.f;
}
DI int crow(int r, int lane) { return 8 * (r >> 2) + 4 * (lane >> 5) + (r & 3); }


DI void st16_bf16(bf16* base, int ld, const float (&v)[16]) {
#pragma unroll
  for (int q = 0; q < 4; ++q) { bf16* pq = base + (size_t)(8 * q) * ld; asm volatile("" : "+v"(pq));
#pragma unroll
    for (int i = 0; i < 4; ++i) pq[(size_t)i * ld] = f2bf(v[4 * q + i]); }
}
DI void st16_f32(float* base, int ld, const float (&v)[16]) {
#pragma unroll
  for (int q = 0; q < 4; ++q) { float* pq = base + (size_t)(8 * q) * ld; asm volatile("" : "+v"(pq));
#pragma unroll
    for (int i = 0; i < 4; ++i) pq[(size_t)i * ld] = v[4 * q + i]; }
}

struct ALBlk { const bf16* base; DI const bf16* rowptr(int r) const { return base + r * 32; } DI int koff32(int kt) const { return kt * 4096; } };

constexpr int ST_LD = 132;
DI void stage_block(float* st, int ldst, int mi, int ni, const float (&v)[16]) {
  const int lane = threadIdx.x & 63, wave = threadIdx.x >> 6, wm = wave >> 1, wn = wave & 1;
  float* b = st + (wm * 64 + mi * 32 + 4 * (lane >> 5)) * ldst + wn * 64 + ni * 32 + (lane & 31);
#pragma unroll
  for (int r = 0; r < 16; ++r) b[(8 * (r >> 2) + (r & 3)) * ldst] = v[r];
}
DI void stage_acc(float* st, f32x16 (&acc)[2][2]) {
#pragma unroll
  for (int mi = 0; mi < 2; ++mi)
#pragma unroll
    for (int ni = 0; ni < 2; ++ni) { float v[16];
#pragma unroll
      for (int r = 0; r < 16; ++r) v[r] = acc[mi][ni][r];
      stage_block(st, ST_LD, mi, ni, v); }
}
DI uint4 pack8(const float* s) { const f32x4 a = *(const f32x4*)s, b = *(const f32x4*)(s + 4); uint4 o; o.x = pk2(a[0], a[1]); o.y = pk2(a[2], a[3]); o.z = pk2(b[0], b[1]); o.w = pk2(b[2], b[3]); return o; }
struct ALPlain { const bf16* base; int ld; DI const bf16* rowptr(int r) const { return base + (size_t)r * ld; } DI int koff(int kt) const { return kt * 64; } DI int koff32(int kt) const { return kt * 32; } };
struct ALGather256 { const bf16* base; const int* list; int nvalid; DI unsigned rowoff(int r) const { int rr = r < nvalid ? r : nvalid - 1; return (unsigned)(list[rr] >> 3) * 1024u; } };
struct ALRows { const bf16* base; int ld; DI unsigned rowoff(int r) const { return (unsigned)(r * ld); } };
struct ALGather { const bf16* H; const int* list; int nvalid; DI const bf16* rowptr(int r) const { int rr = r < nvalid ? r : nvalid - 1; return H + (size_t)(list[rr] >> 3) * 1024; } DI int koff(int kt) const { return kt * 64; } };
struct ALRouter { const bf16* base; DI const bf16* rowptr(int r) const { return base + (size_t)r * 1024; }
  DI int koff(int kt) const { return kt < 16 ? kt * 64 : (kt < 32 ? (int)((O_HLO - O_HHI) / 2) + (kt - 16) * 64 : (kt - 32) * 64); }
  DI int koff32(int kt) const { return kt < 32 ? kt * 32 : (kt < 64 ? (int)((O_HLO - O_HHI) / 2) + (kt - 32) * 32 : (kt - 64) * 32); } };

template <int LDB> struct BLPlain { const float* W; int n0, nmax; const float* pt; bool ok;
  DI void init(int ncol) { int n = n0 + ncol; ok = n < nmax; pt = W + (ok ? n : 0); }
  DI f32x4 ld(int kt, int krow) const { f32x4 z = {0.f, 0.f, 0.f, 0.f}; return ok ? *(const f32x4*)(pt + (size_t)(kt * 64 + krow) * LDB) : z; }
  DI f32x4 ld32(int kt, int krow) const { return *(const f32x4*)(pt + (size_t)(kt * 32 + krow) * LDB); } };
DI int srccol(int n) { return n < 1064 ? n : (n < 1088 ? n + 1280 : (n < 2368 ? n - 24 : n)); }
struct BLInproj { const float* W; int n0; const float* pt; bool ok;
  DI void init(int ncol) { int n = n0 + ncol; ok = n < NIN; pt = W + (ok ? srccol(n) : 0); }
  DI f32x4 ld(int kt, int krow) const { f32x4 z = {0.f, 0.f, 0.f, 0.f}; return ok ? *(const f32x4*)(pt + (size_t)(kt * 64 + krow) * NIN) : z; } };
struct BLGateUp { const float* Wg; long du; int hc0; const float* pt;
  DI void init(int ncol) { int wn = ncol >> 6, ni = (ncol >> 5) & 1, c = ncol & 31; pt = Wg + (long)ni * du + hc0 + wn * 32 + c; }
  DI f32x4 ld(int kt, int krow) const { return *(const f32x4*)(pt + (size_t)(kt * 64 + krow) * 256); }
  DI f32x4 ld32(int kt, int krow) const { return *(const f32x4*)(pt + (size_t)(kt * 32 + krow) * 256); } };
struct BLRouter { const float* W; int n0; const float* pt;
  DI void init(int ncol) { pt = W + n0 + ncol; }
  DI f32x4 ld(int kt, int krow) const { f32x4 w = *(const f32x4*)(pt + (size_t)((kt & 15) * 64 + krow) * 256);
    if (kt >= 32) { w[0] -= bf2f(f2bf(w[0])); w[1] -= bf2f(f2bf(w[1])); w[2] -= bf2f(f2bf(w[2])); w[3] -= bf2f(f2bf(w[3])); } return w; } };

DI float inv_freq(int i) {
  switch (i) {
    case 0: return 1.0f; case 1: return 0.1939227432012558f; case 2: return 0.03760603070259094f; case 3: return 0.007292664609849453f;
    case 4: return 0.0014142135623842478f; case 5: return 0.00027424818836152554f; case 6: return 5.3182957344688475e-05f; case 7: return 1.0313385246263351e-05f;
    case 8: return 1.0f; case 9: return 0.03760603070259094f; case 10: return 0.0014142135623842478f; default: return 5.3182957344688475e-05f;
  }
}

DI void conv_wave_item(PR p, int w, float* scr, int lane) {
  unsigned char* ws = p.ws;
  if (w < 2240) { const int nb = w % 140, kb = w / 140;
    transpose_block(p.w_in, NIN, (bf16*)(ws + O_WT_IN), -1024, kb * 64, nb * 32, scr, lane, [](int n) { return n < NIN ? srccol(n) : -1; }); return; }
  w -= 2240;
  if (w < 512) { const int which = w >> 8, q = w & 255, nb = q & 31, kb = q >> 5;
    transpose_block(which ? p.w_br_b : p.w_br_a, 1024, (bf16*)(ws + (which ? O_WT_BRB : O_WT_BRA)), 512, kb * 64, nb * 32, scr, lane, [](int n) { return n; }); return; }
  w -= 512;
  if (w < 512) { const int nb = w & 31, kb = w >> 5;
    transpose_block(p.w_out, 1024, (bf16*)(ws + O_WT_OUT), 1024, kb * 64, nb * 32, scr, lane, [](int n) { return n; }); return; }
  w -= 512;
  if (w < 256) {
    const int lo = w >> 7, q = w & 127, nb = q & 7, kb = q >> 3, k0 = kb * 64, n0 = nb * 32;
#pragma unroll 8
    for (int i = 0; i < 32; ++i) { const int kk = 2 * i + (lane >> 5); float v = p.w_router[(size_t)(k0 + kk) * 256 + n0 + (lane & 31)]; if (lo) v -= bf2f(f2bf(v)); scr[kk * 33 + (lane & 31)] = v; }
    __builtin_amdgcn_wave_barrier();
    const int c = lane & 7; bf16* WT = (bf16*)(ws + O_WT_RT) + lo * 1024;
#pragma unroll
    for (int j = 0; j < 4; ++j) { const int n = (lane >> 3) + 8 * j; const float* s = scr + (8 * c) * 33 + n;
      uint4 o; o.x = pk2(s[0 * 33], s[1 * 33]); o.y = pk2(s[2 * 33], s[3 * 33]); o.z = pk2(s[4 * 33], s[5 * 33]); o.w = pk2(s[6 * 33], s[7 * 33]);
      *(uint4*)(WT + (size_t)(n0 + n) * 2048 + k0 + 8 * c) = o; }
    __builtin_amdgcn_wave_barrier();
    return; }
  w -= 256;
  if (w < 256) {
    const int nb = w & 15, kb = w >> 4, nt = nb >> 2, wn = (nb >> 1) & 1, ni = nb & 1, sc0 = nt * 64 + wn * 32 - nb * 32;
    transpose_block(ni ? p.w_sh_up : p.w_sh_gate, 256, (bf16*)(ws + O_WT_SGU), 1024, kb * 64, nb * 32, scr, lane, [sc0](int n) { return n + sc0; }); return; }
  w -= 256;
  if (w < 128) { const int nb = w & 31, kb = w >> 5;
    transpose_block(p.w_sh_down, 1024, (bf16*)(ws + O_WT_SD), 256, kb * 64, nb * 32, scr, lane, [](int n) { return n; }); return; }
  w -= 128;
  if (w < 512) { const int which = w >> 8, q = w & 255, nb = q & 7, kb = q >> 3;
    transpose_block(which ? p.cmp_v_w1 : p.cmp_k_w1, 256, (bf16*)(ws + (which ? O_WT_C1V : O_WT_C1K)), 2048, kb * 64, nb * 32, scr, lane, [](int n) { return n; }); return; }
  w -= 512;
  if (w < 32) { const int which = w >> 4, q = w & 15, nb = q & 3, kb = q >> 2;
    transpose_block(which ? p.cmp_v_w2 : p.cmp_k_w2, 64, (bf16*)(ws + (which ? O_WT_C2V : O_WT_C2K)), 256, kb * 64, nb * 32, scr, lane, [](int n) { return n < 64 ? n : -1; }); return; }
}
constexpr int N_CONV_WAVE = 2240 + 512 + 512 + 256 + 256 + 128 + 512 + 32;
DI void ph_prologue(PR p, unsigned char* smem, int* qctr, int* shv) {
  float* sc = (float*)smem;
  constexpr int N_MOD = 96, N_TAB = T * 12 / 256, N_CB = 64, N_CV = N_CONV_WAVE / 4;
  const int G = gridDim.x; constexpr int NR = N_TAB + N_CB + N_CV; const bool split = G >= 2 * N_MOD;
  for (int s = 0;; ++s) {
    int it;
    if (split) { if ((int)blockIdx.x < N_MOD) { if (s) break; it = blockIdx.x; } else { const int r = ((int)blockIdx.x - N_MOD) + s * (G - N_MOD); if (r >= NR) break; it = N_MOD + r; } }
    else { it = blockIdx.x + s * G; if (it >= N_MOD + NR) break; }
    __syncthreads();
    if (it < N_MOD) {
      { f32x4 cv[16];
#pragma unroll
        for (int u = 0; u < 16; ++u) cv[u] = *(const f32x4*)(p.c + (threadIdx.x + 256 * u) * 4);
#pragma unroll
        for (int u = 0; u < 16; ++u) { f32x4 s; s[0] = siluf_(cv[u][0]); s[1] = siluf_(cv[u][1]); s[2] = siluf_(cv[u][2]); s[3] = siluf_(cv[u][3]); *(f32x4*)(sc + (threadIdx.x + 256 * u) * 4) = s; } }
      __syncthreads();
      const int kq = threadIdx.x >> 6, cidx = threadIdx.x & 63, j = it * 64 + cidx;
      float a[16];
#pragma unroll
      for (int b = 0; b < 16; ++b) a[b] = 0.f;
      const float* wp = p.w_ada + (size_t)(kq * 256) * 6144 + j;
      float wb[16];
#pragma unroll
      for (int u = 0; u < 16; ++u) wb[u] = __builtin_nontemporal_load(wp + (size_t)u * 6144);
      for (int k0 = 0; k0 < 256; k0 += 16) {
        float wn[16];
#pragma unroll
        for (int u = 0; u < 16; ++u) wn[u] = (k0 + 16 < 256) ? __builtin_nontemporal_load(wp + (size_t)(k0 + 16 + u) * 6144) : 0.f;
#pragma unroll
        for (int u = 0; u < 16; ++u) {
#pragma unroll
          for (int b = 0; b < 16; ++b) a[b] += sc[b * 1024 + kq * 256 + k0 + u] * wb[u]; }
#pragma unroll
        for (int u = 0; u < 16; ++u) wb[u] = wn[u];
      }
      __syncthreads();
      float* part = sc;
#pragma unroll
      for (int b = 0; b < 16; ++b) part[(kq * 16 + b) * 64 + cidx] = a[b];
      __syncthreads();
      for (int o = threadIdx.x; o < 1024; o += 256) { const int b = o >> 6, cc = o & 63, jj = it * 64 + cc;
        const float s = ((part[(0 * 16 + b) * 64 + cc] + part[(1 * 16 + b) * 64 + cc]) + (part[(2 * 16 + b) * 64 + cc] + part[(3 * 16 + b) * 64 + cc]));
        ((float*)(p.ws + O_MOD))[b * 6144 + jj] = s + p.b_ada[jj]; }
    } else if (it < N_MOD + N_TAB) {
      const int idx = (it - N_MOD) * 256 + threadIdx.x; const int tok = idx / 12, i = idx % 12;
      const float ang = (float)p.pos[tok] * inv_freq(i);
      double rev = (double)ang * 0.15915494309189535; rev -= rint(rev);
      const float a = (float)(rev * 6.283185307179586);
      const float sn = sinf(a), cs = cosf(a);
      if (i < 8) { float* r = (float*)(p.ws + O_ROPEH) + (size_t)tok * 16; r[i] = cs; r[8 + i] = sn; }
      else { float* r = (float*)(p.ws + O_ROPEI) + (size_t)tok * 8; r[i - 8] = cs; r[4 + i - 8] = sn; }
    } else if (it >= N_MOD + N_TAB + N_CB) {
      conv_wave_item(p, (it - N_MOD - N_TAB - N_CB) * 4 + (threadIdx.x >> 6), (float*)smem + (threadIdx.x >> 6) * (64 * 33), threadIdx.x & 63);
    } else {
      const int q = it - N_MOD - N_TAB, which = q >> 5, kc = q & 31, j = threadIdx.x;
      const float* pos = which ? p.cmp_pos_v : p.cmp_pos_k; const float* w1 = which ? p.cmp_v_w1 : p.cmp_k_w1;
      float acc = 0.f;
      for (int k = kc * 64; k < kc * 64 + 64; ++k) acc += pos[k] * w1[(size_t)k * 256 + j];
      ((float*)(p.ws + O_CMPB))[(which * 32 + kc) * 256 + j] = acc;
    }
  }
}
DI void ph_u(PR p) {
  const float* modb = (const float*)(p.ws + O_MOD); bf16* U = (bf16*)(p.ws + O_U);
  const size_t nthr = (size_t)gridDim.x * 256;
  for (size_t i4 = (size_t)blockIdx.x * 256 + threadIdx.x; i4 < (size_t)T * 256; i4 += 4 * nthr) {
    float4 xv[4];
#pragma unroll
    for (int u = 0; u < 4; ++u) { const f32x4 t_ = __builtin_nontemporal_load((const f32x4*)(p.x + (i4 + u * nthr) * 4)); xv[u].x = t_[0]; xv[u].y = t_[1]; xv[u].z = t_[2]; xv[u].w = t_[3]; }
#pragma unroll
    for (int u = 0; u < 4; ++u) {
      const size_t e = (i4 + u * nthr) * 4; const int tok = (int)(e >> 10), col = (int)(e & 1023), b = tok >> 11;
      const float* mod = modb + b * 6144;
      const float4 sh = *(const float4*)(mod + col), sc = *(const float4*)(mod + 1024 + col);
      uint2 o; o.x = pk2(xv[u].x * (1.f + sc.x) + sh.x, xv[u].y * (1.f + sc.y) + sh.y); o.y = pk2(xv[u].z * (1.f + sc.z) + sh.z, xv[u].w * (1.f + sc.w) + sh.w);
      *(uint2*)(U + blk_off(tok, col, 1024)) = o;
    }
  }
}
DI bool is_rope_head_seg(int n) { return n < 640 || (n >= 1088 && n < 1600) || (n >= 1856 && n < 1984) || (n >= 2112 && n < 2240); }
DI float rope_h(const float* ropeH, int tok, int d, float v, float vp) { int i = d & 7; float cs = ropeH[(size_t)tok * 16 + i], sn = ropeH[(size_t)tok * 16 + 8 + i]; return (d < 8) ? v * cs - vp * sn : v * cs + vp * sn; }
DI float rope_i(const float* ropeI, int tok, int d, float v, float vp) { int i = d & 3; float cs = ropeI[(size_t)tok * 8 + i], sn = ropeI[(size_t)tok * 8 + 4 + i]; return (d < 4) ? v * cs - vp * sn : v * cs + vp * sn; }

DI bf16* inproj_dst(unsigned char* ws, int tok, int n, bool raw) {
  if (n < 512) return (bf16*)(ws + O_QA) + (size_t)tok * 512 + n;
  if (n < 640) return (bf16*)(ws + O_KA) + (size_t)tok * 128 + n - 512;
  if (n < 1024) return (bf16*)(ws + O_QI) + (size_t)tok * 256 + n - 768;
  if (n < 1056) return (bf16*)(ws + O_KI) + (size_t)tok * 32 + n - 1024;
  if (n < 1600) return (bf16*)(ws + (raw ? O_QBR : O_QBT)) + (size_t)tok * 512 + n - 1088;
  if (n < 1856) { const int cc = (n - 1600) & 127; return (bf16*)(ws + (n < 1728 ? O_KC : O_VC)) + ((size_t)((tok >> 11) * 2 + (cc >> 6)) * 2048 + (tok & 2047)) * 64 + (cc & 63); }
  if (n < 1984) return (bf16*)(ws + O_KS) + (size_t)tok * 128 + n - 1856;
  if (n < 2240) return (bf16*)(ws + O_KW) + (size_t)tok * 128 + n - 2112;
  if (n < 3392) return (bf16*)(ws + O_SGA) + (size_t)tok * 1024 + n - 2368;
  return (bf16*)(ws + O_SGB) + (size_t)tok * 1024 + n - 3392;
}
DI void inproj_copyout(unsigned char* ws, const float* st, int m0, int n0, bool raw_pass) {
  const int bidx = m0 >> 11;
#pragma unroll 1
  for (int sub = 0; sub < 4; ++sub) {
    const int nsub = n0 + sub * 32;
    if (nsub >= NIN) break;
    if (nsub == 1056) continue;
    if (raw_pass && !(nsub >= 1088 && nsub < 1600)) continue;
    const int tseg = (nsub >= 640 && nsub < 768) ? 0 : ((nsub >= 1984 && nsub < 2112) ? 1 : ((nsub >= 2240 && nsub < 2368) ? 2 : -1));
#pragma unroll
    for (int j = 0; j < 2; ++j) { const int u = threadIdx.x + 256 * j;
      if (tseg < 0) { const int row = u >> 2, cg = u & 3;
        *(uint4*)inproj_dst(ws, m0 + row, nsub + cg * 8, raw_pass) = pack8(st + row * ST_LD + sub * 32 + cg * 8);
      } else {
        const int d = u & 31, rg = u >> 5; const float* s = st + (rg * 8) * ST_LD + sub * 32 + d;
        uint4 o; o.x = pk2(s[0], s[ST_LD]); o.y = pk2(s[2 * ST_LD], s[3 * ST_LD]); o.z = pk2(s[4 * ST_LD], s[5 * ST_LD]); o.w = pk2(s[6 * ST_LD], s[7 * ST_LD]);
        const int cc = nsub - (tseg == 0 ? 640 : (tseg == 1 ? 1984 : 2240)) + d;
        bf16* dst = (bf16*)(ws + (tseg == 0 ? O_VAT : (tseg == 1 ? O_VST : O_VWT))) + ((size_t)(bidx * 2 + (cc >> 6)) * 64 + (cc & 63)) * 2048 + (m0 & 2047) + rg * 8;
        *(uint4*)dst = o; }
    }
  }
}
DI void inproj_epilogue(PR p, f32x16 (&acc)[2][2], int m0, int n0, float* st) {
  unsigned char* ws = p.ws;
  const int lane = threadIdx.x & 63, wave = threadIdx.x >> 6, wm = wave >> 1, wn = wave & 1, c = lane & 31, h4 = 4 * (lane >> 5);
  const float* ropeH = (const float*)(ws + O_ROPEH); const float* ropeI = (const float*)(ws + O_ROPEI);
#pragma unroll
  for (int ni = 0; ni < 2; ++ni) {
    const int nsub = n0 + wn * 64 + ni * 32;
    if (nsub >= NIN) continue;
    const bool hrope = is_rope_head_seg(nsub) && ((nsub & 63) == 0);
    const bool irope = nsub >= 768 && nsub < 1056;
#pragma unroll
    for (int mi = 0; mi < 2; ++mi) {
      const int tok0 = m0 + wm * 64 + mi * 32 + h4;
      float v[16], vr[16];
#pragma unroll
      for (int r = 0; r < 16; ++r) { v[r] = acc[mi][ni][r]; vr[r] = v[r]; }
      if (hrope) {
        const float* rp = ropeH + (size_t)tok0 * 16 + (c & 7); asm volatile("" : "+v"(rp));
#pragma unroll
        for (int r = 0; r < 16; ++r) { const float vp = __shfl_xor(v[r], 8); const int ro = (8 * (r >> 2) + (r & 3)) * 16;
          const float cs = rp[ro], sn = rp[ro + 8]; const float vrot = (c < 8) ? v[r] * cs - vp * sn : v[r] * cs + vp * sn; vr[r] = (c < 16) ? vrot : v[r]; }
      } else if (irope) {
        const float* rp = ropeI + (size_t)tok0 * 8 + (c & 3); asm volatile("" : "+v"(rp));
#pragma unroll
        for (int r = 0; r < 16; ++r) { const float vp = __shfl_xor(v[r], 4); const int ro = (8 * (r >> 2) + (r & 3)) * 8;
          const float cs = rp[ro], sn = rp[ro + 4]; const float vrot = (c < 4) ? v[r] * cs - vp * sn : v[r] * cs + vp * sn; vr[r] = (c < 8) ? vrot : v[r]; }
      }
      if (nsub == 1056) {
        if (c < 8) {
#pragma unroll
          for (int r = 0; r < 16; ++r) vr[r] = v[r] * 0.0625f;
          st16_f32((float*)(ws + O_WI) + (size_t)tok0 * 8 + c, 8, vr);
        } else {
#pragma unroll
          for (int r = 0; r < 16; ++r) vr[r] = sigmoidf_(v[r]);
          st16_f32((float*)(ws + O_GN) + (size_t)tok0 * 24 + c - 8, 24, vr);
        }
      } else {
        if (nsub >= 2368) {
#pragma unroll
          for (int r = 0; r < 16; ++r) vr[r] = sigmoidf_(v[r]);
        }
        stage_block(st, ST_LD, mi, ni, vr);
      }
    }
  }
  __syncthreads();
  inproj_copyout(ws, st, m0, n0, false);
  if (n0 + 128 > 1088 && n0 < 1600) {
    __syncthreads();
#pragma unroll
    for (int ni = 0; ni < 2; ++ni) { const int nsub = n0 + wn * 64 + ni * 32;
      if (nsub >= 1088 && nsub < 1600) {
#pragma unroll
        for (int mi = 0; mi < 2; ++mi) { float v[16];
#pragma unroll
          for (int r = 0; r < 16; ++r) v[r] = acc[mi][ni][r];
          stage_block(st, ST_LD, mi, ni, v); } } }
    __syncthreads();
    inproj_copyout(ws, st, m0, n0, true);
  }
}
DI void inproj_copyout2(unsigned char* ws, const float* st, int m0, int n0) {
  const int bidx = m0 >> 11;
  const float* ropeH = (const float*)(ws + O_ROPEH); const float* ropeI = (const float*)(ws + O_ROPEI);
#pragma unroll 1
  for (int sub = 0; sub < 4; ++sub) {
    const int nsub = n0 + sub * 32;
    if (nsub >= NIN) break;
    if (nsub == 1056) {
#pragma unroll
      for (int j = 0; j < 2; ++j) { const int u = threadIdx.x + 256 * j, row = u >> 2, cg = u & 3, tok = m0 + row;
        const float* s = st + row * ST_LD + sub * 32 + cg * 8; f32x4 va = *(const f32x4*)s, vb = *(const f32x4*)(s + 4);
        if (cg == 0) { va *= 0.0625f; vb *= 0.0625f; float* d = (float*)(ws + O_WI) + (size_t)tok * 8; *(f32x4*)d = va; *(f32x4*)(d + 4) = vb; }
        else { float* d = (float*)(ws + O_GN) + (size_t)tok * 24 + (cg - 1) * 8;
          f32x4 ga, gb; ga[0] = sigmoidf_(va[0]); ga[1] = sigmoidf_(va[1]); ga[2] = sigmoidf_(va[2]); ga[3] = sigmoidf_(va[3]); gb[0] = sigmoidf_(vb[0]); gb[1] = sigmoidf_(vb[1]); gb[2] = sigmoidf_(vb[2]); gb[3] = sigmoidf_(vb[3]);
          *(f32x4*)d = ga; *(f32x4*)(d + 4) = gb; } }
      continue;
    }
    const int tseg = (nsub >= 640 && nsub < 768) ? 0 : ((nsub >= 1984 && nsub < 2112) ? 1 : ((nsub >= 2240 && nsub < 2368) ? 2 : -1));
    const bool hrope = is_rope_head_seg(nsub) && ((nsub & 63) == 0), irope = nsub >= 768 && nsub < 1056, qb = nsub >= 1088 && nsub < 1600;
#pragma unroll
    for (int j = 0; j < 2; ++j) { const int u = threadIdx.x + 256 * j;
      if (tseg < 0) { const int row = u >> 2, cg = u & 3, tok = m0 + row;
        const float* s = st + row * ST_LD + sub * 32 + cg * 8;
        const f32x4 va = *(const f32x4*)s, vb = *(const f32x4*)(s + 4);
        float o[8] = {va[0], va[1], va[2], va[3], vb[0], vb[1], vb[2], vb[3]};
        if (nsub >= 2368) {
#pragma unroll
          for (int e = 0; e < 8; ++e) o[e] = __builtin_amdgcn_rcpf(1.f + __expf(-o[e])); }
        if (qb) { uint4 ro; ro.x = pk2(o[0], o[1]); ro.y = pk2(o[2], o[3]); ro.z = pk2(o[4], o[5]); ro.w = pk2(o[6], o[7]); *(uint4*)inproj_dst(ws, tok, nsub + cg * 8, true) = ro; }
        if (hrope && cg < 2) {
          const float* ps = st + row * ST_LD + sub * 32 + (cg ^ 1) * 8; const f32x4 pa = *(const f32x4*)ps, pb = *(const f32x4*)(ps + 4);
          const float* rp = ropeH + (size_t)tok * 16; const f32x4 ca = *(const f32x4*)rp, cb = *(const f32x4*)(rp + 4), sa = *(const f32x4*)(rp + 8), sb = *(const f32x4*)(rp + 12);
          const float sg = cg == 0 ? -1.f : 1.f;
#pragma unroll
          for (int e = 0; e < 4; ++e) { o[e] = o[e] * ca[e] + sg * pa[e] * sa[e]; o[4 + e] = o[4 + e] * cb[e] + sg * pb[e] * sb[e]; }
        } else if (irope && cg == 0) {
          const float* rp = ropeI + (size_t)tok * 8; const f32x4 cs = *(const f32x4*)rp, sn = *(const f32x4*)(rp + 4);
#pragma unroll
          for (int e = 0; e < 4; ++e) { const float x1 = o[e], x2 = o[4 + e]; o[e] = x1 * cs[e] - x2 * sn[e]; o[4 + e] = x2 * cs[e] + x1 * sn[e]; }
        }
        uint4 r; r.x = pk2(o[0], o[1]); r.y = pk2(o[2], o[3]); r.z = pk2(o[4], o[5]); r.w = pk2(o[6], o[7]);
        if (nsub >= 2368) { typedef unsigned u32x4_t __attribute__((ext_vector_type(4))); u32x4_t rv = {r.x, r.y, r.z, r.w}; __builtin_nontemporal_store(rv, (u32x4_t*)inproj_dst(ws, tok, nsub + cg * 8, false)); }
        else *(uint4*)inproj_dst(ws, tok, nsub + cg * 8, false) = r;
      } else {
        const int d = u & 31, rg = u >> 5; const float* s = st + (rg * 8) * ST_LD + sub * 32 + d;
        uint4 o; o.x = pk2(s[0], s[ST_LD]); o.y = pk2(s[2 * ST_LD], s[3 * ST_LD]); o.z = pk2(s[4 * ST_LD], s[5 * ST_LD]); o.w = pk2(s[6 * ST_LD], s[7 * ST_LD]);
        const int cc = nsub - (tseg == 0 ? 640 : (tseg == 1 ? 1984 : 2240)) + d;
        bf16* dst = (bf16*)(ws + (tseg == 0 ? O_VAT : (tseg == 1 ? O_VST : O_VWT))) + ((size_t)(bidx * 2 + (cc >> 6)) * 64 + (cc & 63)) * 2048 + (m0 & 2047) + rg * 8;
        *(uint4*)dst = o; }
    }
  }
}
DI void inproj_epilogue_m256(PR p, f32x16 (&acc)[4][2], int m0, int n0, float* st) {
  unsigned char* ws = p.ws;
  const int lane = threadIdx.x & 63, wave = threadIdx.x >> 6, wm = wave >> 1, wn = wave & 1, c = lane & 31, h4 = 4 * (lane >> 5);
#pragma unroll 1
  for (int h = 0; h < 2; ++h) {
    if (wm == h) {
#pragma unroll
      for (int ni = 0; ni < 2; ++ni) {
        const int nsub = n0 + wn * 64 + ni * 32;
        if (nsub >= NIN) continue;
#pragma unroll
        for (int mi = 0; mi < 4; ++mi) { float* bq = st + (mi * 32 + h4) * ST_LD + wn * 64 + ni * 32 + c;
#pragma unroll
          for (int r = 0; r < 16; ++r) bq[(8 * (r >> 2) + (r & 3)) * ST_LD] = acc[mi][ni][r]; }
      }
    }
    __syncthreads();
    inproj_copyout2(ws, st, m0 + h * 128, n0);
    __syncthreads();
  }
}
DI void ph_inproj(PR p, bf16* smem, int* ctrs, int* shv) {
  const int myx = xcc_id(); int off = 0, x, idx;
  while (shard_next(ctrs, myx, off, [](int) { return 560; }, shv, x, idx)) {
    const int g = idx / 280, rem = idx % 280, nt = rem >> 3, mt = x * 16 + g * 8 + (rem & 7), m0 = mt * 256, n0 = nt * 128;
    f32x16 acc[4][2];
#pragma unroll
    for (int mi = 0; mi < 4; ++mi)
#pragma unroll
      for (int r = 0; r < 16; ++r) { acc[mi][0][r] = 0.f; acc[mi][1][r] = 0.f; }
    ALBlk2 al{(const bf16*)(p.ws + O_U) + (size_t)m0 * 1024, 32};
    ALBlk bl{(const bf16*)(p.ws + O_WT_IN) + (size_t)n0 * 1024};
    gemm_mainloop_dma_m256(acc, al, bl, 32, (unsigned char*)smem);
    inproj_epilogue_m256(p, acc, m0, n0, (float*)smem);
  }
}

DI void idx_scores_item(PR p, int it, float* qs  ) {
  const int tok = it >> 3, kb = it & 7, t = tok & 2047, b = tok >> 11, s = kb * 256 + threadIdx.x;
  if (kb * 256 > t) return;
  qs[threadIdx.x] = bf2f(((const bf16*)(p.ws + O_QI))[(size_t)tok * 256 + threadIdx.x]);
  if (threadIdx.x < 8) qs[256 + threadIdx.x] = ((const float*)(p.ws + O_WI))[(size_t)tok * 8 + threadIdx.x];
  __syncthreads();
  if (s <= t) {
    const bf16* kr = (const bf16*)(p.ws + O_KI) + (size_t)(b * 2048 + s) * 32;
    float kf[32];
#pragma unroll
    for (int d8 = 0; d8 < 4; ++d8) { const uint4 u = *(const uint4*)(kr + d8 * 8);
      kf[d8 * 8 + 0] = __uint_as_float(u.x << 16); kf[d8 * 8 + 1] = __uint_as_float(u.x & 0xffff0000u); kf[d8 * 8 + 2] = __uint_as_float(u.y << 16); kf[d8 * 8 + 3] = __uint_as_float(u.y & 0xffff0000u);
      kf[d8 * 8 + 4] = __uint_as_float(u.z << 16); kf[d8 * 8 + 5] = __uint_as_float(u.z & 0xffff0000u); kf[d8 * 8 + 6] = __uint_as_float(u.w << 16); kf[d8 * 8 + 7] = __uint_as_float(u.w & 0xffff0000u); }
    float sc = 0.f;
#pragma unroll
    for (int h = 0; h < 8; ++h) { float dt = 0.f;
#pragma unroll
      for (int d = 0; d < 32; ++d) dt += qs[h * 32 + d] * kf[d];
      sc += qs[256 + h] * fmaxf(dt, 0.f); }
    ((float*)(p.ws + O_SC))[(size_t)tok * 2048 + s] = sc;
  }
  __syncthreads();
}

DI unsigned fkey(float f) { f += 0.f; unsigned u = __float_as_uint(f); return (u & 0x80000000u) ? ~u : (u | 0x80000000u); }
DI void select_row(const float* __restrict__ sc, int t, unsigned long long* __restrict__ mrow, unsigned* hist, int lane) {
  if (t < 256) {
    if (lane < 32) { int lo = lane * 64; unsigned long long w = (t >= lo + 63) ? ~0ull : (t < lo ? 0ull : ((2ull << (t - lo)) - 1ull)); mrow[lane] = w; }
    return;
  }
  unsigned key[32];
#pragma unroll
  for (int i = 0; i < 32; ++i) key[i] = __float_as_uint(sc[i * 64 + lane]);
#pragma unroll
  for (int i = 0; i < 32; ++i) { const int s = i * 64 + lane; const unsigned k = fkey(__uint_as_float(key[i])); key[i] = (s <= t) ? k : 0u; }
  unsigned prefix = 0; int krem = 256, cbin = 0;
#pragma unroll
  for (int pass = 0; pass < 4; ++pass) {
    const int shift = 24 - 8 * pass;
    const unsigned mhi = pass == 0 ? 0u : (0xFFFFFFFFu << (shift + 8));
#pragma unroll
    for (int z = 0; z < 16; ++z) hist[lane + 64 * z] = 0;
    __builtin_amdgcn_wave_barrier();
#pragma unroll
    for (int i = 0; i < 32; ++i) { unsigned k = key[i]; if (k != 0u && ((k ^ prefix) & mhi) == 0u) atomicAdd(&hist[(lane & 3) * 256 + ((k >> shift) & 255u)], 1u); }
    __builtin_amdgcn_wave_barrier();
    int c0 = 0, c1 = 0, c2 = 0, c3 = 0;
#pragma unroll
    for (int z = 0; z < 4; ++z) { const uint4 hv = *(const uint4*)(hist + z * 256 + 4 * lane); c0 += hv.x; c1 += hv.y; c2 += hv.z; c3 += hv.w; }
    __builtin_amdgcn_wave_barrier();
    const int tot = c0 + c1 + c2 + c3; int suf = tot;
#pragma unroll
    for (int o = 1; o < 64; o <<= 1) { int v = __shfl_down(suf, o); if (lane + o < 64) suf += v; }
    const int a3 = suf - tot, a2 = a3 + c3, a1 = a2 + c2, a0 = a1 + c1;
    int fj = -1, fa = 0, fc = 0;
    if (a3 < krem && krem <= a3 + c3) { fj = 3; fa = a3; fc = c3; }
    else if (a2 < krem && krem <= a2 + c2) { fj = 2; fa = a2; fc = c2; }
    else if (a1 < krem && krem <= a1 + c1) { fj = 1; fa = a1; fc = c1; }
    else if (a0 < krem && krem <= a0 + c0) { fj = 0; fa = a0; fc = c0; }
    const unsigned long long bal = __ballot(fj >= 0);
    const int fl = bal ? (__ffsll((long long)bal) - 1) : 0;
    const int pk_ = __shfl((fj << 28) | (fc << 14) | fa, fl);
    prefix |= (unsigned)(4 * fl + ((pk_ >> 28) & 3)) << shift;
    krem -= pk_ & 0x3fff; cbin = (pk_ >> 14) & 0x3fff;
    if (cbin == krem) break;
  }
  int running = 0; unsigned long long myw = 0ull;
  if (cbin == krem) {
#pragma unroll
    for (int i = 0; i < 32; ++i) { const unsigned long long bs = __ballot(key[i] >= prefix); if (lane == i) myw = bs; }
  } else
#pragma unroll
  for (int i = 0; i < 32; ++i) {
    const bool eq = key[i] == prefix;
    const unsigned long long be = __ballot(eq);
    const int rank = running + __popcll(be & ((1ull << lane) - 1ull));
    const bool sel = key[i] > prefix || (eq && rank < krem);
    running += __popcll(be);
    const unsigned long long bs = __ballot(sel);
    if (lane == i) myw = bs;
  }
  if (lane < 32) mrow[lane] = myw;
}

template <class Pred>
DI float attn_wave(const bf16* __restrict__ Kb, const bf16* __restrict__ Vt, float q, int s_lo, int s_hi, Pred pred, int lane) {
  float m = NEGF, l = 0.f, acc = 0.f;
  for (int s = s_lo; s <= s_hi; ++s) {
    if (!pred(s)) continue;
    float sc = wave_sum(q * bf2f(Kb[(size_t)s * 128 + lane])) * 0.125f;
    float mn = fmaxf(m, sc), corr = __expf(m - mn), pp = __expf(sc - mn);
    l = l * corr + pp; acc = acc * corr + pp * bf2f(Vt[(size_t)lane * 2048 + s]); m = mn;
  }
  return l > 0.f ? acc / l : 0.f;
}
DI void dsa_naive_wave(PR p, int wid, int lane) {
  const int tok = wid >> 3, h = wid & 7, g = h >> 2, b = tok >> 11, t = tok & 2047;
  const unsigned* mrow = (const unsigned*)(p.ws + O_DSAM) + (size_t)tok * 64;
  float q = bf2f(((const bf16*)(p.ws + O_QA))[(size_t)tok * 512 + h * 64 + lane]);
  float o = attn_wave((const bf16*)(p.ws + O_KA) + (size_t)b * 2048 * 128 + g * 64, (const bf16*)(p.ws + O_VAT) + (size_t)(b * 2 + g) * 64 * 2048, q, 0, t,
                      [&](int s) { return (mrow[s >> 5] >> (s & 31)) & 1u; }, lane);
  ((bf16*)(p.ws + O_OA))[(size_t)tok * 512 + h * 64 + lane] = f2bf(o);
}
DI void cmpattn_naive_wave(PR p, int wid, int lane, float* qsh  , float* psh  ) {
  const int tok = wid >> 1, g = wid & 1, b = tok >> 11, t = tok & 2047;
  const bf16* kcc = (const bf16*)(p.ws + O_KCC) + (size_t)(b * 2 + g) * 128 * 64;
  const bf16* vct = (const bf16*)(p.ws + O_VCCT) + (size_t)(b * 2 + g) * 64 * 128;
  const float* gn = (const float*)(p.ws + O_GN) + (size_t)tok * 24;
  const int c0 = lane, c1 = lane + 64;
  const bool v0 = (16 * c0 + 31) <= t, v1 = (c1 < 127) && ((16 * c1 + 31) <= t);
  float ps0 = 0.f, ps1 = 0.f;
  for (int r = 0; r < 4; ++r) {
    const int h = g * 4 + r;
    qsh[lane] = bf2f(((const bf16*)(p.ws + O_QBR))[(size_t)tok * 512 + h * 64 + lane]);
    __builtin_amdgcn_wave_barrier();
    float d0 = 0.f, d1 = 0.f;
    for (int d = 0; d < 64; ++d) { float qd = qsh[d]; d0 += qd * bf2f(kcc[c0 * 64 + d]); d1 += qd * bf2f(kcc[(c1 & 127) * 64 + d]); }
    float s0 = v0 ? d0 * 0.125f : NEGF, s1 = v1 ? d1 * 0.125f : NEGF;
    float m = wave_max(fmaxf(s0, s1));
    float e0 = v0 ? __expf(s0 - m) : 0.f, e1 = v1 ? __expf(s1 - m) : 0.f;
    float sum = wave_sum(e0 + e1), inv = 1.f / fmaxf(sum, 1e-30f);
    float p0 = e0 * inv, p1 = e1 * inv;
    ps0 += p0; ps1 += p1;
    float o = 0.f;
    for (int c = 0; c < 127; ++c) { float pc = __shfl(c < 64 ? p0 : p1, c & 63); o += pc * bf2f(vct[lane * 128 + c]); }
    ((bf16*)(p.ws + O_OCMP))[(size_t)tok * 512 + h * 64 + lane] = f2bf(gn[h * 3 + 0] * o);
    __builtin_amdgcn_wave_barrier();
  }
  psh[c0] = ps0; psh[c1] = ps1;
  __builtin_amdgcn_wave_barrier();
  const int j = lane & 31, cur = t >> 6;
  float imp = 0.f;
  for (int c = 4 * j - 1; c <= 4 * j + 3; ++c) if (c >= 0 && c < 127) imp += psh[c];
  const bool forced = (j == 0) || (cur - j >= 0 && cur - j < 2), causal = (j * 64) <= t;
  const float v = forced ? 1e9f : (causal ? imp : NEGF);
  int rank = 0;
  for (int i = 0; i < 32; ++i) { float vi = __shfl(v, i); rank += (vi > v || (vi == v && i < j)) ? 1 : 0; }
  const unsigned long long bal = __ballot(rank < 16);
  if (lane == 0) ((unsigned*)(p.ws + O_SELM))[(size_t)tok * 2 + g] = (unsigned)(bal & 0xFFFFFFFFull);
  __builtin_amdgcn_wave_barrier();
}
DI void selwin_naive_wave(PR p, int wid, int lane) {
  const int tok = wid >> 3, h = wid & 7, g = h >> 2, b = tok >> 11, t = tok & 2047;
  const unsigned sm = ((const unsigned*)(p.ws + O_SELM))[(size_t)tok * 2 + g];
  const float* gn = (const float*)(p.ws + O_GN) + (size_t)tok * 24;
  float q = bf2f(((const bf16*)(p.ws + O_QBT))[(size_t)tok * 512 + h * 64 + lane]);
  float os = attn_wave((const bf16*)(p.ws + O_KS) + (size_t)b * 2048 * 128 + g * 64, (const bf16*)(p.ws + O_VST) + (size_t)(b * 2 + g) * 64 * 2048, q, 0, t,
                       [&](int s) { return (sm >> (s >> 6)) & 1u; }, lane);
  int lo = t - 511; if (lo < 0) lo = 0;
  float ow = attn_wave((const bf16*)(p.ws + O_KW) + (size_t)b * 2048 * 128 + g * 64, (const bf16*)(p.ws + O_VWT) + (size_t)(b * 2 + g) * 64 * 2048, q, lo, t,
                       [&](int) { return true; }, lane);
  const size_t oi = (size_t)tok * 512 + h * 64 + lane;
  float oc = bf2f(((const bf16*)(p.ws + O_OCMP))[oi]);
  ((bf16*)(p.ws + O_OB))[oi] = f2bf(oc + gn[h * 3 + 1] * os + gn[h * 3 + 2] * ow);
}


constexpr int AT_ROW = 72;
constexpr int AT_TILE = 64 * AT_ROW;
template <int TY>
DI void attn_item(PR p, int b, int g, int qt, bf16* smem) {
  const int tid = threadIdx.x, lane = tid & 63, wave = tid >> 6, r = lane & 31, hh = lane >> 5;
  const int h = g * 4 + wave, t = qt * 32 + r, tok = b * 2048 + t;
  unsigned char* ws = p.ws;
  const bf16* Q = (const bf16*)(ws + (TY == 0 ? O_QA : O_QBT)) + (size_t)tok * 512 + h * 64;
  const bf16* K = (const bf16*)(ws + (TY == 0 ? O_KA : (TY == 1 ? O_KW : O_KS))) + (size_t)b * 2048 * 128 + g * 64;
  const bf16* VT = (const bf16*)(ws + (TY == 0 ? O_VAT : (TY == 1 ? O_VWT : O_VST))) + (size_t)(b * 2 + g) * 64 * 2048;
  bf16x8 qf[4];
#pragma unroll
  for (int ks = 0; ks < 4; ++ks) { const uint4 qu = *(const uint4*)(Q + ks * 16 + hh * 8); const float c1q = 0.125f * 1.4426950408889634f;
    uint4 qs; qs.x = pk2(__uint_as_float(qu.x << 16) * c1q, __uint_as_float(qu.x & 0xffff0000u) * c1q); qs.y = pk2(__uint_as_float(qu.y << 16) * c1q, __uint_as_float(qu.y & 0xffff0000u) * c1q);
    qs.z = pk2(__uint_as_float(qu.z << 16) * c1q, __uint_as_float(qu.z & 0xffff0000u) * c1q); qs.w = pk2(__uint_as_float(qu.w << 16) * c1q, __uint_as_float(qu.w & 0xffff0000u) * c1q);
    qf[ks] = __builtin_bit_cast(bf16x8, qs); }
  const int kt_hi = qt >> 1;
  const unsigned upto = (kt_hi == 31) ? 0xFFFFFFFFu : ((2u << kt_hi) - 1u);
  unsigned active = upto; unsigned sm = 0;
  if (TY == 1) { const int lo = qt * 32 - 511; const int kt_lo = lo > 0 ? (lo >> 6) : 0; active = upto & ~((1u << kt_lo) - 1u); }
  if (TY == 2) { sm = ((const unsigned*)(ws + O_SELM))[(size_t)tok * 2 + g]; unsigned o = sm;
#pragma unroll
    for (int off = 1; off < 32; off <<= 1) o |= (unsigned)__shfl_xor((int)o, off);
    active = (unsigned)__builtin_amdgcn_readfirstlane((int)o) & upto; }
  const unsigned* mrow = (const unsigned*)(ws + O_DSAM) + (size_t)tok * 64;
  const int srow = tid >> 3, skc = tid & 7;
  const bf16* kg0 = K + (size_t)srow * 128 + skc * 8;
  const bf16* vg0 = VT + (size_t)srow * 2048 + skc * 8;
  uint4 rk0, rk1, rv0, rv1;
#define AT_GLOAD(kt) { rk0 = *(const uint4*)(kg0 + (size_t)(kt) * 64 * 128); rk1 = *(const uint4*)(kg0 + (size_t)(kt) * 64 * 128 + 32 * 128); \
    rv0 = *(const uint4*)(vg0 + (kt) * 64); rv1 = *(const uint4*)(vg0 + (kt) * 64 + 32 * 2048); }
#define AT_LSTORE(buf) { bf16* Ks_ = smem + (buf) * 2 * AT_TILE; bf16* Vs_ = Ks_ + AT_TILE; \
    *(uint4*)(Ks_ + srow * AT_ROW + skc * 8) = rk0; *(uint4*)(Ks_ + (srow + 32) * AT_ROW + skc * 8) = rk1; \
    *(uint4*)(Vs_ + srow * AT_ROW + skc * 8) = rv0; *(uint4*)(Vs_ + (srow + 32) * AT_ROW + skc * 8) = rv1; }
  f32x16 o0, o1;
#pragma unroll
  for (int i = 0; i < 16; ++i) { o0[i] = 0.f; o1[i] = 0.f; }
  float mrun = NEGF, lrun = 0.f;
  const float c1 = 0.125f * 1.4426950408889634f;
  unsigned rem = active; int buf = 0;
  int kt = __builtin_ctz(rem); rem &= rem - 1;
  __syncthreads();
  AT_GLOAD(kt); AT_LSTORE(0); __syncthreads();
  for (;;) {
    const int ktn = rem ? __builtin_ctz(rem) : -1;
    if (ktn >= 0) AT_GLOAD(ktn);
    const bf16* Ks = smem + buf * 2 * AT_TILE; const bf16* Vs = Ks + AT_TILE;
    f32x16 s0, s1;
#pragma unroll
    for (int i = 0; i < 16; ++i) { s0[i] = 0.f; s1[i] = 0.f; }
#pragma unroll
    for (int ks = 0; ks < 4; ++ks) {
      const bf16x8 a0 = *(const bf16x8*)(Ks + r * AT_ROW + ks * 16 + hh * 8), a1 = *(const bf16x8*)(Ks + (32 + r) * AT_ROW + ks * 16 + hh * 8);
      s0 = __builtin_amdgcn_mfma_f32_32x32x16_bf16(a0, qf[ks], s0, 0, 0, 0);
      s1 = __builtin_amdgcn_mfma_f32_32x32x16_bf16(a1, qf[ks], s1, 0, 0, 0);
    }
    const int kbase = kt * 64 + 4 * hh;
    unsigned w0 = 0, w1 = 0;
    if (TY == 0) {
      const uint2 mw = *(const uint2*)(mrow + kt * 2);
      w0 = mw.x >> (4 * hh); w1 = mw.y >> (4 * hh);
    } else if (TY == 1) {
      const bool full = (kt * 64 + 63 <= qt * 32) && (kt * 64 >= qt * 32 + 31 - 511);
      if (!full) {
#pragma unroll
        for (int i = 0; i < 16; ++i) { const int k0 = kbase + 8 * (i >> 2) + (i & 3), k1 = k0 + 32;
          s0[i] = (k0 <= t && k0 > t - 512) ? s0[i] : NEGF; s1[i] = (k1 <= t && k1 > t - 512) ? s1[i] : NEGF; }
      }
    } else {
      const bool bsel = (sm >> kt) & 1u;
      const bool interior = kt * 64 + 63 <= qt * 32;
      if (interior) {
        if (!__all(bsel)) {
#pragma unroll
          for (int i = 0; i < 16; ++i) { s0[i] = bsel ? s0[i] : NEGF; s1[i] = bsel ? s1[i] : NEGF; }
        }
      } else {
#pragma unroll
        for (int i = 0; i < 16; ++i) { const int k0 = kbase + 8 * (i >> 2) + (i & 3), k1 = k0 + 32;
          s0[i] = (bsel && k0 <= t) ? s0[i] : NEGF; s1[i] = (bsel && k1 <= t) ? s1[i] : NEGF; }
      }
    }
    float mx = s0[0];
#pragma unroll
    for (int i = 1; i < 16; ++i) mx = fmaxf(mx, s0[i]);
#pragma unroll
    for (int i = 0; i < 16; ++i) mx = fmaxf(mx, s1[i]);
    mx = fmaxf(mx, __shfl_xor(mx, 32));
    const float mnew = fmaxf(mrun, mx);
    const float muse = (mnew == NEGF) ? 0.f : mnew;
    const float corr = __builtin_amdgcn_exp2f(mrun - mnew);
    mrun = mnew;
    float ls = 0.f;
#pragma unroll
    for (int i = 0; i < 16; ++i) { s0[i] = __builtin_amdgcn_exp2f(s0[i] - muse); s1[i] = __builtin_amdgcn_exp2f(s1[i] - muse); }
    if (TY == 0) {
#pragma unroll
      for (int i = 0; i < 16; ++i) { const int bit = 8 * (i >> 2) + (i & 3);
        s0[i] = __uint_as_float(__float_as_uint(s0[i]) & (unsigned)__builtin_amdgcn_sbfe((int)w0, bit, 1)); s1[i] = __uint_as_float(__float_as_uint(s1[i]) & (unsigned)__builtin_amdgcn_sbfe((int)w1, bit, 1)); }
    }
#pragma unroll
    for (int i = 0; i < 16; ++i) ls += s0[i] + s1[i];
    lrun = lrun * corr + ls;
    if (__any(corr != 1.f)) {
#pragma unroll
      for (int i = 0; i < 16; ++i) { o0[i] *= corr; o1[i] *= corr; }
    }
#pragma unroll
    for (int mt = 0; mt < 2; ++mt)
#pragma unroll
      for (int sp = 0; sp < 2; ++sp) {
        uint4 pu;
        if (mt == 0) { pu.x = pk2(s0[8 * sp], s0[8 * sp + 1]); pu.y = pk2(s0[8 * sp + 2], s0[8 * sp + 3]); pu.z = pk2(s0[8 * sp + 4], s0[8 * sp + 5]); pu.w = pk2(s0[8 * sp + 6], s0[8 * sp + 7]); }
        else { pu.x = pk2(s1[8 * sp], s1[8 * sp + 1]); pu.y = pk2(s1[8 * sp + 2], s1[8 * sp + 3]); pu.z = pk2(s1[8 * sp + 4], s1[8 * sp + 5]); pu.w = pk2(s1[8 * sp + 6], s1[8 * sp + 7]); }
        const bf16x8 pb = __builtin_bit_cast(bf16x8, pu);
        const int kc = mt * 32 + 16 * sp + 4 * hh;
        uint4 vu;
        { const uint2 lo = *(const uint2*)(Vs + r * AT_ROW + kc), hi = *(const uint2*)(Vs + r * AT_ROW + kc + 8); vu.x = lo.x; vu.y = lo.y; vu.z = hi.x; vu.w = hi.y; }
        o0 = __builtin_amdgcn_mfma_f32_32x32x16_bf16(__builtin_bit_cast(bf16x8, vu), pb, o0, 0, 0, 0);
        { const uint2 lo = *(const uint2*)(Vs + (32 + r) * AT_ROW + kc), hi = *(const uint2*)(Vs + (32 + r) * AT_ROW + kc + 8); vu.x = lo.x; vu.y = lo.y; vu.z = hi.x; vu.w = hi.y; }
        o1 = __builtin_amdgcn_mfma_f32_32x32x16_bf16(__builtin_bit_cast(bf16x8, vu), pb, o1, 0, 0, 0);
      }
    if (ktn < 0) break;
    AT_LSTORE(buf ^ 1);
    __syncthreads();
    buf ^= 1; kt = ktn; rem &= rem - 1;
  }
#undef AT_GLOAD
#undef AT_LSTORE
  const float ltot = lrun + __shfl_xor(lrun, 32);
  float inv = ltot > 0.f ? 1.f / ltot : 0.f;
  const float* gn = (const float*)(ws + O_GN) + (size_t)tok * 24 + h * 3;
  if (TY == 1) inv *= gn[2];
  if (TY == 2) inv *= gn[1];
  const size_t ob = (size_t)tok * 512 + h * 64 + 4 * hh;
  bf16* dst = (bf16*)(ws + (TY == 0 ? O_OA : (TY == 1 ? O_OWIN : O_OB))) + ob;
#pragma unroll
  for (int dt = 0; dt < 2; ++dt)
#pragma unroll
    for (int q = 0; q < 4; ++q) {
      float v0, v1, v2, v3;
      if (dt == 0) { v0 = o0[4 * q] * inv; v1 = o0[4 * q + 1] * inv; v2 = o0[4 * q + 2] * inv; v3 = o0[4 * q + 3] * inv; }
      else { v0 = o1[4 * q] * inv; v1 = o1[4 * q + 1] * inv; v2 = o1[4 * q + 2] * inv; v3 = o1[4 * q + 3] * inv; }
      if (TY == 2) {
        const uint2 a = *(const uint2*)((const bf16*)(ws + O_OCMP) + ob + dt * 32 + 8 * q), w = *(const uint2*)((const bf16*)(ws + O_OWIN) + ob + dt * 32 + 8 * q);
        v0 += __uint_as_float(a.x << 16) + __uint_as_float(w.x << 16); v1 += __uint_as_float(a.x & 0xffff0000u) + __uint_as_float(w.x & 0xffff0000u);
        v2 += __uint_as_float(a.y << 16) + __uint_as_float(w.y << 16); v3 += __uint_as_float(a.y & 0xffff0000u) + __uint_as_float(w.y & 0xffff0000u);
      }
      uint2 o; o.x = pk2(v0, v1); o.y = pk2(v2, v3);
      *(uint2*)(dst + dt * 32 + 8 * q) = o;
    }
}


DI void idx_item(PR p, int b, int qt, unsigned char* lds) {
  int tid = threadIdx.x; asm volatile("" : "+v"(tid));
  const int lane = tid & 63, wave = tid >> 6, r = lane & 31, hh = lane >> 5;
  unsigned char* ws = p.ws;
  const int t = qt * 32 + r, tok = b * 2048 + t;
  if (qt >= 8) {
    const bf16* Qi = (const bf16*)(ws + O_QI) + (size_t)tok * 256;
    bf16x8 qf[8][2];
#pragma unroll
    for (int h = 0; h < 8; ++h) { qf[h][0] = *(const bf16x8*)(Qi + h * 32 + hh * 8); qf[h][1] = *(const bf16x8*)(Qi + h * 32 + 16 + hh * 8); }
    const f32x4 wa = *(const f32x4*)((const float*)(ws + O_WI) + (size_t)tok * 8), wb = *(const f32x4*)((const float*)(ws + O_WI) + (size_t)tok * 8 + 4);
    const bf16* Ki = (const bf16*)(ws + O_KI) + (size_t)b * 2048 * 32;
    float* SCr = (float*)(ws + O_SC) + (size_t)tok * 2048 + 4 * hh;
#pragma unroll 1
    for (int kt = wave; kt <= qt; kt += 4) {
      const bf16* kr = Ki + (size_t)(kt * 32 + r) * 32 + hh * 8;
      const bf16x8 a0 = *(const bf16x8*)kr, a1 = *(const bf16x8*)(kr + 16);
      f32x16 sc;
#pragma unroll
      for (int i = 0; i < 16; ++i) sc[i] = 0.f;
#pragma unroll
      for (int h = 0; h < 8; ++h) {
        f32x16 s;
#pragma unroll
        for (int i = 0; i < 16; ++i) s[i] = 0.f;
        s = __builtin_amdgcn_mfma_f32_32x32x16_bf16(a0, qf[h][0], s, 0, 0, 0);
        s = __builtin_amdgcn_mfma_f32_32x32x16_bf16(a1, qf[h][1], s, 0, 0, 0);
        const float w = h < 4 ? wa[h & 3] : wb[h & 3];
#pragma unroll
        for (int i = 0; i < 16; ++i) { float t_ = sc[i] + w * fmaxf(s[i], 0.f); asm volatile("" : "+v"(t_)); sc[i] = t_; }
      }
#pragma unroll
      for (int q = 0; q < 4; ++q) { f32x4 o = {sc[4 * q], sc[4 * q + 1], sc[4 * q + 2], sc[4 * q + 3]}; *(f32x4*)(SCr + kt * 32 + 8 * q) = o; }
    }
    __threadfence_block();
  }
  __syncthreads();
#pragma unroll 1
  for (int i = 0; i < 8; ++i) { const int row = qt * 32 + wave * 8 + i, tk = b * 2048 + row;
    select_row((const float*)(ws + O_SC) + (size_t)tk * 2048, row, (unsigned long long*)(ws + O_DSAM) + (size_t)tk * 32, (unsigned*)lds + wave * 1024, lane); }
}

constexpr int CM_VROW = 136;
DI void cmp_item(PR p, int b, int g, int qt, unsigned char* lds) {
  const int tid = threadIdx.x, lane = tid & 63, wave = tid >> 6, r = lane & 31, hh = lane >> 5;
  unsigned char* ws = p.ws;
  const int h = g * 4 + wave, t = qt * 32 + r, tok = b * 2048 + t;
  bf16* Ks = (bf16*)lds;
  bf16* Vs = Ks + 128 * AT_ROW;
  float* imps = (float*)(Vs + 64 * CM_VROW);
  const bf16* Kg = (const bf16*)(ws + O_KCC) + (size_t)(b * 2 + g) * 128 * 64;
  const bf16* Vg = (const bf16*)(ws + O_VCCT) + (size_t)(b * 2 + g) * 64 * 128;
  __syncthreads();
#pragma unroll
  for (int i = 0; i < 4; ++i) { const int c = tid + 256 * i; { const int row = c >> 3, kc = c & 7; *(uint4*)(Ks + row * AT_ROW + kc * 8) = *(const uint4*)(Kg + row * 64 + kc * 8); }
    { const int row = c >> 4, kc = c & 15; *(uint4*)(Vs + row * CM_VROW + kc * 8) = *(const uint4*)(Vg + row * 128 + kc * 8); } }
  const bf16* Q = (const bf16*)(ws + O_QBR) + (size_t)tok * 512 + h * 64;
  bf16x8 qf[4];
#pragma unroll
  for (int ks = 0; ks < 4; ++ks) qf[ks] = *(const bf16x8*)(Q + ks * 16 + hh * 8);
  __syncthreads();
  f32x16 s[4];
#pragma unroll
  for (int mt = 0; mt < 4; ++mt) {
#pragma unroll
    for (int i = 0; i < 16; ++i) s[mt][i] = 0.f;
#pragma unroll
    for (int ks = 0; ks < 4; ++ks) { const bf16x8 a = *(const bf16x8*)(Ks + (mt * 32 + r) * AT_ROW + ks * 16 + hh * 8); s[mt] = __builtin_amdgcn_mfma_f32_32x32x16_bf16(a, qf[ks], s[mt], 0, 0, 0); }
    if (mt & 1) __builtin_amdgcn_sched_barrier(0);
  }
  const float c1 = 0.125f * 1.4426950408889634f;
  float mx = NEGF;
  int cthr = (t - 31) >> 4; cthr = (cthr > 126 ? 126 : cthr) - 4 * hh;
#pragma unroll
  for (int mt = 0; mt < 4; ++mt)
#pragma unroll
    for (int i = 0; i < 16; ++i) { const bool ok = (mt * 32 + 8 * (i >> 2) + (i & 3)) <= cthr; s[mt][i] = ok ? s[mt][i] * c1 : NEGF; mx = fmaxf(mx, s[mt][i]); }
  mx = fmaxf(mx, __shfl_xor(mx, 32));
  const float muse = (mx == NEGF) ? 0.f : mx;
  float ls = 0.f;
#pragma unroll
  for (int mt = 0; mt < 4; ++mt)
#pragma unroll
    for (int i = 0; i < 16; ++i) { s[mt][i] = __builtin_amdgcn_exp2f(s[mt][i] - muse); ls += s[mt][i]; }
  ls += __shfl_xor(ls, 32);
  const float inv = 1.f / fmaxf(ls, 1e-30f);
#pragma unroll
  for (int mt = 0; mt < 4; ++mt)
#pragma unroll
    for (int i = 0; i < 16; ++i) s[mt][i] *= inv;
  f32x16 o0, o1;
#pragma unroll
  for (int i = 0; i < 16; ++i) { o0[i] = 0.f; o1[i] = 0.f; }
#pragma unroll
  for (int mt = 0; mt < 4; ++mt)
#pragma unroll
    for (int sp = 0; sp < 2; ++sp) {
      uint4 pu; pu.x = pk2(s[mt][8 * sp], s[mt][8 * sp + 1]); pu.y = pk2(s[mt][8 * sp + 2], s[mt][8 * sp + 3]); pu.z = pk2(s[mt][8 * sp + 4], s[mt][8 * sp + 5]); pu.w = pk2(s[mt][8 * sp + 6], s[mt][8 * sp + 7]);
      const bf16x8 pb = __builtin_bit_cast(bf16x8, pu);
      const int kc = mt * 32 + 16 * sp + 4 * hh;
      uint4 vu;
      { const uint2 lo = *(const uint2*)(Vs + r * CM_VROW + kc), hi = *(const uint2*)(Vs + r * CM_VROW + kc + 8); vu.x = lo.x; vu.y = lo.y; vu.z = hi.x; vu.w = hi.y; }
      o0 = __builtin_amdgcn_mfma_f32_32x32x16_bf16(__builtin_bit_cast(bf16x8, vu), pb, o0, 0, 0, 0);
      { const uint2 lo = *(const uint2*)(Vs + (32 + r) * CM_VROW + kc), hi = *(const uint2*)(Vs + (32 + r) * CM_VROW + kc + 8); vu.x = lo.x; vu.y = lo.y; vu.z = hi.x; vu.w = hi.y; }
      o1 = __builtin_amdgcn_mfma_f32_32x32x16_bf16(__builtin_bit_cast(bf16x8, vu), pb, o1, 0, 0, 0);
      if (sp) __builtin_amdgcn_sched_barrier(0);
    }
  { const float g0 = ((const float*)(ws + O_GN))[(size_t)tok * 24 + h * 3];
    bf16* dst = (bf16*)(ws + O_OCMP) + (size_t)tok * 512 + h * 64 + 4 * hh;
#pragma unroll
    for (int q = 0; q < 4; ++q) { uint2 o; o.x = pk2(o0[4 * q] * g0, o0[4 * q + 1] * g0); o.y = pk2(o0[4 * q + 2] * g0, o0[4 * q + 3] * g0); *(uint2*)(dst + 8 * q) = o;
      o.x = pk2(o1[4 * q] * g0, o1[4 * q + 1] * g0); o.y = pk2(o1[4 * q + 2] * g0, o1[4 * q + 3] * g0); *(uint2*)(dst + 32 + 8 * q) = o; } }
  float* myimp = imps + (wave * 32 + r) * 33;
  float prevlast = 0.f;
#pragma unroll
  for (int mt = 0; mt < 4; ++mt)
#pragma unroll
    for (int q = 0; q < 4; ++q) {
      const float qs = (s[mt][4 * q] + s[mt][4 * q + 1]) + (s[mt][4 * q + 2] + s[mt][4 * q + 3]);
      const float other = __shfl_xor(s[mt][4 * q + 3], 32);
      const float prev = hh ? other : prevlast;
      myimp[mt * 8 + 2 * q + hh] = qs + prev;
      prevlast = other;
    }
  __syncthreads();
  {
    const int qq = tid >> 3, j0 = (tid & 7) * 4, tq = qt * 32 + qq, cur = tq >> 6;
    float v[4];
#pragma unroll
    for (int i = 0; i < 4; ++i) { const int j = j0 + i; const float im = (imps[(0 * 32 + qq) * 33 + j] + imps[(1 * 32 + qq) * 33 + j]) + (imps[(2 * 32 + qq) * 33 + j] + imps[(3 * 32 + qq) * 33 + j]);
      const bool forced = (j == 0) || (cur - j >= 0 && cur - j < 2), causal = (j * 64) <= tq; v[i] = forced ? 1e9f : (causal ? im : NEGF); }
    __syncthreads();
    float* vv = imps + qq * 33;
#pragma unroll
    for (int i = 0; i < 4; ++i) vv[j0 + i] = v[i];
    __syncthreads();
    unsigned bits = 0;
#pragma unroll
    for (int i = 0; i < 4; ++i) { const int j = j0 + i; int rank = 0;
      for (int k = 0; k < 32; ++k) { const float vk = vv[k]; rank += (vk > v[i] || (vk == v[i] && k < j)) ? 1 : 0; }
      if (rank < 16) bits |= 1u << j; }
    bits |= (unsigned)__shfl_xor((int)bits, 1); bits |= (unsigned)__shfl_xor((int)bits, 2); bits |= (unsigned)__shfl_xor((int)bits, 4);
    if ((tid & 7) == 0) ((unsigned*)(ws + O_SELM))[(size_t)(b * 2048 + tq) * 2 + g] = bits;
  }
}

DI float gelu_tanh(float x) { float u = 0.7978845608028654f * (x + 0.044715f * x * x * x); return 0.5f * x * (1.f + tanhf(u)); }
DI void cmp1_tile(PR p, int it, bf16* smem) {
  const int which = it >> 6, bg = (it >> 1) & 31, nt = it & 1, n0 = nt * 128;
  const int lane = threadIdx.x & 63, wave = threadIdx.x >> 6, wm = wave >> 1, wn = wave & 1;
  f32x16 acc[2][2]; acc_zero(acc);
  ALPlain al{(const bf16*)(p.ws + (which ? O_VC : O_KC)) + (size_t)bg * 2048 * 64, 1024};
  ALPlain bl{(const bf16*)(p.ws + (which ? O_WT_C1V : O_WT_C1K)) + (size_t)n0 * 2048, 2048};
  gemm_mainloop_dma(acc, al, bl, 64, (unsigned char*)smem);
  const float* cb = (const float*)(p.ws + O_CMPB) + which * 32 * 256;
  bf16* H1 = (bf16*)(p.ws + O_H1) + ((size_t)which * 4096 + bg * 128) * 256;
#pragma unroll
  for (int ni = 0; ni < 2; ++ni) {
    const int n = n0 + wn * 64 + ni * 32 + (lane & 31);
    float bias = 0.f;
    for (int kc = 0; kc < 32; ++kc) bias += cb[kc * 256 + n];
#pragma unroll
    for (int mi = 0; mi < 2; ++mi) { float v[16];
#pragma unroll
      for (int r = 0; r < 16; ++r) v[r] = gelu_tanh(acc[mi][ni][r] + bias);
      st16_bf16(H1 + (size_t)(wm * 64 + mi * 32 + 4 * (lane >> 5)) * 256 + n, 256, v); }
  }
}
DI void cmp2_tile(PR p, int it, bf16* smem) {
  const int which = it >> 5, bg = it & 31;
  const int lane = threadIdx.x & 63, wave = threadIdx.x >> 6, wm = wave >> 1, wn = wave & 1;
  f32x16 acc[2][2]; acc_zero(acc);
  ALPlain al{(const bf16*)(p.ws + O_H1) + ((size_t)which * 4096 + bg * 128) * 256, 256};
  ALPlain bl{(const bf16*)(p.ws + (which ? O_WT_C2V : O_WT_C2K)), 256};
  gemm_mainloop_dma(acc, al, bl, 8, (unsigned char*)smem);
  if (wn == 0) {
#pragma unroll
    for (int ni = 0; ni < 2; ++ni) { const int d = ni * 32 + (lane & 31);
#pragma unroll
      for (int mi = 0; mi < 2; ++mi) { const int c0 = wm * 64 + mi * 32 + 4 * (lane >> 5); float v[16];
#pragma unroll
        for (int r = 0; r < 16; ++r) v[r] = (c0 + 8 * (r >> 2) + (r & 3)) < 127 ? acc[mi][ni][r] : 0.f;
        if (which == 0) st16_bf16((bf16*)(p.ws + O_KCC) + ((size_t)bg * 128 + c0) * 64 + d, 64, v);
        else { bf16* d_ = (bf16*)(p.ws + O_VCCT) + ((size_t)bg * 64 + d) * 128 + c0; asm volatile("" : "+v"(d_));
#pragma unroll
          for (int q = 0; q < 4; ++q) { uint2 o_; o_.x = pk2(v[4 * q], v[4 * q + 1]); o_.y = pk2(v[4 * q + 2], v[4 * q + 3]); *(uint2*)(d_ + 8 * q) = o_; } } } }
  }
}

DI void merge_tile(PR p, int it, bf16* smem) {
  const int nt = it >> 8, mt = it & 255, m0 = mt * 128, n0 = nt * 128;
  const int lane = threadIdx.x & 63, wave = threadIdx.x >> 6, wm = wave >> 1, wn = wave & 1;
  f32x16 acc[2][2], acb[2][2]; acc_zero(acc); acc_zero(acb);
  { ALPlain al{(const bf16*)(p.ws + O_OA) + (size_t)m0 * 512, 512}; ALPlain bl{(const bf16*)(p.ws + O_WT_BRA) + (size_t)n0 * 512, 512}; gemm_mainloop_dma(acc, al, bl, 16, (unsigned char*)smem); }
  { ALPlain al{(const bf16*)(p.ws + O_OB) + (size_t)m0 * 512, 512}; ALPlain bl{(const bf16*)(p.ws + O_WT_BRB) + (size_t)n0 * 512, 512}; gemm_mainloop_dma(acb, al, bl, 16, (unsigned char*)smem); }
  bf16* tA = smem; bf16* tB = smem + 128 * 136;
  { const int c = lane & 31, h4 = 4 * (lane >> 5);
#pragma unroll
    for (int mi = 0; mi < 2; ++mi)
#pragma unroll
      for (int ni = 0; ni < 2; ++ni) { const int o = (wm * 64 + mi * 32 + h4) * 136 + wn * 64 + ni * 32 + c;
#pragma unroll
        for (int r = 0; r < 16; ++r) { const int oo = o + (8 * (r >> 2) + (r & 3)) * 136; tA[oo] = (bf16)pk2(acc[mi][ni][r], 0.f); tB[oo] = (bf16)pk2(acb[mi][ni][r], 0.f); } } }
  __syncthreads();
  const bf16* SGA = (const bf16*)(p.ws + O_SGA); const bf16* SGB = (const bf16*)(p.ws + O_SGB); bf16* M = (bf16*)(p.ws + O_MERGED);
#pragma unroll 2
  for (int j = 0; j < 8; ++j) { const int u = threadIdx.x + 256 * j, row = u >> 4, cg = u & 15;
    const size_t o = (size_t)(m0 + row) * 1024 + n0 + cg * 8;
    const uint4 a = *(const uint4*)(tA + row * 136 + cg * 8), bq = *(const uint4*)(tB + row * 136 + cg * 8), ga = __builtin_bit_cast(uint4, NT_LD16(SGA + o)), gb = __builtin_bit_cast(uint4, NT_LD16(SGB + o));
#define MG(av, bv, gav, gbv, out) { const float lo_ = __uint_as_float(gav << 16) * __uint_as_float(av << 16) + __uint_as_float(gbv << 16) * __uint_as_float(bv << 16); \
      const float hi_ = __uint_as_float(gav & 0xffff0000u) * __uint_as_float(av & 0xffff0000u) + __uint_as_float(gbv & 0xffff0000u) * __uint_as_float(bv & 0xffff0000u); out = pk2(lo_, hi_); }
    uint4 r; MG(a.x, bq.x, ga.x, gb.x, r.x) MG(a.y, bq.y, ga.y, gb.y, r.y) MG(a.z, bq.z, ga.z, gb.z, r.z) MG(a.w, bq.w, ga.w, gb.w, r.w)
#undef MG
    *(uint4*)(M + o) = r; }
}
DI void out_tile(PR p, int it, bf16* smem) {
  const int nt = it >> 7, mt = it & 127, m0 = mt * 256, n0 = nt * 128;
  const int lane = threadIdx.x & 63, wave = threadIdx.x >> 6, wm = wave >> 1, wn = wave & 1;
  f32x16 acc[4][2];
#pragma unroll
  for (int mi = 0; mi < 4; ++mi)
#pragma unroll
    for (int r = 0; r < 16; ++r) { acc[mi][0][r] = 0.f; acc[mi][1][r] = 0.f; }
  ALPlain al{(const bf16*)(p.ws + O_MERGED) + (size_t)m0 * 1024, 1024}; ALPlain bl{(const bf16*)(p.ws + O_WT_OUT) + (size_t)n0 * 1024, 1024};
  gemm_mainloop_dma_m256(acc, al, bl, 32, (unsigned char*)smem);
  const float* g1 = (const float*)(p.ws + O_MOD) + (m0 >> 11) * 6144 + 2048 + n0; float* Y = (float*)(p.ws + O_Y);
  float* st = (float*)smem;
#pragma unroll 1
  for (int h = 0; h < 2; ++h) {
    if (wm == h) {
#pragma unroll
      for (int mi = 0; mi < 4; ++mi)
#pragma unroll
        for (int ni = 0; ni < 2; ++ni) { float* bq = st + (mi * 32 + 4 * (lane >> 5)) * ST_LD + wn * 64 + ni * 32 + (lane & 31);
#pragma unroll
          for (int r = 0; r < 16; ++r) bq[(8 * (r >> 2) + (r & 3)) * ST_LD] = acc[mi][ni][r]; }
    }
    __syncthreads();
#pragma unroll 4
    for (int j = 0; j < 16; ++j) { const int u = threadIdx.x + 256 * j, row = u >> 5, c4 = u & 31;
      const size_t o = (size_t)(m0 + h * 128 + row) * 1024 + n0 + c4 * 4;
      const f32x4 a = *(const f32x4*)(st + row * ST_LD + c4 * 4), xv = __builtin_nontemporal_load((const f32x4*)(p.x + o)), gv = *(const f32x4*)(g1 + c4 * 4);
      f32x4 y; y[0] = DN_ALPHA * xv[0] + gv[0] * a[0]; y[1] = DN_ALPHA * xv[1] + gv[1] * a[1]; y[2] = DN_ALPHA * xv[2] + gv[2] * a[2]; y[3] = DN_ALPHA * xv[3] + gv[3] * a[3];
      *(f32x4*)(Y + o) = y; }
    __syncthreads();
  }
}

DI void ln1_row(PR p, int tok, int lane) {
  const int b = tok >> 11;
  const float4* yr = (const float4*)((const float*)(p.ws + O_Y) + (size_t)tok * 1024);
  float4 v[4]; float s = 0.f;
#pragma unroll
  for (int j = 0; j < 4; ++j) { const f32x4 yv = __builtin_nontemporal_load((const f32x4*)yr + lane + 64 * j); v[j].x = yv[0]; v[j].y = yv[1]; v[j].z = yv[2]; v[j].w = yv[3]; s += (v[j].x + v[j].y) + (v[j].z + v[j].w); }
  const float mean = wave_sum(s) * (1.f / 1024.f); float s2 = 0.f;
#pragma unroll
  for (int j = 0; j < 4; ++j) { v[j].x -= mean; v[j].y -= mean; v[j].z -= mean; v[j].w -= mean; s2 += (v[j].x * v[j].x + v[j].y * v[j].y) + (v[j].z * v[j].z + v[j].w * v[j].w); }
  const float rstd = 1.f / sqrtf(wave_sum(s2) * (1.f / 1024.f) + LN_EPS);
  const float* mod = (const float*)(p.ws + O_MOD) + b * 6144;
  float* X1 = (float*)(p.ws + O_X1) + (size_t)tok * 1024; bf16* HH = (bf16*)(p.ws + O_HHI) + (size_t)tok * 1024; bf16* HL = (bf16*)(p.ws + O_HLO) + (size_t)tok * 1024;
#pragma unroll
  for (int j = 0; j < 4; ++j) {
    const int col = (lane + 64 * j) * 4;
    const float4 g = *(const float4*)(p.ln1_g + col), bb = *(const float4*)(p.ln1_b + col);
    const float4 sh = *(const float4*)(mod + 3072 + col), sc = *(const float4*)(mod + 4096 + col);
    float4 x1; x1.x = v[j].x * rstd * g.x + bb.x; x1.y = v[j].y * rstd * g.y + bb.y; x1.z = v[j].z * rstd * g.z + bb.z; x1.w = v[j].w * rstd * g.w + bb.w;
    { f32x4 xo = {x1.x, x1.y, x1.z, x1.w}; __builtin_nontemporal_store(xo, (f32x4*)(X1 + col)); }
    const float h0 = x1.x * (1.f + sc.x) + sh.x, h1 = x1.y * (1.f + sc.y) + sh.y, h2 = x1.z * (1.f + sc.z) + sh.z, h3 = x1.w * (1.f + sc.w) + sh.w;
    ushort4 hi, lo;
    hi.x = f2bf(h0); hi.y = f2bf(h1); hi.z = f2bf(h2); hi.w = f2bf(h3);
    lo.x = f2bf(h0 - bf2f(hi.x)); lo.y = f2bf(h1 - bf2f(hi.y)); lo.z = f2bf(h2 - bf2f(hi.z)); lo.w = f2bf(h3 - bf2f(hi.w));
    *(ushort4*)(HH + col) = hi; { typedef unsigned u32x2_t __attribute__((ext_vector_type(2))); u32x2_t lv = {(unsigned)lo.x | ((unsigned)lo.y << 16), (unsigned)lo.z | ((unsigned)lo.w << 16)}; __builtin_nontemporal_store(lv, (u32x2_t*)(HL + col)); }
  }
}

DI void router_tile(PR p, int it, bf16* smem) {
  const int nt = it >> 8, mt = it & 255, m0 = mt * 128, n0 = nt * 128;
  const int lane = threadIdx.x & 63, wave = threadIdx.x >> 6, wm = wave >> 1, wn = wave & 1;
  f32x16 acc[2][2]; acc_zero(acc);
  ALRouter al{(const bf16*)(p.ws + O_HHI) + (size_t)m0 * 1024}; BLRouterB bl{(const bf16*)(p.ws + O_WT_RT) + (size_t)n0 * 2048};
  gemm_mainloop_dma(acc, al, bl, 96, (unsigned char*)smem);
  float* L = (float*)(p.ws + O_LOGITS);
  float* st = (float*)smem; stage_acc(st, acc);
  __syncthreads();
#pragma unroll 4
  for (int j = 0; j < 16; ++j) { const int u = threadIdx.x + 256 * j, row = u >> 5, c4 = u & 31;
    __builtin_nontemporal_store(*(const f32x4*)(st + row * ST_LD + c4 * 4), (f32x4*)(L + (size_t)(m0 + row) * 256 + n0 + c4 * 4)); }
}
DI void gateup_store(f32x16 (&acc)[2][2], bf16* dst  , int nvalid, int hc0, float* st) {
  const int lane = threadIdx.x & 63, wave = threadIdx.x >> 6, wm = wave >> 1, wn = wave & 1;
#pragma unroll
  for (int mi = 0; mi < 2; ++mi) {
    float* b = st + (wm * 64 + mi * 32 + 4 * (lane >> 5)) * 68 + wn * 32 + (lane & 31);
#pragma unroll
    for (int r = 0; r < 16; ++r) b[(8 * (r >> 2) + (r & 3)) * 68] = siluf_(acc[mi][0][r]) * acc[mi][1][r]; }
  __syncthreads();
#pragma unroll
  for (int j = 0; j < 4; ++j) { const int u = threadIdx.x + 256 * j, row = u >> 3, cg = u & 7;
    if (row < nvalid) *(uint4*)(dst + (size_t)row * 256 + hc0 + cg * 8) = pack8(st + row * 68 + cg * 8); }
}
DI void sh1_tile(PR p, int it, bf16* smem) {
  const int nt = it >> 8, mt = it & 255, m0 = mt * 128;
  f32x16 acc[2][2]; acc_zero(acc);
  ALPlain al{(const bf16*)(p.ws + O_HHI) + (size_t)m0 * 1024, 1024}; ALPlain bl{(const bf16*)(p.ws + O_WT_SGU) + (size_t)nt * 128 * 1024, 1024};
  gemm_mainloop_dma(acc, al, bl, 32, (unsigned char*)smem);
  gateup_store(acc, (bf16*)(p.ws + O_ACTSH) + (size_t)m0 * 256, 128, nt * 64, (float*)smem);
}
DI void sh2_tile(PR p, int it, bf16* smem) {
  const int nt = it >> 8, mt = it & 255, m0 = mt * 128, n0 = nt * 128;
  const int lane = threadIdx.x & 63, wave = threadIdx.x >> 6, wm = wave >> 1, wn = wave & 1;
  f32x16 acc[2][2]; acc_zero(acc);
  ALPlain al{(const bf16*)(p.ws + O_ACTSH) + (size_t)m0 * 256, 256}; ALPlain bl{(const bf16*)(p.ws + O_WT_SD) + (size_t)n0 * 256, 256};
  gemm_mainloop_dma(acc, al, bl, 8, (unsigned char*)smem);
  bf16* Y = (bf16*)(p.ws + O_YSH);
  float* st = (float*)smem; stage_acc(st, acc);
  __syncthreads();
#pragma unroll 2
  for (int j = 0; j < 8; ++j) { const int u = threadIdx.x + 256 * j, row = u >> 4, cg = u & 15;
    *(uint4*)(Y + (size_t)(m0 + row) * 1024 + n0 + cg * 8) = pack8(st + row * ST_LD + cg * 8); }
}

DI void route_token(unsigned char* ws, const float* __restrict__ logit, const float* __restrict__ bias, int tok, int lane) {
  const f32x4 lgv = __builtin_nontemporal_load((const f32x4*)(logit + 4 * lane)); float4 lg; lg.x = lgv[0]; lg.y = lgv[1]; lg.z = lgv[2]; lg.w = lgv[3]; const float4 bi = *(const float4*)(bias + 4 * lane);
  float sv[4] = {sigmoidf_(lg.x), sigmoidf_(lg.y), sigmoidf_(lg.z), sigmoidf_(lg.w)};
  float cv[4] = {sv[0] + bi.x, sv[1] + bi.y, sv[2] + bi.z, sv[3] + bi.w};
  float m1 = fmaxf(fmaxf(cv[0], cv[1]), fmaxf(cv[2], cv[3]));
  float m2;
  { float a = fmaxf(cv[0], cv[1]), bq = fminf(cv[0], cv[1]), c = fmaxf(cv[2], cv[3]), d = fminf(cv[2], cv[3]); m2 = fmaxf(fminf(a, c), fmaxf(bq, d)); }
#pragma unroll
  for (int o = 1; o < 8; o <<= 1) { float o1 = __shfl_xor(m1, o), o2 = __shfl_xor(m2, o); float n1 = fmaxf(m1, o1), n2 = fmaxf(fminf(m1, o1), fmaxf(m2, o2)); m1 = n1; m2 = n2; }
  const float gs = m1 + m2; const int grp = lane >> 3;
  int rank = 0;
#pragma unroll
  for (int g2 = 0; g2 < 8; ++g2) { float og = __shfl(gs, g2 * 8); rank += (og > gs || (og == gs && g2 < grp)) ? 1 : 0; }
  const bool keep = rank < 4;
#pragma unroll
  for (int j = 0; j < 4; ++j) if (!keep) cv[j] = NEGF;
  float wsum = 0.f, myw = 0.f; int myidx = 0;
#pragma unroll
  for (int r = 0; r < 8; ++r) {
    float bv = cv[0]; int bj = 0;
#pragma unroll
    for (int j = 1; j < 4; ++j) if (cv[j] > bv) { bv = cv[j]; bj = j; }
    float wv = bv; int wi = 4 * lane + bj;
#pragma unroll
    for (int o = 1; o < 64; o <<= 1) { float ov = __shfl_xor(wv, o); int oi = __shfl_xor(wi, o); if (ov > wv || (ov == wv && oi < wi)) { wv = ov; wi = oi; } }
    const int owner = wi >> 2, oj = wi & 3;
    float sj = (oj == 0) ? sv[0] : (oj == 1) ? sv[1] : (oj == 2) ? sv[2] : sv[3];
    const float ssel = __shfl(sj, owner);
    if (lane == owner) { if (oj == 0) cv[0] = -3e38f; else if (oj == 1) cv[1] = -3e38f; else if (oj == 2) cv[2] = -3e38f; else cv[3] = -3e38f; }
    wsum += ssel;
    if (lane == r) { myw = ssel; myidx = wi; }
  }
  if (lane < 8) {
    const float wgt = myw / wsum * 2.5f;
    ((int*)(ws + O_RIDX))[(size_t)tok * 8 + lane] = myidx;
    ((float*)(ws + O_RW))[(size_t)tok * 8 + lane] = wgt;
    const int pos = atomicAdd((int*)(ws + O_CTL) + CW_CNT + myidx * CNT_STRIDE, 1);
    ((int*)(ws + O_LIST))[(size_t)myidx * 32768 + pos] = tok * 8 + lane;
  }
}

DI void moe_offsets(const int* cnt, int* offs, int* stoffs) {
  __syncthreads();
  const int t = threadIdx.x; const int c = cnt[t * CNT_STRIDE];
  offs[t + 1] = c; if (t == 0) offs[0] = 0;
  __syncthreads();
  for (int o = 1; o < 256; o <<= 1) {
    int a = 0; if (t + 1 > o) a = offs[t + 1 - o];
    __syncthreads();
    if (t + 1 > o) offs[t + 1] += a;
    __syncthreads();
  }
  if (t < 8) { int a = 0; for (int j = 0; j < 32; ++j) { stoffs[t * 33 + j] = a; const int e = t + 8 * j; a += (offs[e + 1] - offs[e] + 255) >> 8; } stoffs[t * 33 + 32] = a; }
  __syncthreads();
}
DI int find_le32(const int* arr, int v) { int lo = 0, hi = 31; while (lo < hi) { int mid = (lo + hi + 1) >> 1; if (arr[mid] <= v) lo = mid; else hi = mid - 1; } return lo; }

DI void ph_moe1(PR p, bf16* smem, int* misc, int* ctrs) {
  int* offs = misc + 16; int* stoffs = misc + 280; int* shv = misc;
  moe_offsets((const int*)(p.ws + O_CTL) + CW_CNT, offs, stoffs);
  const int myx = xcc_id(); int off = 0, x, idx;
  constexpr int NSPL = 2, NPER = 4 / NSPL;
  while (shard_next(ctrs, myx, off, [stoffs](int xx) { return stoffs[xx * 33 + 32] * NSPL + 128; }, shv, x, idx)) {
    const int n_routed = stoffs[x * 33 + 32] * NSPL;
    if (idx >= n_routed) { const int i2 = idx - n_routed, g = i2 >> 5, rem = i2 & 31, nt = rem >> 3, mt = x * 32 + g * 8 + (rem & 7); sh1_tile(p, nt * 256 + mt, smem); continue; }
    int tid = threadIdx.x; asm volatile("" : "+v"(tid));
    const int lane = tid & 63, wave = tid >> 6, wm = wave >> 1, wn = wave & 1;
    const int arow = tid >> 2, akc = tid & 3, kg = tid >> 5, n4 = tid & 31;
    const int r = lane & 31, hh = lane >> 5;
    const int aoff = (wm * 128 + r) * 40 + hh * 8;
    const int nb0 = wn * 64 + r, nb1 = nb0 + 32;
    const int boff0 = M2_A_ELEMS + (hh * 128 + (nb0 ^ ((nb0 >> 3) & 3))) * 8, boff1 = M2_A_ELEMS + (hh * 128 + (nb1 ^ ((nb1 >> 3) & 3))) * 8;
    const int j = find_le32(stoffs + x * 33, idx / NSPL), e = x + 8 * j;
    const int me = stoffs[x * 33 + j + 1] - stoffs[x * 33 + j], local = idx - stoffs[x * 33 + j] * NSPL, nt_lo = (local / me) * NPER, mt = local % me;
    const int cnt = offs[e + 1] - offs[e], nvalid = min(256, cnt - mt * 256);
    const int* list = (const int*)(p.ws + O_LIST) + (size_t)e * 32768 + mt * 256;
    const bf16* abase = (const bf16*)(p.ws + O_HHI);
    unsigned ao0, ao1, ao2, ao3;
    { const int r0 = arow < nvalid ? arow : nvalid - 1, r1 = arow + 64 < nvalid ? arow + 64 : nvalid - 1, r2 = arow + 128 < nvalid ? arow + 128 : nvalid - 1, r3 = arow + 192 < nvalid ? arow + 192 : nvalid - 1;
      const int t0 = list[r0], t1 = list[r1], t2 = list[r2], t3 = list[r3];
      ao0 = (unsigned)(t0 >> 3) * 1024u + akc * 8; ao1 = (unsigned)(t1 >> 3) * 1024u + akc * 8; ao2 = (unsigned)(t2 >> 3) * 1024u + akc * 8; ao3 = (unsigned)(t3 >> 3) * 1024u + akc * 8; }
    const long du = (long)(p.w_exp_up - p.w_exp_gate);
    const float* wb = p.w_exp_gate + (size_t)e * 262144 + (long)(((n4 * 4) >> 5) & 1) * du + ((n4 * 4) >> 6) * 32 + ((n4 * 4) & 31) + (size_t)(kg * 4) * 256;
    uint4 ra0, ra1, ra2, ra3; f32x4 rb[4];
#define GLOADX(nt, kt) { const bf16* ab_ = abase + (kt) * 32; ra0 = *(const uint4*)(ab_ + ao0); ra1 = *(const uint4*)(ab_ + ao1); ra2 = *(const uint4*)(ab_ + ao2); ra3 = *(const uint4*)(ab_ + ao3); \
      const float* bp_ = wb + (nt) * 64 + (size_t)((kt) * 32) * 256; _Pragma("unroll") for (int r_ = 0; r_ < 4; ++r_) rb[r_] = *(const f32x4*)(bp_ + r_ * 256); }
#define LSTOREX(buf) { bf16* A_ = smem + (buf) * M2_STAGE_ELEMS; bf16* B_ = A_ + M2_A_ELEMS; const int o_ = arow * 40 + akc * 8; \
      *(uint4*)(A_ + o_) = ra0; *(uint4*)(A_ + o_ + 64 * 40) = ra1; *(uint4*)(A_ + o_ + 128 * 40) = ra2; *(uint4*)(A_ + o_ + 192 * 40) = ra3; \
      _Pragma("unroll") for (int c_ = 0; c_ < 4; ++c_) { uint2 v_; v_.x = pk2(rb[0][c_], rb[1][c_]); v_.y = pk2(rb[2][c_], rb[3][c_]); const int n_ = n4 * 4 + c_; \
        *(uint2*)(B_ + ((kg >> 1) * 128 + (n_ ^ ((n_ >> 3) & 3))) * 8 + (kg & 1) * 4) = v_; } }
    GLOADX(nt_lo, 0); LSTOREX(0); __syncthreads();
    float* st = (float*)smem;
#pragma unroll 1
    for (int nt = nt_lo; nt < nt_lo + NPER; ++nt) {
      f32x16 acc[4][2];
#pragma unroll
      for (int mi = 0; mi < 4; ++mi)
#pragma unroll
        for (int q = 0; q < 16; ++q) { acc[mi][0][q] = 0.f; acc[mi][1][q] = 0.f; }
#pragma unroll 1
      for (int kt = 0; kt < 32; ++kt) {
        if (kt + 1 < 32) GLOADX(nt, kt + 1)
        const bf16* S = smem + (kt & 1) * M2_STAGE_ELEMS;
#pragma unroll
        for (int ks = 0; ks < 2; ++ks) {
          const bf16x8 b0 = *(const bf16x8*)(S + boff0 + ks * 2 * 128 * 8), b1 = *(const bf16x8*)(S + boff1 + ks * 2 * 128 * 8);
#pragma unroll
          for (int mi = 0; mi < 4; ++mi) { const bf16x8 a = *(const bf16x8*)(S + aoff + mi * 32 * 40 + ks * 16);
            acc[mi][0] = __builtin_amdgcn_mfma_f32_32x32x16_bf16(a, b0, acc[mi][0], 0, 0, 0);
            acc[mi][1] = __builtin_amdgcn_mfma_f32_32x32x16_bf16(a, b1, acc[mi][1], 0, 0, 0); }
          __builtin_amdgcn_sched_barrier(0);
        }
        if (kt + 1 < 32) LSTOREX((kt + 1) & 1);
        __syncthreads();
      }
#pragma unroll
      for (int mi = 0; mi < 4; ++mi) {
        float* bq = st + (wm * 128 + mi * 32 + 4 * (lane >> 5)) * 68 + wn * 32 + (lane & 31);
#pragma unroll
        for (int q = 0; q < 16; ++q) bq[(8 * (q >> 2) + (q & 3)) * 68] = siluf_(acc[mi][0][q]) * acc[mi][1][q]; }
      if (nt + 1 < nt_lo + NPER) GLOADX(nt + 1, 0)
      __syncthreads();
      bf16* dst = (bf16*)(p.ws + O_ACT) + (size_t)(offs[e] + mt * 256) * 256 + nt * 64;
#pragma unroll 2
      for (int jq = 0; jq < 8; ++jq) { const int u = tid + 256 * jq, row = u >> 3, cg = u & 7;
        if (row < nvalid) NT_ST16(pack8(st + row * 68 + cg * 8), dst + (size_t)row * 256 + cg * 8) }
      __syncthreads();
      if (nt + 1 < nt_lo + NPER) { LSTOREX(0); __syncthreads(); }
    }
#undef GLOADX
#undef LSTOREX
  }
}
DI void ph_moe2(PR p, bf16* smem, int* misc, int* ctrs) {
  int* offs = misc + 16; int* stoffs = misc + 280; int* shv = misc;
  int* lasg = (int*)((unsigned char*)smem + 67584); float* lw = (float*)((unsigned char*)smem + 67584 + 1024);
  moe_offsets((const int*)(p.ws + O_CTL) + CW_CNT, offs, stoffs);
  const int tid = threadIdx.x, lane = tid & 63, wave = tid >> 6, wm = wave >> 1, wn = wave & 1;
  const int arow = tid >> 2, akc = tid & 3, kg = tid >> 5, n4 = tid & 31;
  const int r = lane & 31, hh = lane >> 5;
  const int aoff = (wm * 128 + r) * 40 + hh * 8;
  const int nb0 = wn * 64 + r, nb1 = nb0 + 32;
  const int boff0 = M2_A_ELEMS + (hh * 128 + (nb0 ^ ((nb0 >> 3) & 3))) * 8, boff1 = M2_A_ELEMS + (hh * 128 + (nb1 ^ ((nb1 >> 3) & 3))) * 8;
  const int myx = xcc_id(); int off = 0, x, idx;
  constexpr int NSPL = 4, NPER = 8 / NSPL;
  while (shard_next(ctrs, myx, off, [stoffs](int xx) { return stoffs[xx * 33 + 32] * NSPL + 256; }, shv, x, idx)) {
    const int n_routed = stoffs[x * 33 + 32] * NSPL;
    if (idx >= n_routed) { const int i2 = idx - n_routed, g = i2 >> 6, rem = i2 & 63, nt = rem >> 3, mt = x * 32 + g * 8 + (rem & 7); sh2_tile(p, nt * 256 + mt, smem); continue; }
    const int j = find_le32(stoffs + x * 33, idx / NSPL), e = x + 8 * j;
    const int me = stoffs[x * 33 + j + 1] - stoffs[x * 33 + j], local = idx - stoffs[x * 33 + j] * NSPL, nt_lo = (local / me) * NPER, mt = local % me;
    const int cnt = offs[e + 1] - offs[e], nvalid = min(256, cnt - mt * 256);
    { const int rr = tid < nvalid ? tid : 0; const int asg = ((const int*)(p.ws + O_LIST))[(size_t)e * 32768 + mt * 256 + rr]; lasg[tid] = asg; lw[tid] = ((const float*)(p.ws + O_RW))[asg]; }
    const bf16* abase = (const bf16*)(p.ws + O_ACT) + (size_t)(offs[e] + mt * 256) * 256;
    const unsigned ao0 = (unsigned)(arow * 256 + akc * 8), ao1 = ao0 + 64 * 256, ao2 = ao0 + 128 * 256, ao3 = ao0 + 192 * 256;
    const float* wb = p.w_exp_down + (size_t)e * 262144 + n4 * 4 + (size_t)(kg * 4) * 1024;
    uint4 ra0, ra1, ra2, ra3; f32x4 rb[4];
#define GLOADX(nt, kt) { const bf16* ab_ = abase + (kt) * 32; ra0 = *(const uint4*)(ab_ + ao0); ra1 = *(const uint4*)(ab_ + ao1); ra2 = *(const uint4*)(ab_ + ao2); ra3 = *(const uint4*)(ab_ + ao3); \
      const float* bp_ = wb + (nt) * 128 + (size_t)((kt) * 32) * 1024; _Pragma("unroll") for (int r_ = 0; r_ < 4; ++r_) rb[r_] = *(const f32x4*)(bp_ + r_ * 1024); }
#define LSTOREX(buf) { bf16* A_ = smem + (buf) * M2_STAGE_ELEMS; bf16* B_ = A_ + M2_A_ELEMS; const int o_ = arow * 40 + akc * 8; \
      *(uint4*)(A_ + o_) = ra0; *(uint4*)(A_ + o_ + 64 * 40) = ra1; *(uint4*)(A_ + o_ + 128 * 40) = ra2; *(uint4*)(A_ + o_ + 192 * 40) = ra3; \
      _Pragma("unroll") for (int c_ = 0; c_ < 4; ++c_) { uint2 v_; v_.x = pk2(rb[0][c_], rb[1][c_]); v_.y = pk2(rb[2][c_], rb[3][c_]); const int n_ = n4 * 4 + c_; \
        *(uint2*)(B_ + ((kg >> 1) * 128 + (n_ ^ ((n_ >> 3) & 3))) * 8 + (kg & 1) * 4) = v_; } }
    GLOADX(nt_lo, 0); LSTOREX(0); __syncthreads();
    bf16* YK = (bf16*)(p.ws + O_YK);
    float* st = (float*)smem;
#pragma unroll 1
    for (int nt = nt_lo; nt < nt_lo + NPER; ++nt) {
      f32x16 acc[4][2];
#pragma unroll
      for (int mi = 0; mi < 4; ++mi)
#pragma unroll
        for (int q = 0; q < 16; ++q) { acc[mi][0][q] = 0.f; acc[mi][1][q] = 0.f; }
#pragma unroll 1
      for (int kt = 0; kt < 8; ++kt) {
        if (kt + 1 < 8) GLOADX(nt, kt + 1)
        const bf16* S = smem + (kt & 1) * M2_STAGE_ELEMS;
#pragma unroll
        for (int ks = 0; ks < 2; ++ks) {
          const bf16x8 b0 = *(const bf16x8*)(S + boff0 + ks * 2 * 128 * 8), b1 = *(const bf16x8*)(S + boff1 + ks * 2 * 128 * 8);
#pragma unroll
          for (int mi = 0; mi < 4; ++mi) { const bf16x8 a = *(const bf16x8*)(S + aoff + mi * 32 * 40 + ks * 16);
            acc[mi][0] = __builtin_amdgcn_mfma_f32_32x32x16_bf16(a, b0, acc[mi][0], 0, 0, 0);
            acc[mi][1] = __builtin_amdgcn_mfma_f32_32x32x16_bf16(a, b1, acc[mi][1], 0, 0, 0); }
          __builtin_amdgcn_sched_barrier(0);
        }
        if (kt + 1 < 8) LSTOREX((kt + 1) & 1);
        __syncthreads();
      }
      const int n0 = nt * 128;
#pragma unroll 1
      for (int h = 0; h < 2; ++h) {
        if (wm == h) {
#pragma unroll
          for (int mi = 0; mi < 4; ++mi)
#pragma unroll
            for (int ni = 0; ni < 2; ++ni) { float* bq = st + (mi * 32 + 4 * (lane >> 5)) * ST_LD + wn * 64 + ni * 32 + (lane & 31);
#pragma unroll
              for (int q = 0; q < 16; ++q) bq[(8 * (q >> 2) + (q & 3)) * ST_LD] = acc[mi][ni][q]; }
        }
        if (h == 1 && nt + 1 < nt_lo + NPER) GLOADX(nt + 1, 0)
        __syncthreads();
#pragma unroll 2
        for (int jq = 0; jq < 8; ++jq) { const int u = tid + 256 * jq, row = u >> 4, cg = u & 15, grow = h * 128 + row;
          if (grow < nvalid) { const float w = lw[grow]; const float* s = st + row * ST_LD + cg * 8; const f32x4 a = *(const f32x4*)s, bq = *(const f32x4*)(s + 4);
            uint4 o; o.x = pk2(w * a[0], w * a[1]); o.y = pk2(w * a[2], w * a[3]); o.z = pk2(w * bq[0], w * bq[1]); o.w = pk2(w * bq[2], w * bq[3]);
            { typedef unsigned u32x4_t __attribute__((ext_vector_type(4))); u32x4_t ov = {o.x, o.y, o.z, o.w}; __builtin_nontemporal_store(ov, (u32x4_t*)(YK + (size_t)lasg[grow] * 1024 + n0 + cg * 8)); } } }
        __syncthreads();
      }
      if (nt + 1 < nt_lo + NPER) { LSTOREX(0); __syncthreads(); }
    }
#undef GLOADX
#undef LSTOREX
  }
}

DI void final_row(PR p, int tok, int lane) {
  const int b = tok >> 11;
  const float* mod = (const float*)(p.ws + O_MOD) + b * 6144;
  const float* X1 = (const float*)(p.ws + O_X1) + (size_t)tok * 1024;
  const bf16* YK = (const bf16*)(p.ws + O_YK) + (size_t)tok * 8 * 1024; const bf16* YS = (const bf16*)(p.ws + O_YSH) + (size_t)tok * 1024;
  float4 v[4]; float s = 0.f;
#pragma unroll
  for (int j = 0; j < 4; ++j) {
    const int col = (lane + 64 * j) * 4;
    typedef unsigned u32x2_t __attribute__((ext_vector_type(2)));
    const u32x2_t ysq = __builtin_nontemporal_load((const u32x2_t*)(YS + col));
    float f0 = __uint_as_float(ysq.x << 16), f1 = __uint_as_float(ysq.x & 0xffff0000u), f2 = __uint_as_float(ysq.y << 16), f3 = __uint_as_float(ysq.y & 0xffff0000u);
#pragma unroll
    for (int k = 0; k < 8; ++k) { typedef unsigned u32x2_t __attribute__((ext_vector_type(2))); const u32x2_t yq = __builtin_nontemporal_load((const u32x2_t*)(YK + (size_t)k * 1024 + col)); f0 += __uint_as_float(yq.x << 16); f1 += __uint_as_float(yq.x & 0xffff0000u); f2 += __uint_as_float(yq.y << 16); f3 += __uint_as_float(yq.y & 0xffff0000u); }
    const f32x4 x1v = __builtin_nontemporal_load((const f32x4*)(X1 + col)); float4 x1; x1.x = x1v[0]; x1.y = x1v[1]; x1.z = x1v[2]; x1.w = x1v[3]; const float4 g2 = *(const float4*)(mod + 5120 + col);
    v[j].x = DN_ALPHA * x1.x + g2.x * f0; v[j].y = DN_ALPHA * x1.y + g2.y * f1; v[j].z = DN_ALPHA * x1.z + g2.z * f2; v[j].w = DN_ALPHA * x1.w + g2.w * f3;
    s += (v[j].x + v[j].y) + (v[j].z + v[j].w);
  }
  const float mean = wave_sum(s) * (1.f / 1024.f); float s2 = 0.f;
#pragma unroll
  for (int j = 0; j < 4; ++j) { v[j].x -= mean; v[j].y -= mean; v[j].z -= mean; v[j].w -= mean; s2 += (v[j].x * v[j].x + v[j].y * v[j].y) + (v[j].z * v[j].z + v[j].w * v[j].w); }
  const float rstd = 1.f / sqrtf(wave_sum(s2) * (1.f / 1024.f) + LN_EPS);
#pragma unroll
  for (int j = 0; j < 4; ++j) {
    const int col = (lane + 64 * j) * 4;
    const float4 g = *(const float4*)(p.ln2_g + col), bb = *(const float4*)(p.ln2_b + col);
    float4 o; o.x = v[j].x * rstd * g.x + bb.x; o.y = v[j].y * rstd * g.y + bb.y; o.z = v[j].z * rstd * g.z + bb.z; o.w = v[j].w * rstd * g.w + bb.w;
    { f32x4 ov = {o.x, o.y, o.z, o.w}; __builtin_nontemporal_store(ov, (f32x4*)(p.out + (size_t)tok * 1024 + col)); }
  }
}

__global__ void __launch_bounds__(256, 2) mega(P p_arg) {
  PR p = *(const __attribute__((address_space(4))) P*)__builtin_amdgcn_kernarg_segment_ptr();
  extern __shared__ __attribute__((aligned(16))) unsigned char lds[];
  cg::grid_group grid = cg::this_grid();
  bf16* smem = (bf16*)lds; int* misc = (int*)(lds + MISC_OFF); int* shv = misc;
  int* qc = (int*)(p.ws + O_CTL) + CW_Q;
#define NREP(k) 1
#define QC(k) (qc + (k) + 32 * rep_)
#define SQ(k) ((int*)(p.ws + O_CTL) + 32768 + (k) * 512 + rep_ * 256)
#define PH_BEGIN(k) if (p.ph_lo <= (k) && (k) < p.ph_hi) { int tx_ = threadIdx.x; asm volatile("" : "+v"(tx_)); const int lane = tx_ & 63, wave = tx_ >> 6, gw = blockIdx.x * 4 + wave, NGW = gridDim.x * 4; (void)lane; (void)gw; (void)NGW; \
  for (int rep_ = 0; rep_ < NREP(k); ++rep_) { if (rep_) { xcd_barrier(gbar, myxcc, xst); }
#define PH_STAMP(k)
#define PH_END(k) } if ((k) + 1 < p.ph_hi) { xcd_barrier(gbar, myxcc, xst); PH_STAMP(k) } }
  unsigned* gbar = (unsigned*)(p.ws + O_CTL) + 65536; const unsigned myxcc = (unsigned)__builtin_amdgcn_s_getreg((3 << 11) | 20) & 0xFu;
  volatile unsigned* xst = (volatile unsigned*)(misc + 1000);
  if (threadIdx.x == 0) { xst[0] = 0u; xst[1] = 0u; }
  if (threadIdx.x == 0) (void)xb_add(&gbar[XB_XCNT(myxcc)], 1u);
  PH_STAMP(-1)
  if (p.ph_lo <= 0 && 0 < p.ph_hi) { { const int rep_ = 0; (void)rep_; ph_prologue(p, lds, QC(0), shv); } if (1 < p.ph_hi) { grid.sync(); PH_STAMP(0) } }
  PH_BEGIN(1) ph_u(p); PH_END(1)
  PH_BEGIN(2) ph_inproj(p, smem, SQ(2), shv); PH_END(2)
  PH_BEGIN(3)
    { const int myx = xcc_id(); int off = 0, x, idx;
      while (shard_next(SQ(3), myx, off, [](int) { return 144; }, shv, x, idx)) { const int it = idx * 8 + x;
        if (it < 128) cmp1_tile(p, it, smem); else { const int j = it - 128; idx_item(p, j & 15, 63 - (j >> 4), lds); } } }
  PH_END(3)
  PH_BEGIN(4)
    for (;;) { const int it = sched_next(QC(4), shv); if (it >= 64) break; cmp2_tile(p, it, smem); }
  PH_END(4)
  PH_BEGIN(5)
    { const int myx = xcc_id(); int off = 0, x, idx;
    while (shard_next(SQ(5), myx, off, [](int) { return 768; }, shv, x, idx)) { const int it = idx * 8 + ((x + idx) & 7);
      if (it < 4096) { const int ty = it & 1, j = it >> 1, qt = 63 - (j >> 5), bg = j & 31;
        if (ty == 0) attn_item<0>(p, bg >> 1, bg & 1, qt, smem); else attn_item<1>(p, bg >> 1, bg & 1, qt, smem); }
      else { const int j = it - 4096, qt = j >> 5, bg = j & 31; cmp_item(p, bg >> 1, bg & 1, qt, lds); } } }
  PH_END(5)
  PH_BEGIN(6) { const int myx = xcc_id(); int off = 0, x, idx; while (shard_next(SQ(6), myx, off, [](int) { return 256; }, shv, x, idx)) { const int it = idx * 8 + x; const int qt = 63 - (it >> 5), bg = it & 31; attn_item<2>(p, bg >> 1, bg & 1, qt, smem); } } PH_END(6)
  PH_BEGIN(7) { const int myx = xcc_id(); int off = 0, x, idx; while (shard_next(SQ(7), myx, off, [](int) { return 256; }, shv, x, idx)) { const int g = idx >> 6, rem = idx & 63; merge_tile(p, (rem >> 3) * 256 + x * 32 + g * 8 + (rem & 7), smem); } } PH_END(7)
  PH_BEGIN(8) { const int myx = xcc_id(); int off = 0, x, idx; while (shard_next(SQ(8), myx, off, [](int) { return 128; }, shv, x, idx)) { const int g = idx >> 6, rem = idx & 63; out_tile(p, (rem >> 3) * 128 + x * 16 + g * 8 + (rem & 7), smem); } } PH_END(8)
  PH_BEGIN(9) for (int w = gw; w < T; w += NGW) ln1_row(p, w, lane); PH_END(9)
  PH_BEGIN(10) { const int myx = xcc_id(); int off = 0, x, idx; while (shard_next(SQ(10), myx, off, [](int) { return 64; }, shv, x, idx)) { const int g = idx >> 4, rem = idx & 15; router_tile(p, (rem >> 3) * 256 + x * 32 + g * 8 + (rem & 7), smem); } } PH_END(10)
  PH_BEGIN(11) for (int w = gw; w < T; w += NGW) route_token(p.ws, (const float*)(p.ws + O_LOGITS) + (size_t)w * 256, p.router_bias, w, lane); PH_END(11)
  PH_BEGIN(12) ph_moe1(p, smem, misc, SQ(12)); PH_END(12)
  PH_BEGIN(13) ph_moe2(p, smem, misc, SQ(13)); PH_END(13)
  PH_BEGIN(14) for (int w = gw; w < T; w += NGW) final_row(p, w, lane); PH_END(14)
}

extern "C" void kernel_launch(void* const* d_in, const int* in_sizes, int n_in, void* d_out, int out_size, void* d_ws, size_t ws_size, hipStream_t stream) {
  if (n_in != 27 || ws_size < WS_NEED2) { fprintf(stderr, "kernel_launch: unexpected n_in %d / ws_size %zu (need %zu)\n", n_in, ws_size, (size_t)WS_NEED2); return; }
  static int grid_blocks = 0;
  if (!grid_blocks) {
    int dev = 0, cus = 0, per_cu = 0;
    (void)hipGetDevice(&dev);
    (void)hipDeviceGetAttribute(&cus, hipDeviceAttributeMultiprocessorCount, dev);
    (void)hipFuncSetAttribute((const void*)mega, hipFuncAttributeMaxDynamicSharedMemorySize, LDS_BYTES);
    (void)hipOccupancyMaxActiveBlocksPerMultiprocessor(&per_cu, mega, 256, LDS_BYTES);
    if (per_cu < 1) per_cu = 1;
    grid_blocks = cus * per_cu;
    fprintf(stderr, "kernel_launch: cus %d per_cu %d grid %d\n", cus, per_cu, grid_blocks);
  }
  P p{};
  p.x = (const float*)d_in[0]; p.c = (const float*)d_in[1]; p.pos = (const int*)d_in[2];
  p.w_ada = (const float*)d_in[3]; p.b_ada = (const float*)d_in[4]; p.w_in = (const float*)d_in[5]; p.w_br_a = (const float*)d_in[6]; p.w_br_b = (const float*)d_in[7];
  p.w_out = (const float*)d_in[8]; p.cmp_pos_k = (const float*)d_in[9]; p.cmp_pos_v = (const float*)d_in[10]; p.cmp_k_w1 = (const float*)d_in[11]; p.cmp_k_w2 = (const float*)d_in[12];
  p.cmp_v_w1 = (const float*)d_in[13]; p.cmp_v_w2 = (const float*)d_in[14]; p.ln1_g = (const float*)d_in[15]; p.ln1_b = (const float*)d_in[16]; p.w_router = (const float*)d_in[17];
  p.router_bias = (const float*)d_in[18]; p.w_exp_gate = (const float*)d_in[19]; p.w_exp_up = (const float*)d_in[20]; p.w_exp_down = (const float*)d_in[21];
  p.w_sh_gate = (const float*)d_in[22]; p.w_sh_up = (const float*)d_in[23]; p.w_sh_down = (const float*)d_in[24]; p.ln2_g = (const float*)d_in[25]; p.ln2_b = (const float*)d_in[26];
  p.out = (float*)d_out; p.ws = (unsigned char*)d_ws;
  p.ph_lo = 0; p.ph_hi = NPHASE;
  (void)hipMemsetAsync((char*)d_ws + O_CTL, 0, 1 * MiB, stream);
  void* args[] = {&p};
  hipError_t e = hipLaunchCooperativeKernel((void*)mega, dim3(grid_blocks), dim3(256), args, LDS_BYTES, stream);
  if (e != hipSuccess) fprintf(stderr, "cooperative launch failed: %s (grid %d)\n", hipGetErrorString(e), grid_blocks);
}
```

```cpp
#include <hip/hip_runtime.h>
#include <hip/hip_cooperative_groups.h>
#include <stdint.h>
#include <stdio.h>
namespace cg = cooperative_groups;

typedef unsigned short bf16;
typedef float f32x16 __attribute__((ext_vector_type(16)));
typedef float f32x4 __attribute__((ext_vector_type(4)));
typedef float f32x2 __attribute__((ext_vector_type(2)));
typedef short bf16x8 __attribute__((ext_vector_type(8)));
typedef __bf16 bf16x2_t __attribute__((ext_vector_type(2)));
typedef unsigned u32x4 __attribute__((ext_vector_type(4)));
#define NT_LD16(p_) __builtin_nontemporal_load((const u32x4*)(p_))
#define NT_ST16(v_, p_) { const uint4 t__ = (v_); u32x4 q__ = {t__.x, t__.y, t__.z, t__.w}; __builtin_nontemporal_store(q__, (u32x4*)(p_)); }
#define DI __device__ __forceinline__

constexpr int D = 1024, NB = 16, S = 2048, T = NB * S, NIN = 4416;
constexpr float DN_ALPHA = 1.189207115002721f;
constexpr float LN_EPS = 1e-5f;
constexpr float NEGF = -1e30f;

constexpr size_t MiB = 1ull << 20;
constexpr size_t O_CTL = 0;
constexpr size_t O_MOD = 1 * MiB;
constexpr size_t O_ROPEH = 2 * MiB;
constexpr size_t O_ROPEI = 4 * MiB;
constexpr size_t O_CMPB = 5 * MiB;
constexpr size_t O_SELM = 6 * MiB;
constexpr size_t O_DSAM = 8 * MiB;
constexpr size_t O_RIDX = 16 * MiB;
constexpr size_t O_RW = 17 * MiB;
constexpr size_t O_LIST = 18 * MiB;
constexpr size_t O_H1 = 50 * MiB;
constexpr size_t BASE = 64 * MiB;
constexpr size_t O_U = BASE + 0 * MiB;
constexpr size_t O_SGA = BASE + 64 * MiB;
constexpr size_t O_SGB = BASE + 128 * MiB;
constexpr size_t O_QA = BASE + 192 * MiB;
constexpr size_t O_QBR = BASE + 224 * MiB;
constexpr size_t O_QBT = BASE + 256 * MiB;
constexpr size_t O_QI = BASE + 288 * MiB;
constexpr size_t O_KA = BASE + 304 * MiB;
constexpr size_t O_VAT = BASE + 312 * MiB;
constexpr size_t O_KS = BASE + 320 * MiB;
constexpr size_t O_VST = BASE + 328 * MiB;
constexpr size_t O_KW = BASE + 336 * MiB;
constexpr size_t O_VWT = BASE + 344 * MiB;
constexpr size_t O_KC = BASE + 352 * MiB;
constexpr size_t O_VC = BASE + 361 * MiB;
constexpr size_t O_KI = BASE + 370 * MiB;
constexpr size_t O_WI = BASE + 372 * MiB;
constexpr size_t O_GN = BASE + 373 * MiB;
constexpr size_t O_KCC = BASE + 376 * MiB;
constexpr size_t O_VCCT = BASE + 377 * MiB;
constexpr size_t O_OA = BASE + 378 * MiB;
constexpr size_t O_OCMP = BASE + 410 * MiB;
constexpr size_t O_OB = BASE + 442 * MiB;
constexpr size_t O_OWIN = BASE + 826 * MiB;
constexpr size_t O_MERGED = BASE + 474 * MiB;
constexpr size_t O_SC = BASE + 538 * MiB;
constexpr size_t O_Y = O_SC;
constexpr size_t O_X1 = BASE + 0 * MiB;
constexpr size_t O_HHI = BASE + 128 * MiB;
constexpr size_t O_HLO = BASE + 192 * MiB;
constexpr size_t O_YSH = O_HLO;
constexpr size_t O_ACTSH = BASE + 256 * MiB;
constexpr size_t O_ACT = BASE + 272 * MiB;
constexpr size_t O_YK = BASE + 400 * MiB;
constexpr size_t O_LOGITS = O_YK;
constexpr size_t WS_NEED = BASE + 912 * MiB;
constexpr size_t O_WT = 976 * MiB;
constexpr size_t O_WT_IN = O_WT;
constexpr size_t O_WT_BRA = O_WT + 10 * MiB;
constexpr size_t O_WT_BRB = O_WT + 11 * MiB;
constexpr size_t O_WT_OUT = O_WT + 12 * MiB;
constexpr size_t O_WT_RT = O_WT + 14 * MiB;
constexpr size_t O_WT_SGU = O_WT + 15 * MiB;
constexpr size_t O_WT_SD = O_WT + 16 * MiB;
constexpr size_t O_WT_C1K = O_WT + 17 * MiB;
constexpr size_t O_WT_C1V = O_WT + 18 * MiB;
constexpr size_t O_WT_C2K = O_WT + 19 * MiB;
constexpr size_t O_WT_C2V = O_WT + 19 * MiB + 65536;
constexpr size_t WS_NEED2 = O_WT + 20 * MiB;

constexpr int CW_CNT = 16384, CNT_STRIDE = 32;
constexpr int CW_Q = 64;

constexpr int NPHASE = 15;
constexpr int LDS_ROW = 72;
constexpr int TILE_ELEMS = 128 * LDS_ROW;
constexpr int GEMM_LDS_BYTES = 4 * TILE_ELEMS * 2;
constexpr int MISC_OFF = GEMM_LDS_BYTES;
constexpr int LDS_BYTES = GEMM_LDS_BYTES + 4096;

struct P {
  const float *x, *c; const int* pos;
  const float *w_ada, *b_ada, *w_in, *w_br_a, *w_br_b, *w_out, *cmp_pos_k, *cmp_pos_v, *cmp_k_w1, *cmp_k_w2, *cmp_v_w1, *cmp_v_w2,
      *ln1_g, *ln1_b, *w_router, *router_bias, *w_exp_gate, *w_exp_up, *w_exp_down, *w_sh_gate, *w_sh_up, *w_sh_down, *ln2_g, *ln2_b;
  float* out; unsigned char* ws;
  int ph_lo, ph_hi;
};

typedef const __attribute__((address_space(4))) P& PR;

DI bf16 f2bf(float f) { unsigned u = __float_as_uint(f); u += 0x7fffu + ((u >> 16) & 1u); return (bf16)(u >> 16); }
DI float bf2f(bf16 h) { return __uint_as_float(((unsigned)h) << 16); }
DI unsigned pk2(float a, float b) { f32x2 v = {a, b}; bf16x2_t r = __builtin_convertvector(v, bf16x2_t); return __builtin_bit_cast(unsigned, r); }
DI size_t blk_off(int row, int k, int K) { return ((size_t)(row >> 7) * (K >> 5) + (k >> 5)) * 4096 + (row & 127) * 32 + (k & 31); }
DI float sigmoidf_(float v) { return 1.f / (1.f + __expf(-v)); }
DI float siluf_(float v) { return v / (1.f + __expf(-v)); }
DI float wave_sum(float v) {
#pragma unroll
  for (int o = 1; o < 64; o <<= 1) v += __shfl_xor(v, o);
  return v;
}
DI float wave_max(float v) {
#pragma unroll
  for (int o = 1; o < 64; o <<= 1) v = fmaxf(v, __shfl_xor(v, o));
  return v;
}
DI void grid_barrier(unsigned* bar, unsigned target) {
  asm volatile("s_waitcnt vmcnt(0)" ::: "memory");
  __syncthreads();
  if (threadIdx.x == 0) {
    __builtin_amdgcn_fence(__ATOMIC_RELEASE, "agent");
    asm volatile("s_waitcnt vmcnt(0)" ::: "memory");
    __hip_atomic_fetch_add(bar, 1u, __ATOMIC_RELAXED, __HIP_MEMORY_SCOPE_AGENT);
    while (__hip_atomic_load(bar, __ATOMIC_RELAXED, __HIP_MEMORY_SCOPE_AGENT) < target) __builtin_amdgcn_s_sleep(2);
    __builtin_amdgcn_fence(__ATOMIC_ACQUIRE, "agent");
    asm volatile("s_waitcnt vmcnt(0)" ::: "memory");
  }
  __syncthreads();
}
DI int xcc_id() { return (int)(__builtin_amdgcn_s_getreg((3 << 11) | 20) & 7u); }
template <class NSub>
DI bool shard_next(int* ctrs, int myx, int& off, NSub nsub, int* shv, int& x, int& idx) {
  __syncthreads();
  if (threadIdx.x == 0) {
    int o = off, rx = -1, ri = 0;
    while (o < 8) { const int xx = (myx + o) & 7; const int i = atomicAdd(&ctrs[xx * 32], 1); if (i < nsub(xx)) { rx = xx; ri = i; break; } ++o; }
    shv[0] = rx; shv[1] = ri; shv[2] = o;
  }
  __syncthreads();
  x = shv[0]; idx = shv[1]; off = shv[2];
  return x >= 0;
}

#define XB_TMO      128
#define XB_XCNT(j)  (256  + 64 * (j))
#define XB_XSUB(j)  (1280 + 64 * (j))
#define XB_XGEN(j)  (2304 + 64 * (j))
#define XB_TOP      3328
#define XB_TOPGEN   3392
#define XB_SPIN_CAP (1u << 22)
DI unsigned xb_ld(unsigned* p) { return __hip_atomic_load(p, __ATOMIC_RELAXED, __HIP_MEMORY_SCOPE_AGENT); }
DI unsigned xb_add(unsigned* p, unsigned v) { return __hip_atomic_fetch_add(p, v, __ATOMIC_RELAXED, __HIP_MEMORY_SCOPE_AGENT); }
#define XB_SPIN(cond, bar) do { unsigned _sp = 0; while (cond) { __builtin_amdgcn_s_sleep(1); \
    if ((++_sp & 255u) == 0u) { if (xb_ld(&(bar)[XB_TMO])) break; if (_sp > XB_SPIN_CAP) { atomicAdd(&(bar)[XB_TMO], 1u); break; } } } } while (0)
DI void xcd_barrier_complete(unsigned* bar, unsigned x, unsigned& nloc, unsigned& nx) {
  const unsigned G = gridDim.x;
  unsigned sum, cnt, mine, sp = 0u;
  for (;;) {
    sum = 0u; cnt = 0u; mine = 0u;
#pragma unroll
    for (unsigned j = 0; j < 16; ++j) { const unsigned c = xb_ld(&bar[XB_XCNT(j)]); sum += c; cnt += (c > 0u) ? 1u : 0u; mine = (j == x) ? c : mine; }
    if (sum == G) break;
    __builtin_amdgcn_s_sleep(1);
    if ((++sp & 255u) == 0u) { if (xb_ld(&bar[XB_TMO])) break; if (sp > XB_SPIN_CAP) { atomicAdd(&bar[XB_TMO], 1u); break; } }
  }
  nloc = mine > 0u ? mine : 1u; nx = cnt > 0u ? cnt : 1u;
}
DI void xcd_barrier(unsigned* bar, unsigned x, volatile unsigned* st) {
  asm volatile("s_waitcnt vmcnt(0)" ::: "memory");
  __syncthreads();
  if (threadIdx.x == 0) {
    __builtin_amdgcn_s_waitcnt(0);
    unsigned nloc = st[0], nx = st[1];
    if (nloc == 0u) { xcd_barrier_complete(bar, x, nloc, nx); st[0] = nloc; st[1] = nx; }
    const unsigned old = xb_add(&bar[XB_XSUB(x)], 1u);
    const unsigned gen = old / nloc;
    if (old + 1u == (gen + 1u) * nloc) {
      __builtin_amdgcn_fence(__ATOMIC_RELEASE, "agent");
      asm volatile("s_waitcnt vmcnt(0)" ::: "memory");
      const unsigned og = xb_add(&bar[XB_TOP], 1u);
      const unsigned tg = og / nx;
      if (og + 1u == (tg + 1u) * nx) xb_add(&bar[XB_TOPGEN], 1u);
      else XB_SPIN(xb_ld(&bar[XB_TOPGEN]) == tg, bar);
      __builtin_amdgcn_fence(__ATOMIC_ACQUIRE, "agent");
      xb_add(&bar[XB_XGEN(x)], 1u);
      asm volatile("s_waitcnt vmcnt(0)" ::: "memory");
    } else {
      XB_SPIN(xb_ld(&bar[XB_XGEN(x)]) == gen, bar);
      __builtin_amdgcn_fence(__ATOMIC_ACQUIRE, "agent");
      asm volatile("s_waitcnt vmcnt(0)" ::: "memory");
    }
  }
  __syncthreads();
}
DI int sched_next(int* ctr, int* shv) {
  __syncthreads();
  if (threadIdx.x == 0) *shv = atomicAdd(ctr, 1);
  __syncthreads();
  return *shv;
}

template <class AL, class BL>
DI void gemm_mainloop(f32x16 (&acc)[2][2], const AL& al, BL& bl, int ktiles, bf16* smem) {
  const int tid = threadIdx.x, lane = tid & 63, wave = tid >> 6, wm = wave >> 1, wn = wave & 1;
  const int arow = tid >> 3, akc = tid & 7, kg = tid >> 5, n4 = tid & 31;
  const bf16* ap0 = al.rowptr(arow) + akc * 8;
  const bf16* ap1 = al.rowptr(arow + 32) + akc * 8;
  const bf16* ap2 = al.rowptr(arow + 64) + akc * 8;
  const bf16* ap3 = al.rowptr(arow + 96) + akc * 8;
  bl.init(n4 * 4);
  uint4 ra0, ra1, ra2, ra3; f32x4 rb[8];
#define GLOAD(kt) { const int ko_ = al.koff(kt); ra0 = *(const uint4*)(ap0 + ko_); ra1 = *(const uint4*)(ap1 + ko_); ra2 = *(const uint4*)(ap2 + ko_); ra3 = *(const uint4*)(ap3 + ko_); \
    _Pragma("unroll") for (int r_ = 0; r_ < 8; ++r_) rb[r_] = bl.ld(kt, kg * 8 + r_); }
#define LSTORE(buf) { bf16* A_ = smem + (buf) * 2 * TILE_ELEMS; bf16* B_ = A_ + TILE_ELEMS; \
    *(uint4*)(A_ + (arow) * LDS_ROW + akc * 8) = ra0; *(uint4*)(A_ + (arow + 32) * LDS_ROW + akc * 8) = ra1; \
    *(uint4*)(A_ + (arow + 64) * LDS_ROW + akc * 8) = ra2; *(uint4*)(A_ + (arow + 96) * LDS_ROW + akc * 8) = ra3; \
    _Pragma("unroll") for (int c_ = 0; c_ < 4; ++c_) { uint4 v_; v_.x = pk2(rb[0][c_], rb[1][c_]); v_.y = pk2(rb[2][c_], rb[3][c_]); v_.z = pk2(rb[4][c_], rb[5][c_]); v_.w = pk2(rb[6][c_], rb[7][c_]); \
      *(uint4*)(B_ + (n4 * 4 + c_) * LDS_ROW + kg * 8) = v_; } }
  GLOAD(0); LSTORE(0); __syncthreads();
  const int aoff = (wm * 64 + (lane & 31)) * LDS_ROW + (lane >> 5) * 8;
  const int boff = (wn * 64 + (lane & 31)) * LDS_ROW + (lane >> 5) * 8;
  for (int kt = 0; kt < ktiles; ++kt) {
    if (kt + 1 < ktiles) GLOAD(kt + 1);
    const bf16* A = smem + (kt & 1) * 2 * TILE_ELEMS; const bf16* B = A + TILE_ELEMS;
    bf16x8 a0 = *(const bf16x8*)(A + aoff), a1 = *(const bf16x8*)(A + aoff + 32 * LDS_ROW);
    bf16x8 b0 = *(const bf16x8*)(B + boff), b1 = *(const bf16x8*)(B + boff + 32 * LDS_ROW);
#pragma unroll
    for (int ks = 0; ks < 4; ++ks) {
      bf16x8 na0 = a0, na1 = a1, nb0 = b0, nb1 = b1;
      if (ks < 3) { na0 = *(const bf16x8*)(A + aoff + (ks + 1) * 16); na1 = *(const bf16x8*)(A + aoff + 32 * LDS_ROW + (ks + 1) * 16);
        nb0 = *(const bf16x8*)(B + boff + (ks + 1) * 16); nb1 = *(const bf16x8*)(B + boff + 32 * LDS_ROW + (ks + 1) * 16); }
      acc[0][0] = __builtin_amdgcn_mfma_f32_32x32x16_bf16(a0, b0, acc[0][0], 0, 0, 0);
      acc[0][1] = __builtin_amdgcn_mfma_f32_32x32x16_bf16(a0, b1, acc[0][1], 0, 0, 0);
      acc[1][0] = __builtin_amdgcn_mfma_f32_32x32x16_bf16(a1, b0, acc[1][0], 0, 0, 0);
      acc[1][1] = __builtin_amdgcn_mfma_f32_32x32x16_bf16(a1, b1, acc[1][1], 0, 0, 0);
      __builtin_amdgcn_sched_barrier(0);
      a0 = na0; a1 = na1; b0 = nb0; b1 = nb1;
    }
    if (kt + 1 < ktiles) LSTORE((kt + 1) & 1);
    __syncthreads();
  }
#undef GLOAD
#undef LSTORE
}
template <class AL, class BLB>
DI void gemm_mainloop_bb(f32x16 (&acc)[2][2], const AL& al, const BLB& bl, int ktiles, bf16* smem) {
  const int tid = threadIdx.x, lane = tid & 63, wave = tid >> 6, wm = wave >> 1, wn = wave & 1;
  const int arow = tid >> 3, akc = tid & 7;
  const bf16* ap0 = al.rowptr(arow) + akc * 8;
  const bf16* ap1 = al.rowptr(arow + 32) + akc * 8;
  const bf16* ap2 = al.rowptr(arow + 64) + akc * 8;
  const bf16* ap3 = al.rowptr(arow + 96) + akc * 8;
  const bf16* bp0 = bl.rowptr(arow) + akc * 8;
  const bf16* bp1 = bl.rowptr(arow + 32) + akc * 8;
  const bf16* bp2 = bl.rowptr(arow + 64) + akc * 8;
  const bf16* bp3 = bl.rowptr(arow + 96) + akc * 8;
  uint4 ra0, ra1, ra2, ra3, rb0, rb1, rb2, rb3;
#define GLOAD(kt) { const int ko_ = al.koff(kt), kb_ = bl.koff(kt); ra0 = *(const uint4*)(ap0 + ko_); ra1 = *(const uint4*)(ap1 + ko_); ra2 = *(const uint4*)(ap2 + ko_); ra3 = *(const uint4*)(ap3 + ko_); \
    rb0 = *(const uint4*)(bp0 + kb_); rb1 = *(const uint4*)(bp1 + kb_); rb2 = *(const uint4*)(bp2 + kb_); rb3 = *(const uint4*)(bp3 + kb_); }
#define LSTORE(buf) { bf16* A_ = smem + (buf) * 2 * TILE_ELEMS; bf16* B_ = A_ + TILE_ELEMS; const int o_ = arow * LDS_ROW + akc * 8; \
    *(uint4*)(A_ + o_) = ra0; *(uint4*)(A_ + o_ + 32 * LDS_ROW) = ra1; *(uint4*)(A_ + o_ + 64 * LDS_ROW) = ra2; *(uint4*)(A_ + o_ + 96 * LDS_ROW) = ra3; \
    *(uint4*)(B_ + o_) = rb0; *(uint4*)(B_ + o_ + 32 * LDS_ROW) = rb1; *(uint4*)(B_ + o_ + 64 * LDS_ROW) = rb2; *(uint4*)(B_ + o_ + 96 * LDS_ROW) = rb3; }
  GLOAD(0); LSTORE(0); __syncthreads();
  const int aoff = (wm * 64 + (lane & 31)) * LDS_ROW + (lane >> 5) * 8;
  const int boff = (wn * 64 + (lane & 31)) * LDS_ROW + (lane >> 5) * 8;
  for (int kt = 0; kt < ktiles; ++kt) {
    if (kt + 1 < ktiles) GLOAD(kt + 1);
    const bf16* A = smem + (kt & 1) * 2 * TILE_ELEMS; const bf16* B = A + TILE_ELEMS;
#pragma unroll
    for (int ks = 0; ks < 4; ++ks) {
      const bf16x8 a0 = *(const bf16x8*)(A + aoff + ks * 16), a1 = *(const bf16x8*)(A + aoff + 32 * LDS_ROW + ks * 16);
      const bf16x8 b0 = *(const bf16x8*)(B + boff + ks * 16), b1 = *(const bf16x8*)(B + boff + 32 * LDS_ROW + ks * 16);
      acc[0][0] = __builtin_amdgcn_mfma_f32_32x32x16_bf16(a0, b0, acc[0][0], 0, 0, 0);
      acc[0][1] = __builtin_amdgcn_mfma_f32_32x32x16_bf16(a0, b1, acc[0][1], 0, 0, 0);
      acc[1][0] = __builtin_amdgcn_mfma_f32_32x32x16_bf16(a1, b0, acc[1][0], 0, 0, 0);
      acc[1][1] = __builtin_amdgcn_mfma_f32_32x32x16_bf16(a1, b1, acc[1][1], 0, 0, 0);
    }
    if (kt + 1 < ktiles) LSTORE((kt + 1) & 1);
    __syncthreads();
  }
#undef GLOAD
#undef LSTORE
}

#define WAIT_V(n) asm volatile("s_waitcnt vmcnt(%0)" ::"n"(n) : "memory")
#define RAW_BARRIER() do { asm volatile("s_waitcnt lgkmcnt(0)" ::: "memory"); __builtin_amdgcn_s_barrier(); } while (0)
template <class AL, class BLB>
DI void gemm_mainloop_dma(f32x16 (&acc)[2][2], const AL& al, const BLB& bl, int ktiles, unsigned char* lds) {
  const int tid = threadIdx.x, lane = tid & 63, wave = tid >> 6, wm = wave >> 1, wn = wave & 1;
  const int r0 = 16 * (wave * 2) + (lane >> 2), r1 = r0 + 16;
  const bf16* ga0 = al.rowptr(r0) + (((lane & 3) ^ ((r0 >> 2) & 3)) << 3);
  const bf16* ga1 = al.rowptr(r1) + (((lane & 3) ^ ((r1 >> 2) & 3)) << 3);
  const bf16* gb0 = bl.rowptr(r0) + (((lane & 3) ^ ((r0 >> 2) & 3)) << 3);
  const bf16* gb1 = bl.rowptr(r1) + (((lane & 3) ^ ((r1 >> 2) & 3)) << 3);
  unsigned char* dst = lds + wave * 2048;
#define DMA_STAGE(buf, kt) { const int kt_ = (kt) < ktiles ? (kt) : ktiles - 1; const int ka_ = al.koff32(kt_), kb_ = bl.koff32(kt_); unsigned char* d_ = dst + (buf) * 16384; \
    __builtin_amdgcn_global_load_lds((const unsigned*)(ga0 + ka_), (unsigned*)(d_), 16, 0, 0); \
    __builtin_amdgcn_global_load_lds((const unsigned*)(ga1 + ka_), (unsigned*)(d_ + 1024), 16, 0, 0); \
    __builtin_amdgcn_global_load_lds((const unsigned*)(gb0 + kb_), (unsigned*)(d_ + 8192), 16, 0, 0); \
    __builtin_amdgcn_global_load_lds((const unsigned*)(gb1 + kb_), (unsigned*)(d_ + 8192 + 1024), 16, 0, 0); }
  const int r = lane & 31, hh = lane >> 5, sw = (r >> 2) & 3;
  const int oa0 = (wm * 64 + r) * 64 + (((0 + hh) ^ sw) << 4), oa1 = (wm * 64 + r) * 64 + (((2 + hh) ^ sw) << 4);
  const int ob0 = 8192 + (wn * 64 + r) * 64 + (((0 + hh) ^ sw) << 4), ob1 = 8192 + (wn * 64 + r) * 64 + (((2 + hh) ^ sw) << 4);
  __syncthreads();
  DMA_STAGE(0, 0); DMA_STAGE(1, 1); DMA_STAGE(2, 2);
  for (int t = 0; t < ktiles; ++t) {
    WAIT_V(8);
    RAW_BARRIER();
    const unsigned char* S = lds + (t & 3) * 16384;
    {
      const bf16x8 a0 = *(const bf16x8*)(S + oa0), a1 = *(const bf16x8*)(S + oa0 + 2048), b0 = *(const bf16x8*)(S + ob0), b1 = *(const bf16x8*)(S + ob0 + 2048);
      const bf16x8 c0 = *(const bf16x8*)(S + oa1), c1 = *(const bf16x8*)(S + oa1 + 2048), d0 = *(const bf16x8*)(S + ob1), d1 = *(const bf16x8*)(S + ob1 + 2048);
      acc[0][0] = __builtin_amdgcn_mfma_f32_32x32x16_bf16(a0, b0, acc[0][0], 0, 0, 0);
      acc[0][1] = __builtin_amdgcn_mfma_f32_32x32x16_bf16(a0, b1, acc[0][1], 0, 0, 0);
      acc[1][0] = __builtin_amdgcn_mfma_f32_32x32x16_bf16(a1, b0, acc[1][0], 0, 0, 0);
      acc[1][1] = __builtin_amdgcn_mfma_f32_32x32x16_bf16(a1, b1, acc[1][1], 0, 0, 0);
      acc[0][0] = __builtin_amdgcn_mfma_f32_32x32x16_bf16(c0, d0, acc[0][0], 0, 0, 0);
      acc[0][1] = __builtin_amdgcn_mfma_f32_32x32x16_bf16(c0, d1, acc[0][1], 0, 0, 0);
      acc[1][0] = __builtin_amdgcn_mfma_f32_32x32x16_bf16(c1, d0, acc[1][0], 0, 0, 0);
      acc[1][1] = __builtin_amdgcn_mfma_f32_32x32x16_bf16(c1, d1, acc[1][1], 0, 0, 0);
    }
    __builtin_amdgcn_sched_barrier(0);
    DMA_STAGE((t + 3) & 3, t + 3);
    __builtin_amdgcn_sched_barrier(0);
  }
  WAIT_V(0);
  RAW_BARRIER();
#undef DMA_STAGE
}

constexpr int M2_A_ELEMS = 256 * 40, M2_STAGE_ELEMS = M2_A_ELEMS + 4 * 128 * 8;
template <class AL, class BL>
DI void gemm_mainloop_256(f32x16 (&acc)[4][2], const AL& al, BL& bl, int ktiles, bf16* smem) {
  const int tid = threadIdx.x, lane = tid & 63, wave = tid >> 6, wm = wave >> 1, wn = wave & 1;
  const int arow = tid >> 2, akc = tid & 3, kg = tid >> 5, n4 = tid & 31;
  const bf16* abase = al.base;
  const unsigned ao0 = al.rowoff(arow) + akc * 8, ao1 = al.rowoff(arow + 64) + akc * 8, ao2 = al.rowoff(arow + 128) + akc * 8, ao3 = al.rowoff(arow + 192) + akc * 8;
  bl.init(n4 * 4);
  uint4 ra0, ra1, ra2, ra3; f32x4 rb[4];
#define GLOAD(kt) { const bf16* ab_ = abase + (kt) * 32; ra0 = *(const uint4*)(ab_ + ao0); ra1 = *(const uint4*)(ab_ + ao1); ra2 = *(const uint4*)(ab_ + ao2); ra3 = *(const uint4*)(ab_ + ao3); \
    _Pragma("unroll") for (int r_ = 0; r_ < 4; ++r_) rb[r_] = bl.ld32(kt, kg * 4 + r_); }
#define LSTORE(buf) { bf16* A_ = smem + (buf) * M2_STAGE_ELEMS; bf16* B_ = A_ + M2_A_ELEMS; const int o_ = arow * 40 + akc * 8; \
    *(uint4*)(A_ + o_) = ra0; *(uint4*)(A_ + o_ + 64 * 40) = ra1; *(uint4*)(A_ + o_ + 128 * 40) = ra2; *(uint4*)(A_ + o_ + 192 * 40) = ra3; \
    _Pragma("unroll") for (int c_ = 0; c_ < 4; ++c_) { uint2 v_; v_.x = pk2(rb[0][c_], rb[1][c_]); v_.y = pk2(rb[2][c_], rb[3][c_]); const int n_ = n4 * 4 + c_; \
      *(uint2*)(B_ + ((kg >> 1) * 128 + (n_ ^ ((n_ >> 3) & 3))) * 8 + (kg & 1) * 4) = v_; } }
  GLOAD(0); LSTORE(0); __syncthreads();
  const int r = lane & 31, hh = lane >> 5;
  const int aoff = (wm * 128 + r) * 40 + hh * 8;
  const int nb0 = wn * 64 + r, nb1 = nb0 + 32;
  const int boff0 = M2_A_ELEMS + (hh * 128 + (nb0 ^ ((nb0 >> 3) & 3))) * 8, boff1 = M2_A_ELEMS + (hh * 128 + (nb1 ^ ((nb1 >> 3) & 3))) * 8;
  for (int kt = 0; kt < ktiles; ++kt) {
    if (kt + 1 < ktiles) GLOAD(kt + 1);
    const bf16* S = smem + (kt & 1) * M2_STAGE_ELEMS;
#pragma unroll
    for (int ks = 0; ks < 2; ++ks) {
      const bf16x8 b0 = *(const bf16x8*)(S + boff0 + ks * 2 * 128 * 8), b1 = *(const bf16x8*)(S + boff1 + ks * 2 * 128 * 8);
#pragma unroll
      for (int mi = 0; mi < 4; ++mi) { const bf16x8 a = *(const bf16x8*)(S + aoff + mi * 32 * 40 + ks * 16);
        acc[mi][0] = __builtin_amdgcn_mfma_f32_32x32x16_bf16(a, b0, acc[mi][0], 0, 0, 0);
        acc[mi][1] = __builtin_amdgcn_mfma_f32_32x32x16_bf16(a, b1, acc[mi][1], 0, 0, 0); }
      __builtin_amdgcn_sched_barrier(0);
    }
    if (kt + 1 < ktiles) LSTORE((kt + 1) & 1);
    __syncthreads();
  }
#undef GLOAD
#undef LSTORE
}

template <class AL, class BLB>
DI void gemm_mainloop_dma_m256(f32x16 (&acc)[4][2], const AL& al, const BLB& bl, int ktiles, unsigned char* lds) {
  const int tid = threadIdx.x, lane = tid & 63, wave = __builtin_amdgcn_readfirstlane(tid >> 6), wm = wave >> 1, wn = wave & 1;
  const int ra_ = 16 * (wave * 4) + (lane >> 2), rb_ = 16 * (wave * 2) + (lane >> 2);
  const bf16* abase = al.rowptr(0); const bf16* bbase = bl.rowptr(0);
  const unsigned ao0 = (unsigned)(al.rowptr(ra_) - abase) + (((lane & 3) ^ ((ra_ >> 2) & 3)) << 3);
  const unsigned ao1 = (unsigned)(al.rowptr(ra_ + 16) - abase) + (((lane & 3) ^ (((ra_ + 16) >> 2) & 3)) << 3);
  const unsigned ao2 = (unsigned)(al.rowptr(ra_ + 32) - abase) + (((lane & 3) ^ (((ra_ + 32) >> 2) & 3)) << 3);
  const unsigned ao3 = (unsigned)(al.rowptr(ra_ + 48) - abase) + (((lane & 3) ^ (((ra_ + 48) >> 2) & 3)) << 3);
  const unsigned bo0 = (unsigned)(bl.rowptr(rb_) - bbase) + (((lane & 3) ^ ((rb_ >> 2) & 3)) << 3);
  const unsigned bo1 = (unsigned)(bl.rowptr(rb_ + 16) - bbase) + (((lane & 3) ^ (((rb_ + 16) >> 2) & 3)) << 3);
  constexpr int STG = 24576;
#define DMA_STAGE3(buf, kt) { const int kt_ = (kt) < ktiles ? (kt) : ktiles - 1; const bf16* ap_ = abase + al.koff32(kt_); const bf16* bp_ = bbase + bl.koff32(kt_); unsigned char* d_ = lds + (buf) * STG; \
    __builtin_amdgcn_global_load_lds((const unsigned*)(ap_ + ao0), (unsigned*)(d_ + wave * 4096), 16, 0, 0); \
    __builtin_amdgcn_global_load_lds((const unsigned*)(ap_ + ao1), (unsigned*)(d_ + wave * 4096 + 1024), 16, 0, 0); \
    __builtin_amdgcn_global_load_lds((const unsigned*)(ap_ + ao2), (unsigned*)(d_ + wave * 4096 + 2048), 16, 0, 0); \
    __builtin_amdgcn_global_load_lds((const unsigned*)(ap_ + ao3), (unsigned*)(d_ + wave * 4096 + 3072), 16, 0, 0); \
    __builtin_amdgcn_global_load_lds((const unsigned*)(bp_ + bo0), (unsigned*)(d_ + 16384 + wave * 2048), 16, 0, 0); \
    __builtin_amdgcn_global_load_lds((const unsigned*)(bp_ + bo1), (unsigned*)(d_ + 16384 + wave * 2048 + 1024), 16, 0, 0); }
  const int r = lane & 31, hh = lane >> 5, sw = (r >> 2) & 3;
  const int oa0 = (wm * 128 + r) * 64 + (((0 + hh) ^ sw) << 4), oa1 = (wm * 128 + r) * 64 + (((2 + hh) ^ sw) << 4);
  const int ob0 = 16384 + (wn * 64 + r) * 64 + (((0 + hh) ^ sw) << 4), ob1 = 16384 + (wn * 64 + r) * 64 + (((2 + hh) ^ sw) << 4);
  __syncthreads();
  DMA_STAGE3(0, 0); DMA_STAGE3(1, 1);
  int buf = 0;
  for (int t = 0; t < ktiles; ++t) {
    WAIT_V(6);
    RAW_BARRIER();
    const unsigned char* S = lds + buf * STG;
#pragma unroll
    for (int ks = 0; ks < 2; ++ks) {
      const int oa = ks ? oa1 : oa0, ob = ks ? ob1 : ob0;
      const bf16x8 b0 = *(const bf16x8*)(S + ob), b1 = *(const bf16x8*)(S + ob + 2048);
#pragma unroll
      for (int mi = 0; mi < 4; ++mi) { const bf16x8 a = *(const bf16x8*)(S + oa + mi * 2048);
        acc[mi][0] = __builtin_amdgcn_mfma_f32_32x32x16_bf16(a, b0, acc[mi][0], 0, 0, 0);
        acc[mi][1] = __builtin_amdgcn_mfma_f32_32x32x16_bf16(a, b1, acc[mi][1], 0, 0, 0); }
    }
    __builtin_amdgcn_sched_barrier(0);
    { const int nb = buf == 0 ? 2 : buf - 1; DMA_STAGE3(nb, t + 2); }
    __builtin_amdgcn_sched_barrier(0);
    buf = buf == 2 ? 0 : buf + 1;
  }
  WAIT_V(0);
  RAW_BARRIER();
#undef DMA_STAGE3
}
struct ALBlk2 { const bf16* base; int kblocks; DI const bf16* rowptr(int r) const { return base + (size_t)(r >> 7) * kblocks * 4096 + (r & 127) * 32; } DI int koff32(int kt) const { return kt * 4096; } };
struct BLRouterB { const bf16* base; DI const bf16* rowptr(int r) const { return base + (size_t)r * 2048; }
  DI int koff(int kt) const { return kt < 16 ? kt * 64 : (kt < 32 ? (kt - 16) * 64 : 1024 + (kt - 32) * 64); }
  DI int koff32(int kt) const { return kt < 32 ? kt * 32 : (kt < 64 ? (kt - 32) * 32 : 1024 + (kt - 64) * 32); } };
template <class CM>
DI void transpose_block(const float* __restrict__ W, int N, bf16* __restrict__ WT, int ldt, int k0, int n0, float* scr, int lane, CM colmap) {
  const int sc = colmap(n0 + (lane & 31));
#pragma unroll 8
  for (int i = 0; i < 32; ++i) { const int kk = 2 * i + (lane >> 5); const float wv = __builtin_nontemporal_load(W + (size_t)(k0 + kk) * N + (sc >= 0 ? sc : 0)); scr[kk * 33 + (lane & 31)] = sc >= 0 ? wv : 0.f; }
  __builtin_amdgcn_wave_barrier();
  const int c = lane & 7;
#pragma unroll
  for (int j = 0; j < 4; ++j) { const int n = (lane >> 3) + 8 * j; const float* s = scr + (8 * c) * 33 + n;
    uint4 o; o.x = pk2(s[0 * 33], s[1 * 33]); o.y = pk2(s[2 * 33], s[3 * 33]); o.z = pk2(s[4 * 33], s[5 * 33]); o.w = pk2(s[6 * 33], s[7 * 33]);
    if (ldt < 0) *(uint4*)(WT + blk_off(n0 + n, k0 + 8 * c, -ldt)) = o; else *(uint4*)(WT + (size_t)(n0 + n) * ldt + k0 + 8 * c) = o; }
  __builtin_amdgcn_wave_barrier();
}
DI void acc_zero(f32x16 (&acc)[2][2]) {
#pragma unroll
  for (int i = 0; i < 2; ++i)
#pragma unroll
    for (int j = 0; j < 2; ++j)
#pragma unroll
      for (int r = 0; r < 16; ++r) acc[i][j][r] = 0.f;
}
DI int crow(int r, int lane) { return 8 * (r >> 2) + 4 * (lane >> 5) + (r & 3); }


DI void st16_bf16(bf16* base, int ld, const float (&v)[16]) {
#pragma unroll
  for (int q = 0; q < 4; ++q) { bf16* pq = base + (size_t)(8 * q) * ld; asm volatile("" : "+v"(pq));
#pragma unroll
    for (int i = 0; i < 4; ++i) pq[(size_t)i * ld] = f2bf(v[4 * q + i]); }
}
DI void st16_f32(float* base, int ld, const float (&v)[16]) {
#pragma unroll
  for (int q = 0; q < 4; ++q) { float* pq = base + (size_t)(8 * q) * ld; asm volatile("" : "+v"(pq));
#pragma unroll
    for (int i = 0; i < 4; ++i) pq[(size_t)i * ld] = v[4 * q + i]; }
}

struct ALBlk { const bf16* base; DI const bf16* rowptr(int r) const { return base + r * 32; } DI int koff32(int kt) const { return kt * 4096; } };

constexpr int ST_LD = 132;
DI void stage_block(float* st, int ldst, int mi, int ni, const float (&v)[16]) {
  const int lane = threadIdx.x & 63, wave = threadIdx.x >> 6, wm = wave >> 1, wn = wave & 1;
  float* b = st + (wm * 64 + mi * 32 + 4 * (lane >> 5)) * ldst + wn * 64 + ni * 32 + (lane & 31);
#pragma unroll
  for (int r = 0; r < 16; ++r) b[(8 * (r >> 2) + (r & 3)) * ldst] = v[r];
}
DI void stage_acc(float* st, f32x16 (&acc)[2][2]) {
#pragma unroll
  for (int mi = 0; mi < 2; ++mi)
#pragma unroll
    for (int ni = 0; ni < 2; ++ni) { float v[16];
#pragma unroll
      for (int r = 0; r < 16; ++r) v[r] = acc[mi][ni][r];
      stage_block(st, ST_LD, mi, ni, v); }
}
DI uint4 pack8(const float* s) { const f32x4 a = *(const f32x4*)s, b = *(const f32x4*)(s + 4); uint4 o; o.x = pk2(a[0], a[1]); o.y = pk2(a[2], a[3]); o.z = pk2(b[0], b[1]); o.w = pk2(b[2], b[3]); return o; }
struct ALPlain { const bf16* base; int ld; DI const bf16* rowptr(int r) const { return base + (size_t)r * ld; } DI int koff(int kt) const { return kt * 64; } DI int koff32(int kt) const { return kt * 32; } };
struct ALGather256 { const bf16* base; const int* list; int nvalid; DI unsigned rowoff(int r) const { int rr = r < nvalid ? r : nvalid - 1; return (unsigned)(list[rr] >> 3) * 1024u; } };
struct ALRows { const bf16* base; int ld; DI unsigned rowoff(int r) const { return (unsigned)(r * ld); } };
struct ALGather { const bf16* H; const int* list; int nvalid; DI const bf16* rowptr(int r) const { int rr = r < nvalid ? r : nvalid - 1; return H + (size_t)(list[rr] >> 3) * 1024; } DI int koff(int kt) const { return kt * 64; } };
struct ALRouter { const bf16* base; DI const bf16* rowptr(int r) const { return base + (size_t)r * 1024; }
  DI int koff(int kt) const { return kt < 16 ? kt * 64 : (kt < 32 ? (int)((O_HLO - O_HHI) / 2) + (kt - 16) * 64 : (kt - 32) * 64); }
  DI int koff32(int kt) const { return kt < 32 ? kt * 32 : (kt < 64 ? (int)((O_HLO - O_HHI) / 2) + (kt - 32) * 32 : (kt - 64) * 32); } };

template <int LDB> struct BLPlain { const float* W; int n0, nmax; const float* pt; bool ok;
  DI void init(int ncol) { int n = n0 + ncol; ok = n < nmax; pt = W + (ok ? n : 0); }
  DI f32x4 ld(int kt, int krow) const { f32x4 z = {0.f, 0.f, 0.f, 0.f}; return ok ? *(const f32x4*)(pt + (size_t)(kt * 64 + krow) * LDB) : z; }
  DI f32x4 ld32(int kt, int krow) const { return *(const f32x4*)(pt + (size_t)(kt * 32 + krow) * LDB); } };
DI int srccol(int n) { return n < 1064 ? n : (n < 1088 ? n + 1280 : (n < 2368 ? n - 24 : n)); }
struct BLInproj { const float* W; int n0; const float* pt; bool ok;
  DI void init(int ncol) { int n = n0 + ncol; ok = n < NIN; pt = W + (ok ? srccol(n) : 0); }
  DI f32x4 ld(int kt, int krow) const { f32x4 z = {0.f, 0.f, 0.f, 0.f}; return ok ? *(const f32x4*)(pt + (size_t)(kt * 64 + krow) * NIN) : z; } };
struct BLGateUp { const float* Wg; long du; int hc0; const float* pt;
  DI void init(int ncol) { int wn = ncol >> 6, ni = (ncol >> 5) & 1, c = ncol & 31; pt = Wg + (long)ni * du + hc0 + wn * 32 + c; }
  DI f32x4 ld(int kt, int krow) const { return *(const f32x4*)(pt + (size_t)(kt * 64 + krow) * 256); }
  DI f32x4 ld32(int kt, int krow) const { return *(const f32x4*)(pt + (size_t)(kt * 32 + krow) * 256); } };
struct BLRouter { const float* W; int n0; const float* pt;
  DI void init(int ncol) { pt = W + n0 + ncol; }
  DI f32x4 ld(int kt, int krow) const { f32x4 w = *(const f32x4*)(pt + (size_t)((kt & 15) * 64 + krow) * 256);
    if (kt >= 32) { w[0] -= bf2f(f2bf(w[0])); w[1] -= bf2f(f2bf(w[1])); w[2] -= bf2f(f2bf(w[2])); w[3] -= bf2f(f2bf(w[3])); } return w; } };

DI float inv_freq(int i) {
  switch (i) {
    case 0: return 1.0f; case 1: return 0.1939227432012558f; case 2: return 0.03760603070259094f; case 3: return 0.007292664609849453f;
    case 4: return 0.0014142135623842478f; case 5: return 0.00027424818836152554f; case 6: return 5.3182957344688475e-05f; case 7: return 1.0313385246263351e-05f;
    case 8: return 1.0f; case 9: return 0.03760603070259094f; case 10: return 0.0014142135623842478f; default: return 5.3182957344688475e-05f;
  }
}

DI void conv_wave_item(PR p, int w, float* scr, int lane) {
  unsigned char* ws = p.ws;
  if (w < 2240) { const int nb = w % 140, kb = w / 140;
    transpose_block(p.w_in, NIN, (bf16*)(ws + O_WT_IN), -1024, kb * 64, nb * 32, scr, lane, [](int n) { return n < NIN ? srccol(n) : -1; }); return; }
  w -= 2240;
  if (w < 512) { const int which = w >> 8, q = w & 255, nb = q & 31, kb = q >> 5;
    transpose_block(which ? p.w_br_b : p.w_br_a, 1024, (bf16*)(ws + (which ? O_WT_BRB : O_WT_BRA)), 512, kb * 64, nb * 32, scr, lane, [](int n) { return n; }); return; }
  w -= 512;
  if (w < 512) { const int nb = w & 31, kb = w >> 5;
    transpose_block(p.w_out, 1024, (bf16*)(ws + O_WT_OUT), 1024, kb * 64, nb * 32, scr, lane, [](int n) { return n; }); return; }
  w -= 512;
  if (w < 256) {
    const int lo = w >> 7, q = w & 127, nb = q & 7, kb = q >> 3, k0 = kb * 64, n0 = nb * 32;
#pragma unroll 8
    for (int i = 0; i < 32; ++i) { const int kk = 2 * i + (lane >> 5); float v = p.w_router[(size_t)(k0 + kk) * 256 + n0 + (lane & 31)]; if (lo) v -= bf2f(f2bf(v)); scr[kk * 33 + (lane & 31)] = v; }
    __builtin_amdgcn_wave_barrier();
    const int c = lane & 7; bf16* WT = (bf16*)(ws + O_WT_RT) + lo * 1024;
#pragma unroll
    for (int j = 0; j < 4; ++j) { const int n = (lane >> 3) + 8 * j; const float* s = scr + (8 * c) * 33 + n;
      uint4 o; o.x = pk2(s[0 * 33], s[1 * 33]); o.y = pk2(s[2 * 33], s[3 * 33]); o.z = pk2(s[4 * 33], s[5 * 33]); o.w = pk2(s[6 * 33], s[7 * 33]);
      *(uint4*)(WT + (size_t)(n0 + n) * 2048 + k0 + 8 * c) = o; }
    __builtin_amdgcn_wave_barrier();
    return; }
  w -= 256;
  if (w < 256) {
    const int nb = w & 15, kb = w >> 4, nt = nb >> 2, wn = (nb >> 1) & 1, ni = nb & 1, sc0 = nt * 64 + wn * 32 - nb * 32;
    transpose_block(ni ? p.w_sh_up : p.w_sh_gate, 256, (bf16*)(ws + O_WT_SGU), 1024, kb * 64, nb * 32, scr, lane, [sc0](int n) { return n + sc0; }); return; }
  w -= 256;
  if (w < 128) { const int nb = w & 31, kb = w >> 5;
    transpose_block(p.w_sh_down, 1024, (bf16*)(ws + O_WT_SD), 256, kb * 64, nb * 32, scr, lane, [](int n) { return n; }); return; }
  w -= 128;
  if (w < 512) { const int which = w >> 8, q = w & 255, nb = q & 7, kb = q >> 3;
    transpose_block(which ? p.cmp_v_w1 : p.cmp_k_w1, 256, (bf16*)(ws + (which ? O_WT_C1V : O_WT_C1K)), 2048, kb * 64, nb * 32, scr, lane, [](int n) { return n; }); return; }
  w -= 512;
  if (w < 32) { const int which = w >> 4, q = w & 15, nb = q & 3, kb = q >> 2;
    transpose_block(which ? p.cmp_v_w2 : p.cmp_k_w2, 64, (bf16*)(ws + (which ? O_WT_C2V : O_WT_C2K)), 256, kb * 64, nb * 32, scr, lane, [](int n) { return n < 64 ? n : -1; }); return; }
}
constexpr int N_CONV_WAVE = 2240 + 512 + 512 + 256 + 256 + 128 + 512 + 32;
DI void ph_prologue(PR p, unsigned char* smem, int* qctr, int* shv) {
  float* sc = (float*)smem;
  constexpr int N_MOD = 96, N_TAB = T * 12 / 256, N_CB = 64, N_CV = N_CONV_WAVE / 4;
  const int G = gridDim.x; constexpr int NR = N_TAB + N_CB + N_CV; const bool split = G >= 2 * N_MOD;
  for (int s = 0;; ++s) {
    int it;
    if (split) { if ((int)blockIdx.x < N_MOD) { if (s) break; it = blockIdx.x; } else { const int r = ((int)blockIdx.x - N_MOD) + s * (G - N_MOD); if (r >= NR) break; it = N_MOD + r; } }
    else { it = blockIdx.x + s * G; if (it >= N_MOD + NR) break; }
    __syncthreads();
    if (it < N_MOD) {
      { f32x4 cv[16];
#pragma unroll
        for (int u = 0; u < 16; ++u) cv[u] = *(const f32x4*)(p.c + (threadIdx.x + 256 * u) * 4);
#pragma unroll
        for (int u = 0; u < 16; ++u) { f32x4 s; s[0] = siluf_(cv[u][0]); s[1] = siluf_(cv[u][1]); s[2] = siluf_(cv[u][2]); s[3] = siluf_(cv[u][3]); *(f32x4*)(sc + (threadIdx.x + 256 * u) * 4) = s; } }
      __syncthreads();
      const int kq = threadIdx.x >> 6, cidx = threadIdx.x & 63, j = it * 64 + cidx;
      float a[16];
#pragma unroll
      for (int b = 0; b < 16; ++b) a[b] = 0.f;
      const float* wp = p.w_ada + (size_t)(kq * 256) * 6144 + j;
      float wb[16];
#pragma unroll
      for (int u = 0; u < 16; ++u) wb[u] = __builtin_nontemporal_load(wp + (size_t)u * 6144);
      for (int k0 = 0; k0 < 256; k0 += 16) {
        float wn[16];
#pragma unroll
        for (int u = 0; u < 16; ++u) wn[u] = (k0 + 16 < 256) ? __builtin_nontemporal_load(wp + (size_t)(k0 + 16 + u) * 6144) : 0.f;
#pragma unroll
        for (int u = 0; u < 16; ++u) {
#pragma unroll
          for (int b = 0; b < 16; ++b) a[b] += sc[b * 1024 + kq * 256 + k0 + u] * wb[u]; }
#pragma unroll
        for (int u = 0; u < 16; ++u) wb[u] = wn[u];
      }
      __syncthreads();
      float* part = sc;
#pragma unroll
      for (int b = 0; b < 16; ++b) part[(kq * 16 + b) * 64 + cidx] = a[b];
      __syncthreads();
      for (int o = threadIdx.x; o < 1024; o += 256) { const int b = o >> 6, cc = o & 63, jj = it * 64 + cc;
        const float s = ((part[(0 * 16 + b) * 64 + cc] + part[(1 * 16 + b) * 64 + cc]) + (part[(2 * 16 + b) * 64 + cc] + part[(3 * 16 + b) * 64 + cc]));
        ((float*)(p.ws + O_MOD))[b * 6144 + jj] = s + p.b_ada[jj]; }
    } else if (it < N_MOD + N_TAB) {
      const int idx = (it - N_MOD) * 256 + threadIdx.x; const int tok = idx / 12, i = idx % 12;
      const float ang = (float)p.pos[tok] * inv_freq(i);
      double rev = (double)ang * 0.15915494309189535; rev -= rint(rev);
      const float a = (float)(rev * 6.283185307179586);
      const float sn = sinf(a), cs = cosf(a);
      if (i < 8) { float* r = (float*)(p.ws + O_ROPEH) + (size_t)tok * 16; r[i] = cs; r[8 + i] = sn; }
      else { float* r = (float*)(p.ws + O_ROPEI) + (size_t)tok * 8; r[i - 8] = cs; r[4 + i - 8] = sn; }
    } else if (it >= N_MOD + N_TAB + N_CB) {
      conv_wave_item(p, (it - N_MOD - N_TAB - N_CB) * 4 + (threadIdx.x >> 6), (float*)smem + (threadIdx.x >> 6) * (64 * 33), threadIdx.x & 63);
    } else {
      const int q = it - N_MOD - N_TAB, which = q >> 5, kc = q & 31, j = threadIdx.x;
      const float* pos = which ? p.cmp_pos_v : p.cmp_pos_k; const float* w1 = which ? p.cmp_v_w1 : p.cmp_k_w1;
      float acc = 0.f;
      for (int k = kc * 64; k < kc * 64 + 64; ++k) acc += pos[k] * w1[(size_t)k * 256 + j];
      ((float*)(p.ws + O_CMPB))[(which * 32 + kc) * 256 + j] = acc;
    }
  }
}
DI void ph_u(PR p) {
  const float* modb = (const float*)(p.ws + O_MOD); bf16* U = (bf16*)(p.ws + O_U);
  const size_t nthr = (size_t)gridDim.x * 256;
  for (size_t i4 = (size_t)blockIdx.x * 256 + threadIdx.x; i4 < (size_t)T * 256; i4 += 4 * nthr) {
    float4 xv[4];
#pragma unroll
    for (int u = 0; u < 4; ++u) { const f32x4 t_ = __builtin_nontemporal_load((const f32x4*)(p.x + (i4 + u * nthr) * 4)); xv[u].x = t_[0]; xv[u].y = t_[1]; xv[u].z = t_[2]; xv[u].w = t_[3]; }
#pragma unroll
    for (int u = 0; u < 4; ++u) {
      const size_t e = (i4 + u * nthr) * 4; const int tok = (int)(e >> 10), col = (int)(e & 1023), b = tok >> 11;
      const float* mod = modb + b * 6144;
      const float4 sh = *(const float4*)(mod + col), sc = *(const float4*)(mod + 1024 + col);
      uint2 o; o.x = pk2(xv[u].x * (1.f + sc.x) + sh.x, xv[u].y * (1.f + sc.y) + sh.y); o.y = pk2(xv[u].z * (1.f + sc.z) + sh.z, xv[u].w * (1.f + sc.w) + sh.w);
      *(uint2*)(U + blk_off(tok, col, 1024)) = o;
    }
  }
}
DI bool is_rope_head_seg(int n) { return n < 640 || (n >= 1088 && n < 1600) || (n >= 1856 && n < 1984) || (n >= 2112 && n < 2240); }
DI float rope_h(const float* ropeH, int tok, int d, float v, float vp) { int i = d & 7; float cs = ropeH[(size_t)tok * 16 + i], sn = ropeH[(size_t)tok * 16 + 8 + i]; return (d < 8) ? v * cs - vp * sn : v * cs + vp * sn; }
DI float rope_i(const float* ropeI, int tok, int d, float v, float vp) { int i = d & 3; float cs = ropeI[(size_t)tok * 8 + i], sn = ropeI[(size_t)tok * 8 + 4 + i]; return (d < 4) ? v * cs - vp * sn : v * cs + vp * sn; }

DI bf16* inproj_dst(unsigned char* ws, int tok, int n, bool raw) {
  if (n < 512) return (bf16*)(ws + O_QA) + (size_t)tok * 512 + n;
  if (n < 640) return (bf16*)(ws + O_KA) + (size_t)tok * 128 + n - 512;
  if (n < 1024) return (bf16*)(ws + O_QI) + (size_t)tok * 256 + n - 768;
  if (n < 1056) return (bf16*)(ws + O_KI) + (size_t)tok * 32 + n - 1024;
  if (n < 1600) return (bf16*)(ws + (raw ? O_QBR : O_QBT)) + (size_t)tok * 512 + n - 1088;
  if (n < 1856) { const int cc = (n - 1600) & 127; return (bf16*)(ws + (n < 1728 ? O_KC : O_VC)) + ((size_t)((tok >> 11) * 2 + (cc >> 6)) * 2048 + (tok & 2047)) * 64 + (cc & 63); }
  if (n < 1984) return (bf16*)(ws + O_KS) + (size_t)tok * 128 + n - 1856;
  if (n < 2240) return (bf16*)(ws + O_KW) + (size_t)tok * 128 + n - 2112;
  if (n < 3392) return (bf16*)(ws + O_SGA) + (size_t)tok * 1024 + n - 2368;
  return (bf16*)(ws + O_SGB) + (size_t)tok * 1024 + n - 3392;
}
DI void inproj_copyout(unsigned char* ws, const float* st, int m0, int n0, bool raw_pass) {
  const int bidx = m0 >> 11;
#pragma unroll 1
  for (int sub = 0; sub < 4; ++sub) {
    const int nsub = n0 + sub * 32;
    if (nsub >= NIN) break;
    if (nsub == 1056) continue;
    if (raw_pass && !(nsub >= 1088 && nsub < 1600)) continue;
    const int tseg = (nsub >= 640 && nsub < 768) ? 0 : ((nsub >= 1984 && nsub < 2112) ? 1 : ((nsub >= 2240 && nsub < 2368) ? 2 : -1));
#pragma unroll
    for (int j = 0; j < 2; ++j) { const int u = threadIdx.x + 256 * j;
      if (tseg < 0) { const int row = u >> 2, cg = u & 3;
        *(uint4*)inproj_dst(ws, m0 + row, nsub + cg * 8, raw_pass) = pack8(st + row * ST_LD + sub * 32 + cg * 8);
      } else {
        const int d = u & 31, rg = u >> 5; const float* s = st + (rg * 8) * ST_LD + sub * 32 + d;
        uint4 o; o.x = pk2(s[0], s[ST_LD]); o.y = pk2(s[2 * ST_LD], s[3 * ST_LD]); o.z = pk2(s[4 * ST_LD], s[5 * ST_LD]); o.w = pk2(s[6 * ST_LD], s[7 * ST_LD]);
        const int cc = nsub - (tseg == 0 ? 640 : (tseg == 1 ? 1984 : 2240)) + d;
        bf16* dst = (bf16*)(ws + (tseg == 0 ? O_VAT : (tseg == 1 ? O_VST : O_VWT))) + ((size_t)(bidx * 2 + (cc >> 6)) * 64 + (cc & 63)) * 2048 + (m0 & 2047) + rg * 8;
        *(uint4*)dst = o; }
    }
  }
}
DI void inproj_epilogue(PR p, f32x16 (&acc)[2][2], int m0, int n0, float* st) {
  unsigned char* ws = p.ws;
  const int lane = threadIdx.x & 63, wave = threadIdx.x >> 6, wm = wave >> 1, wn = wave & 1, c = lane & 31, h4 = 4 * (lane >> 5);
  const float* ropeH = (const float*)(ws + O_ROPEH); const float* ropeI = (const float*)(ws + O_ROPEI);
#pragma unroll
  for (int ni = 0; ni < 2; ++ni) {
    const int nsub = n0 + wn * 64 + ni * 32;
    if (nsub >= NIN) continue;
    const bool hrope = is_rope_head_seg(nsub) && ((nsub & 63) == 0);
    const bool irope = nsub >= 768 && nsub < 1056;
#pragma unroll
    for (int mi = 0; mi < 2; ++mi) {
      const int tok0 = m0 + wm * 64 + mi * 32 + h4;
      float v[16], vr[16];
#pragma unroll
      for (int r = 0; r < 16; ++r) { v[r] = acc[mi][ni][r]; vr[r] = v[r]; }
      if (hrope) {
        const float* rp = ropeH + (size_t)tok0 * 16 + (c & 7); asm volatile("" : "+v"(rp));
#pragma unroll
        for (int r = 0; r < 16; ++r) { const float vp = __shfl_xor(v[r], 8); const int ro = (8 * (r >> 2) + (r & 3)) * 16;
          const float cs = rp[ro], sn = rp[ro + 8]; const float vrot = (c < 8) ? v[r] * cs - vp * sn : v[r] * cs + vp * sn; vr[r] = (c < 16) ? vrot : v[r]; }
      } else if (irope) {
        const float* rp = ropeI + (size_t)tok0 * 8 + (c & 3); asm volatile("" : "+v"(rp));
#pragma unroll
        for (int r = 0; r < 16; ++r) { const float vp = __shfl_xor(v[r], 4); const int ro = (8 * (r >> 2) + (r & 3)) * 8;
          const float cs = rp[ro], sn = rp[ro + 4]; const float vrot = (c < 4) ? v[r] * cs - vp * sn : v[r] * cs + vp * sn; vr[r] = (c < 8) ? vrot : v[r]; }
      }
      if (nsub == 1056) {
        if (c < 8) {
#pragma unroll
          for (int r = 0; r < 16; ++r) vr[r] = v[r] * 0.0625f;
          st16_f32((float*)(ws + O_WI) + (size_t)tok0 * 8 + c, 8, vr);
        } else {
#pragma unroll
          for (int r = 0; r < 16; ++r) vr[r] = sigmoidf_(v[r]);
          st16_f32((float*)(ws + O_GN) + (size_t)tok0 * 24 + c - 8, 24, vr);
        }
      } else {
        if (nsub >= 2368) {
#pragma unroll
          for (int r = 0; r < 16; ++r) vr[r] = sigmoidf_(v[r]);
        }
        stage_block(st, ST_LD, mi, ni, vr);
      }
    }
  }
  __syncthreads();
  inproj_copyout(ws, st, m0, n0, false);
  if (n0 + 128 > 1088 && n0 < 1600) {
    __syncthreads();
#pragma unroll
    for (int ni = 0; ni < 2; ++ni) { const int nsub = n0 + wn * 64 + ni * 32;
      if (nsub >= 1088 && nsub < 1600) {
#pragma unroll
        for (int mi = 0; mi < 2; ++mi) { float v[16];
#pragma unroll
          for (int r = 0; r < 16; ++r) v[r] = acc[mi][ni][r];
          stage_block(st, ST_LD, mi, ni, v); } } }
    __syncthreads();
    inproj_copyout(ws, st, m0, n0, true);
  }
}
DI void inproj_copyout2(unsigned char* ws, const float* st, int m0, int n0) {
  const int bidx = m0 >> 11;
  const float* ropeH = (const float*)(ws + O_ROPEH); const float* ropeI = (const float*)(ws + O_ROPEI);
#pragma unroll 1
  for (int sub = 0; sub < 4; ++sub) {
    const int nsub = n0 + sub * 32;
    if (nsub >= NIN) break;
    if (nsub == 1056) {
#pragma unroll
      for (int j = 0; j < 2; ++j) { const int u = threadIdx.x + 256 * j, row = u >> 2, cg = u & 3, tok = m0 + row;
        const float* s = st + row * ST_LD + sub * 32 + cg * 8; f32x4 va = *(const f32x4*)s, vb = *(const f32x4*)(s + 4);
        if (cg == 0) { va *= 0.0625f; vb *= 0.0625f; float* d = (float*)(ws + O_WI) + (size_t)tok * 8; *(f32x4*)d = va; *(f32x4*)(d + 4) = vb; }
        else { float* d = (float*)(ws + O_GN) + (size_t)tok * 24 + (cg - 1) * 8;
          f32x4 ga, gb; ga[0] = sigmoidf_(va[0]); ga[1] = sigmoidf_(va[1]); ga[2] = sigmoidf_(va[2]); ga[3] = sigmoidf_(va[3]); gb[0] = sigmoidf_(vb[0]); gb[1] = sigmoidf_(vb[1]); gb[2] = sigmoidf_(vb[2]); gb[3] = sigmoidf_(vb[3]);
          *(f32x4*)d = ga; *(f32x4*)(d + 4) = gb; } }
      continue;
    }
    const int tseg = (nsub >= 640 && nsub < 768) ? 0 : ((nsub >= 1984 && nsub < 2112) ? 1 : ((nsub >= 2240 && nsub < 2368) ? 2 : -1));
    const bool hrope = is_rope_head_seg(nsub) && ((nsub & 63) == 0), irope = nsub >= 768 && nsub < 1056, qb = nsub >= 1088 && nsub < 1600;
#pragma unroll
    for (int j = 0; j < 2; ++j) { const int u = threadIdx.x + 256 * j;
      if (tseg < 0) { const int row = u >> 2, cg = u & 3, tok = m0 + row;
        const float* s = st + row * ST_LD + sub * 32 + cg * 8;
        const f32x4 va = *(const f32x4*)s, vb = *(const f32x4*)(s + 4);
        float o[8] = {va[0], va[1], va[2], va[3], vb[0], vb[1], vb[2], vb[3]};
        if (nsub >= 2368) {
#pragma unroll
          for (int e = 0; e < 8; ++e) o[e] = __builtin_amdgcn_rcpf(1.f + __expf(-o[e])); }
        if (qb) { uint4 ro; ro.x = pk2(o[0], o[1]); ro.y = pk2(o[2], o[3]); ro.z = pk2(o[4], o[5]); ro.w = pk2(o[6], o[7]); *(uint4*)inproj_dst(ws, tok, nsub + cg * 8, true) = ro; }
        if (hrope && cg < 2) {
          const float* ps = st + row * ST_LD + sub * 32 + (cg ^ 1) * 8; const f32x4 pa = *(const f32x4*)ps, pb = *(const f32x4*)(ps + 4);
          const float* rp = ropeH + (size_t)tok * 16; const f32x4 ca = *(const f32x4*)rp, cb = *(const f32x4*)(rp + 4), sa = *(const f32x4*)(rp + 8), sb = *(const f32x4*)(rp + 12);
          const float sg = cg == 0 ? -1.f : 1.f;
#pragma unroll
          for (int e = 0; e < 4; ++e) { o[e] = o[e] * ca[e] + sg * pa[e] * sa[e]; o[4 + e] = o[4 + e] * cb[e] + sg * pb[e] * sb[e]; }
        } else if (irope && cg == 0) {
          const float* rp = ropeI + (size_t)tok * 8; const f32x4 cs = *(const f32x4*)rp, sn = *(const f32x4*)(rp + 4);
#pragma unroll
          for (int e = 0; e < 4; ++e) { const float x1 = o[e], x2 = o[4 + e]; o[e] = x1 * cs[e] - x2 * sn[e]; o[4 + e] = x2 * cs[e] + x1 * sn[e]; }
        }
        uint4 r; r.x = pk2(o[0], o[1]); r.y = pk2(o[2], o[3]); r.z = pk2(o[4], o[5]); r.w = pk2(o[6], o[7]);
        if (nsub >= 2368) { typedef unsigned u32x4_t __attribute__((ext_vector_type(4))); u32x4_t rv = {r.x, r.y, r.z, r.w}; __builtin_nontemporal_store(rv, (u32x4_t*)inproj_dst(ws, tok, nsub + cg * 8, false)); }
        else *(uint4*)inproj_dst(ws, tok, nsub + cg * 8, false) = r;
      } else {
        const int d = u & 31, rg = u >> 5; const float* s = st + (rg * 8) * ST_LD + sub * 32 + d;
        uint4 o; o.x = pk2(s[0], s[ST_LD]); o.y = pk2(s[2 * ST_LD], s[3 * ST_LD]); o.z = pk2(s[4 * ST_LD], s[5 * ST_LD]); o.w = pk2(s[6 * ST_LD], s[7 * ST_LD]);
        const int cc = nsub - (tseg == 0 ? 640 : (tseg == 1 ? 1984 : 2240)) + d;
        bf16* dst = (bf16*)(ws + (tseg == 0 ? O_VAT : (tseg == 1 ? O_VST : O_VWT))) + ((size_t)(bidx * 2 + (cc >> 6)) * 64 + (cc & 63)) * 2048 + (m0 & 2047) + rg * 8;
        *(uint4*)dst = o; }
    }
  }
}
DI void inproj_epilogue_m256(PR p, f32x16 (&acc)[4][2], int m0, int n0, float* st) {
  unsigned char* ws = p.ws;
  const int lane = threadIdx.x & 63, wave = threadIdx.x >> 6, wm = wave >> 1, wn = wave & 1, c = lane & 31, h4 = 4 * (lane >> 5);
#pragma unroll 1
  for (int h = 0; h < 2; ++h) {
    if (wm == h) {
#pragma unroll
      for (int ni = 0; ni < 2; ++ni) {
        const int nsub = n0 + wn * 64 + ni * 32;
        if (nsub >= NIN) continue;
#pragma unroll
        for (int mi = 0; mi < 4; ++mi) { float* bq = st + (mi * 32 + h4) * ST_LD + wn * 64 + ni * 32 + c;
#pragma unroll
          for (int r = 0; r < 16; ++r) bq[(8 * (r >> 2) + (r & 3)) * ST_LD] = acc[mi][ni][r]; }
      }
    }
    __syncthreads();
    inproj_copyout2(ws, st, m0 + h * 128, n0);
    __syncthreads();
  }
}
DI void ph_inproj(PR p, bf16* smem, int* ctrs, int* shv) {
  const int myx = xcc_id(); int off = 0, x, idx;
  while (shard_next(ctrs, myx, off, [](int) { return 560; }, shv, x, idx)) {
    const int g = idx / 280, rem = idx % 280, nt = rem >> 3, mt = x * 16 + g * 8 + (rem & 7), m0 = mt * 256, n0 = nt * 128;
    f32x16 acc[4][2];
#pragma unroll
    for (int mi = 0; mi < 4; ++mi)
#pragma unroll
      for (int r = 0; r < 16; ++r) { acc[mi][0][r] = 0.f; acc[mi][1][r] = 0.f; }
    ALBlk2 al{(const bf16*)(p.ws + O_U) + (size_t)m0 * 1024, 32};
    ALBlk bl{(const bf16*)(p.ws + O_WT_IN) + (size_t)n0 * 1024};
    gemm_mainloop_dma_m256(acc, al, bl, 32, (unsigned char*)smem);
    inproj_epilogue_m256(p, acc, m0, n0, (float*)smem);
  }
}

DI void idx_scores_item(PR p, int it, float* qs  ) {
  const int tok = it >> 3, kb = it & 7, t = tok & 2047, b = tok >> 11, s = kb * 256 + threadIdx.x;
  if (kb * 256 > t) return;
  qs[threadIdx.x] = bf2f(((const bf16*)(p.ws + O_QI))[(size_t)tok * 256 + threadIdx.x]);
  if (threadIdx.x < 8) qs[256 + threadIdx.x] = ((const float*)(p.ws + O_WI))[(size_t)tok * 8 + threadIdx.x];
  __syncthreads();
  if (s <= t) {
    const bf16* kr = (const bf16*)(p.ws + O_KI) + (size_t)(b * 2048 + s) * 32;
    float kf[32];
#pragma unroll
    for (int d8 = 0; d8 < 4; ++d8) { const uint4 u = *(const uint4*)(kr + d8 * 8);
      kf[d8 * 8 + 0] = __uint_as_float(u.x << 16); kf[d8 * 8 + 1] = __uint_as_float(u.x & 0xffff0000u); kf[d8 * 8 + 2] = __uint_as_float(u.y << 16); kf[d8 * 8 + 3] = __uint_as_float(u.y & 0xffff0000u);
      kf[d8 * 8 + 4] = __uint_as_float(u.z << 16); kf[d8 * 8 + 5] = __uint_as_float(u.z & 0xffff0000u); kf[d8 * 8 + 6] = __uint_as_float(u.w << 16); kf[d8 * 8 + 7] = __uint_as_float(u.w & 0xffff0000u); }
    float sc = 0.f;
#pragma unroll
    for (int h = 0; h < 8; ++h) { float dt = 0.f;
#pragma unroll
      for (int d = 0; d < 32; ++d) dt += qs[h * 32 + d] * kf[d];
      sc += qs[256 + h] * fmaxf(dt, 0.f); }
    ((float*)(p.ws + O_SC))[(size_t)tok * 2048 + s] = sc;
  }
  __syncthreads();
}

DI unsigned fkey(float f) { f += 0.f; unsigned u = __float_as_uint(f); return (u & 0x80000000u) ? ~u : (u | 0x80000000u); }
DI void select_row(const float* __restrict__ sc, int t, unsigned long long* __restrict__ mrow, unsigned* hist, int lane) {
  if (t < 256) {
    if (lane < 32) { int lo = lane * 64; unsigned long long w = (t >= lo + 63) ? ~0ull : (t < lo ? 0ull : ((2ull << (t - lo)) - 1ull)); mrow[lane] = w; }
    return;
  }
  unsigned key[32];
#pragma unroll
  for (int i = 0; i < 32; ++i) key[i] = __float_as_uint(sc[i * 64 + lane]);
#pragma unroll
  for (int i = 0; i < 32; ++i) { const int s = i * 64 + lane; const unsigned k = fkey(__uint_as_float(key[i])); key[i] = (s <= t) ? k : 0u; }
  unsigned prefix = 0; int krem = 256, cbin = 0;
#pragma unroll
  for (int pass = 0; pass < 4; ++pass) {
    const int shift = 24 - 8 * pass;
    const unsigned mhi = pass == 0 ? 0u : (0xFFFFFFFFu << (shift + 8));
#pragma unroll
    for (int z = 0; z < 16; ++z) hist[lane + 64 * z] = 0;
    __builtin_amdgcn_wave_barrier();
#pragma unroll
    for (int i = 0; i < 32; ++i) { unsigned k = key[i]; if (k != 0u && ((k ^ prefix) & mhi) == 0u) atomicAdd(&hist[(lane & 3) * 256 + ((k >> shift) & 255u)], 1u); }
    __builtin_amdgcn_wave_barrier();
    int c0 = 0, c1 = 0, c2 = 0, c3 = 0;
#pragma unroll
    for (int z = 0; z < 4; ++z) { const uint4 hv = *(const uint4*)(hist + z * 256 + 4 * lane); c0 += hv.x; c1 += hv.y; c2 += hv.z; c3 += hv.w; }
    __builtin_amdgcn_wave_barrier();
    const int tot = c0 + c1 + c2 + c3; int suf = tot;
#pragma unroll
    for (int o = 1; o < 64; o <<= 1) { int v = __shfl_down(suf, o); if (lane + o < 64) suf += v; }
    const int a3 = suf - tot, a2 = a3 + c3, a1 = a2 + c2, a0 = a1 + c1;
    int fj = -1, fa = 0, fc = 0;
    if (a3 < krem && krem <= a3 + c3) { fj = 3; fa = a3; fc = c3; }
    else if (a2 < krem && krem <= a2 + c2) { fj = 2; fa = a2; fc = c2; }
    else if (a1 < krem && krem <= a1 + c1) { fj = 1; fa = a1; fc = c1; }
    else if (a0 < krem && krem <= a0 + c0) { fj = 0; fa = a0; fc = c0; }
    const unsigned long long bal = __ballot(fj >= 0);
    const int fl = bal ? (__ffsll((long long)bal) - 1) : 0;
    const int pk_ = __shfl((fj << 28) | (fc << 14) | fa, fl);
    prefix |= (unsigned)(4 * fl + ((pk_ >> 28) & 3)) << shift;
    krem -= pk_ & 0x3fff; cbin = (pk_ >> 14) & 0x3fff;
    if (cbin == krem) break;
  }
  int running = 0; unsigned long long myw = 0ull;
  if (cbin == krem) {
#pragma unroll
    for (int i = 0; i < 32; ++i) { const unsigned long long bs = __ballot(key[i] >= prefix); if (lane == i) myw = bs; }
  } else
#pragma unroll
  for (int i = 0; i < 32; ++i) {
    const bool eq = key[i] == prefix;
    const unsigned long long be = __ballot(eq);
    const int rank = running + __popcll(be & ((1ull << lane) - 1ull));
    const bool sel = key[i] > prefix || (eq && rank < krem);
    running += __popcll(be);
    const unsigned long long bs = __ballot(sel);
    if (lane == i) myw = bs;
  }
  if (lane < 32) mrow[lane] = myw;
}

template <class Pred>
DI float attn_wave(const bf16* __restrict__ Kb, const bf16* __restrict__ Vt, float q, int s_lo, int s_hi, Pred pred, int lane) {
  float m = NEGF, l = 0.f, acc = 0.f;
  for (int s = s_lo; s <= s_hi; ++s) {
    if (!pred(s)) continue;
    float sc = wave_sum(q * bf2f(Kb[(size_t)s * 128 + lane])) * 0.125f;
    float mn = fmaxf(m, sc), corr = __expf(m - mn), pp = __expf(sc - mn);
    l = l * corr + pp; acc = acc * corr + pp * bf2f(Vt[(size_t)lane * 2048 + s]); m = mn;
  }
  return l > 0.f ? acc / l : 0.f;
}
DI void dsa_naive_wave(PR p, int wid, int lane) {
  const int tok = wid >> 3, h = wid & 7, g = h >> 2, b = tok >> 11, t = tok & 2047;
  const unsigned* mrow = (const unsigned*)(p.ws + O_DSAM) + (size_t)tok * 64;
  float q = bf2f(((const bf16*)(p.ws + O_QA))[(size_t)tok * 512 + h * 64 + lane]);
  float o = attn_wave((const bf16*)(p.ws + O_KA) + (size_t)b * 2048 * 128 + g * 64, (const bf16*)(p.ws + O_VAT) + (size_t)(b * 2 + g) * 64 * 2048, q, 0, t,
                      [&](int s) { return (mrow[s >> 5] >> (s & 31)) & 1u; }, lane);
  ((bf16*)(p.ws + O_OA))[(size_t)tok * 512 + h * 64 + lane] = f2bf(o);
}
DI void cmpattn_naive_wave(PR p, int wid, int lane, float* qsh  , float* psh  ) {
  const int tok = wid >> 1, g = wid & 1, b = tok >> 11, t = tok & 2047;
  const bf16* kcc = (const bf16*)(p.ws + O_KCC) + (size_t)(b * 2 + g) * 128 * 64;
  const bf16* vct = (const bf16*)(p.ws + O_VCCT) + (size_t)(b * 2 + g) * 64 * 128;
  const float* gn = (const float*)(p.ws + O_GN) + (size_t)tok * 24;
  const int c0 = lane, c1 = lane + 64;
  const bool v0 = (16 * c0 + 31) <= t, v1 = (c1 < 127) && ((16 * c1 + 31) <= t);
  float ps0 = 0.f, ps1 = 0.f;
  for (int r = 0; r < 4; ++r) {
    const int h = g * 4 + r;
    qsh[lane] = bf2f(((const bf16*)(p.ws + O_QBR))[(size_t)tok * 512 + h * 64 + lane]);
    __builtin_amdgcn_wave_barrier();
    float d0 = 0.f, d1 = 0.f;
    for (int d = 0; d < 64; ++d) { float qd = qsh[d]; d0 += qd * bf2f(kcc[c0 * 64 + d]); d1 += qd * bf2f(kcc[(c1 & 127) * 64 + d]); }
    float s0 = v0 ? d0 * 0.125f : NEGF, s1 = v1 ? d1 * 0.125f : NEGF;
    float m = wave_max(fmaxf(s0, s1));
    float e0 = v0 ? __expf(s0 - m) : 0.f, e1 = v1 ? __expf(s1 - m) : 0.f;
    float sum = wave_sum(e0 + e1), inv = 1.f / fmaxf(sum, 1e-30f);
    float p0 = e0 * inv, p1 = e1 * inv;
    ps0 += p0; ps1 += p1;
    float o = 0.f;
    for (int c = 0; c < 127; ++c) { float pc = __shfl(c < 64 ? p0 : p1, c & 63); o += pc * bf2f(vct[lane * 128 + c]); }
    ((bf16*)(p.ws + O_OCMP))[(size_t)tok * 512 + h * 64 + lane] = f2bf(gn[h * 3 + 0] * o);
    __builtin_amdgcn_wave_barrier();
  }
  psh[c0] = ps0; psh[c1] = ps1;
  __builtin_amdgcn_wave_barrier();
  const int j = lane & 31, cur = t >> 6;
  float imp = 0.f;
  for (int c = 4 * j - 1; c <= 4 * j + 3; ++c) if (c >= 0 && c < 127) imp += psh[c];
  const bool forced = (j == 0) || (cur - j >= 0 && cur - j < 2), causal = (j * 64) <= t;
  const float v = forced ? 1e9f : (causal ? imp : NEGF);
  int rank = 0;
  for (int i = 0; i < 32; ++i) { float vi = __shfl(v, i); rank += (vi > v || (vi == v && i < j)) ? 1 : 0; }
  const unsigned long long bal = __ballot(rank < 16);
  if (lane == 0) ((unsigned*)(p.ws + O_SELM))[(size_t)tok * 2 + g] = (unsigned)(bal & 0xFFFFFFFFull);
  __builtin_amdgcn_wave_barrier();
}
DI void selwin_naive_wave(PR p, int wid, int lane) {
  const int tok = wid >> 3, h = wid & 7, g = h >> 2, b = tok >> 11, t = tok & 2047;
  const unsigned sm = ((const unsigned*)(p.ws + O_SELM))[(size_t)tok * 2 + g];
  const float* gn = (const float*)(p.ws + O_GN) + (size_t)tok * 24;
  float q = bf2f(((const bf16*)(p.ws + O_QBT))[(size_t)tok * 512 + h * 64 + lane]);
  float os = attn_wave((const bf16*)(p.ws + O_KS) + (size_t)b * 2048 * 128 + g * 64, (const bf16*)(p.ws + O_VST) + (size_t)(b * 2 + g) * 64 * 2048, q, 0, t,
                       [&](int s) { return (sm >> (s >> 6)) & 1u; }, lane);
  int lo = t - 511; if (lo < 0) lo = 0;
  float ow = attn_wave((const bf16*)(p.ws + O_KW) + (size_t)b * 2048 * 128 + g * 64, (const bf16*)(p.ws + O_VWT) + (size_t)(b * 2 + g) * 64 * 2048, q, lo, t,
                       [&](int) { return true; }, lane);
  const size_t oi = (size_t)tok * 512 + h * 64 + lane;
  float oc = bf2f(((const bf16*)(p.ws + O_OCMP))[oi]);
  ((bf16*)(p.ws + O_OB))[oi] = f2bf(oc + gn[h * 3 + 1] * os + gn[h * 3 + 2] * ow);
}


constexpr int AT_ROW = 72;
constexpr int AT_TILE = 64 * AT_ROW;
template <int TY>
DI void attn_item(PR p, int b, int g, int qt, bf16* smem) {
  const int tid = threadIdx.x, lane = tid & 63, wave = tid >> 6, r = lane & 31, hh = lane >> 5;
  const int h = g * 4 + wave, t = qt * 32 + r, tok = b * 2048 + t;
  unsigned char* ws = p.ws;
  const bf16* Q = (const bf16*)(ws + (TY == 0 ? O_QA : O_QBT)) + (size_t)tok * 512 + h * 64;
  const bf16* K = (const bf16*)(ws + (TY == 0 ? O_KA : (TY == 1 ? O_KW : O_KS))) + (size_t)b * 2048 * 128 + g * 64;
  const bf16* VT = (const bf16*)(ws + (TY == 0 ? O_VAT : (TY == 1 ? O_VWT : O_VST))) + (size_t)(b * 2 + g) * 64 * 2048;
  bf16x8 qf[4];
#pragma unroll
  for (int ks = 0; ks < 4; ++ks) { const uint4 qu = *(const uint4*)(Q + ks * 16 + hh * 8); const float c1q = 0.125f * 1.4426950408889634f;
    uint4 qs; qs.x = pk2(__uint_as_float(qu.x << 16) * c1q, __uint_as_float(qu.x & 0xffff0000u) * c1q); qs.y = pk2(__uint_as_float(qu.y << 16) * c1q, __uint_as_float(qu.y & 0xffff0000u) * c1q);
    qs.z = pk2(__uint_as_float(qu.z << 16) * c1q, __uint_as_float(qu.z & 0xffff0000u) * c1q); qs.w = pk2(__uint_as_float(qu.w << 16) * c1q, __uint_as_float(qu.w & 0xffff0000u) * c1q);
    qf[ks] = __builtin_bit_cast(bf16x8, qs); }
  const int kt_hi = qt >> 1;
  const unsigned upto = (kt_hi == 31) ? 0xFFFFFFFFu : ((2u << kt_hi) - 1u);
  unsigned active = upto; unsigned sm = 0;
  if (TY == 1) { const int lo = qt * 32 - 511; const int kt_lo = lo > 0 ? (lo >> 6) : 0; active = upto & ~((1u << kt_lo) - 1u); }
  if (TY == 2) { sm = ((const unsigned*)(ws + O_SELM))[(size_t)tok * 2 + g]; unsigned o = sm;
#pragma unroll
    for (int off = 1; off < 32; off <<= 1) o |= (unsigned)__shfl_xor((int)o, off);
    active = (unsigned)__builtin_amdgcn_readfirstlane((int)o) & upto; }
  const unsigned* mrow = (const unsigned*)(ws + O_DSAM) + (size_t)tok * 64;
  const int srow = tid >> 3, skc = tid & 7;
  const bf16* kg0 = K + (size_t)srow * 128 + skc * 8;
  const bf16* vg0 = VT + (size_t)srow * 2048 + skc * 8;
  uint4 rk0, rk1, rv0, rv1;
#define AT_GLOAD(kt) { rk0 = *(const uint4*)(kg0 + (size_t)(kt) * 64 * 128); rk1 = *(const uint4*)(kg0 + (size_t)(kt) * 64 * 128 + 32 * 128); \
    rv0 = *(const uint4*)(vg0 + (kt) * 64); rv1 = *(const uint4*)(vg0 + (kt) * 64 + 32 * 2048); }
#define AT_LSTORE(buf) { bf16* Ks_ = smem + (buf) * 2 * AT_TILE; bf16* Vs_ = Ks_ + AT_TILE; \
    *(uint4*)(Ks_ + srow * AT_ROW + skc * 8) = rk0; *(uint4*)(Ks_ + (srow + 32) * AT_ROW + skc * 8) = rk1; \
    *(uint4*)(Vs_ + srow * AT_ROW + skc * 8) = rv0; *(uint4*)(Vs_ + (srow + 32) * AT_ROW + skc * 8) = rv1; }
  f32x16 o0, o1;
#pragma unroll
  for (int i = 0; i < 16; ++i) { o0[i] = 0.f; o1[i] = 0.f; }
  float mrun = NEGF, lrun = 0.f;
  const float c1 = 0.125f * 1.4426950408889634f;
  unsigned rem = active; int buf = 0;
  int kt = __builtin_ctz(rem); rem &= rem - 1;
  __syncthreads();
  AT_GLOAD(kt); AT_LSTORE(0); __syncthreads();
  for (;;) {
    const int ktn = rem ? __builtin_ctz(rem) : -1;
    if (ktn >= 0) AT_GLOAD(ktn);
    const bf16* Ks = smem + buf * 2 * AT_TILE; const bf16* Vs = Ks + AT_TILE;
    f32x16 s0, s1;
#pragma unroll
    for (int i = 0; i < 16; ++i) { s0[i] = 0.f; s1[i] = 0.f; }
#pragma unroll
    for (int ks = 0; ks < 4; ++ks) {
      const bf16x8 a0 = *(const bf16x8*)(Ks + r * AT_ROW + ks * 16 + hh * 8), a1 = *(const bf16x8*)(Ks + (32 + r) * AT_ROW + ks * 16 + hh * 8);
      s0 = __builtin_amdgcn_mfma_f32_32x32x16_bf16(a0, qf[ks], s0, 0, 0, 0);
      s1 = __builtin_amdgcn_mfma_f32_32x32x16_bf16(a1, qf[ks], s1, 0, 0, 0);
    }
    const int kbase = kt * 64 + 4 * hh;
    unsigned w0 = 0, w1 = 0;
    if (TY == 0) {
      const uint2 mw = *(const uint2*)(mrow + kt * 2);
      w0 = mw.x >> (4 * hh); w1 = mw.y >> (4 * hh);
    } else if (TY == 1) {
      const bool full = (kt * 64 + 63 <= qt * 32) && (kt * 64 >= qt * 32 + 31 - 511);
      if (!full) {
#pragma unroll
        for (int i = 0; i < 16; ++i) { const int k0 = kbase + 8 * (i >> 2) + (i & 3), k1 = k0 + 32;
          s0[i] = (k0 <= t && k0 > t - 512) ? s0[i] : NEGF; s1[i] = (k1 <= t && k1 > t - 512) ? s1[i] : NEGF; }
      }
    } else {
      const bool bsel = (sm >> kt) & 1u;
      const bool interior = kt * 64 + 63 <= qt * 32;
      if (interior) {
        if (!__all(bsel)) {
#pragma unroll
          for (int i = 0; i < 16; ++i) { s0[i] = bsel ? s0[i] : NEGF; s1[i] = bsel ? s1[i] : NEGF; }
        }
      } else {
#pragma unroll
        for (int i = 0; i < 16; ++i) { const int k0 = kbase + 8 * (i >> 2) + (i & 3), k1 = k0 + 32;
          s0[i] = (bsel && k0 <= t) ? s0[i] : NEGF; s1[i] = (bsel && k1 <= t) ? s1[i] : NEGF; }
      }
    }
    float mx = s0[0];
#pragma unroll
    for (int i = 1; i < 16; ++i) mx = fmaxf(mx, s0[i]);
#pragma unroll
    for (int i = 0; i < 16; ++i) mx = fmaxf(mx, s1[i]);
    mx = fmaxf(mx, __shfl_xor(mx, 32));
    const float mnew = fmaxf(mrun, mx);
    const float muse = (mnew == NEGF) ? 0.f : mnew;
    const float corr = __builtin_amdgcn_exp2f(mrun - mnew);
    mrun = mnew;
    float ls = 0.f;
#pragma unroll
    for (int i = 0; i < 16; ++i) { s0[i] = __builtin_amdgcn_exp2f(s0[i] - muse); s1[i] = __builtin_amdgcn_exp2f(s1[i] - muse); }
    if (TY == 0) {
#pragma unroll
      for (int i = 0; i < 16; ++i) { const int bit = 8 * (i >> 2) + (i & 3);
        s0[i] = __uint_as_float(__float_as_uint(s0[i]) & (unsigned)__builtin_amdgcn_sbfe((int)w0, bit, 1)); s1[i] = __uint_as_float(__float_as_uint(s1[i]) & (unsigned)__builtin_amdgcn_sbfe((int)w1, bit, 1)); }
    }
#pragma unroll
    for (int i = 0; i < 16; ++i) ls += s0[i] + s1[i];
    lrun = lrun * corr + ls;
    if (__any(corr != 1.f)) {
#pragma unroll
      for (int i = 0; i < 16; ++i) { o0[i] *= corr; o1[i] *= corr; }
    }
#pragma unroll
    for (int mt = 0; mt < 2; ++mt)
#pragma unroll
      for (int sp = 0; sp < 2; ++sp) {
        uint4 pu;
        if (mt == 0) { pu.x = pk2(s0[8 * sp], s0[8 * sp + 1]); pu.y = pk2(s0[8 * sp + 2], s0[8 * sp + 3]); pu.z = pk2(s0[8 * sp + 4], s0[8 * sp + 5]); pu.w = pk2(s0[8 * sp + 6], s0[8 * sp + 7]); }
        else { pu.x = pk2(s1[8 * sp], s1[8 * sp + 1]); pu.y = pk2(s1[8 * sp + 2], s1[8 * sp + 3]); pu.z = pk2(s1[8 * sp + 4], s1[8 * sp + 5]); pu.w = pk2(s1[8 * sp + 6], s1[8 * sp + 7]); }
        const bf16x8 pb = __builtin_bit_cast(bf16x8, pu);
        const int kc = mt * 32 + 16 * sp + 4 * hh;
        uint4 vu;
        { const uint2 lo = *(const uint2*)(Vs + r * AT_ROW + kc), hi = *(const uint2*)(Vs + r * AT_ROW + kc + 8); vu.x = lo.x; vu.y = lo.y; vu.z = hi.x; vu.w = hi.y; }
        o0 = __builtin_amdgcn_mfma_f32_32x32x16_bf16(__builtin_bit_cast(bf16x8, vu), pb, o0, 0, 0, 0);
        { const uint2 lo = *(const uint2*)(Vs + (32 + r) * AT_ROW + kc), hi = *(const uint2*)(Vs + (32 + r) * AT_ROW + kc + 8); vu.x = lo.x; vu.y = lo.y; vu.z = hi.x; vu.w = hi.y; }
        o1 = __builtin_amdgcn_mfma_f32_32x32x16_bf16(__builtin_bit_cast(bf16x8, vu), pb, o1, 0, 0, 0);
      }
    if (ktn < 0) break;
    AT_LSTORE(buf ^ 1);
    __syncthreads();
    buf ^= 1; kt = ktn; rem &= rem - 1;
  }
#undef AT_GLOAD
#undef AT_LSTORE
  const float ltot = lrun + __shfl_xor(lrun, 32);
  float inv = ltot > 0.f ? 1.f / ltot : 0.f;
  const float* gn = (const float*)(ws + O_GN) + (size_t)tok * 24 + h * 3;
  if (TY == 1) inv *= gn[2];
  if (TY == 2) inv *= gn[1];
  const size_t ob = (size_t)tok * 512 + h * 64 + 4 * hh;
  bf16* dst = (bf16*)(ws + (TY == 0 ? O_OA : (TY == 1 ? O_OWIN : O_OB))) + ob;
#pragma unroll
  for (int dt = 0; dt < 2; ++dt)
#pragma unroll
    for (int q = 0; q < 4; ++q) {
      float v0, v1, v2, v3;
      if (dt == 0) { v0 = o0[4 * q] * inv; v1 = o0[4 * q + 1] * inv; v2 = o0[4 * q + 2] * inv; v3 = o0[4 * q + 3] * inv; }
      else { v0 = o1[4 * q] * inv; v1 = o1[4 * q + 1] * inv; v2 = o1[4 * q + 2] * inv; v3 = o1[4 * q + 3] * inv; }
      if (TY == 2) {
        const uint2 a = *(const uint2*)((const bf16*)(ws + O_OCMP) + ob + dt * 32 + 8 * q), w = *(const uint2*)((const bf16*)(ws + O_OWIN) + ob + dt * 32 + 8 * q);
        v0 += __uint_as_float(a.x << 16) + __uint_as_float(w.x << 16); v1 += __uint_as_float(a.x & 0xffff0000u) + __uint_as_float(w.x & 0xffff0000u);
        v2 += __uint_as_float(a.y << 16) + __uint_as_float(w.y << 16); v3 += __uint_as_float(a.y & 0xffff0000u) + __uint_as_float(w.y & 0xffff0000u);
      }
      uint2 o; o.x = pk2(v0, v1); o.y = pk2(v2, v3);
      *(uint2*)(dst + dt * 32 + 8 * q) = o;
    }
}


DI void idx_item(PR p, int b, int qt, unsigned char* lds) {
  int tid = threadIdx.x; asm volatile("" : "+v"(tid));
  const int lane = tid & 63, wave = tid >> 6, r = lane & 31, hh = lane >> 5;
  unsigned char* ws = p.ws;
  const int t = qt * 32 + r, tok = b * 2048 + t;
  if (qt >= 8) {
    const bf16* Qi = (const bf16*)(ws + O_QI) + (size_t)tok * 256;
    bf16x8 qf[8][2];
#pragma unroll
    for (int h = 0; h < 8; ++h) { qf[h][0] = *(const bf16x8*)(Qi + h * 32 + hh * 8); qf[h][1] = *(const bf16x8*)(Qi + h * 32 + 16 + hh * 8); }
    const f32x4 wa = *(const f32x4*)((const float*)(ws + O_WI) + (size_t)tok * 8), wb = *(const f32x4*)((const float*)(ws + O_WI) + (size_t)tok * 8 + 4);
    const bf16* Ki = (const bf16*)(ws + O_KI) + (size_t)b * 2048 * 32;
    float* SCr = (float*)(ws + O_SC) + (size_t)tok * 2048 + 4 * hh;
#pragma unroll 1
    for (int kt = wave; kt <= qt; kt += 4) {
      const bf16* kr = Ki + (size_t)(kt * 32 + r) * 32 + hh * 8;
      const bf16x8 a0 = *(const bf16x8*)kr, a1 = *(const bf16x8*)(kr + 16);
      f32x16 sc;
#pragma unroll
      for (int i = 0; i < 16; ++i) sc[i] = 0.f;
#pragma unroll
      for (int h = 0; h < 8; ++h) {
        f32x16 s;
#pragma unroll
        for (int i = 0; i < 16; ++i) s[i] = 0.f;
        s = __builtin_amdgcn_mfma_f32_32x32x16_bf16(a0, qf[h][0], s, 0, 0, 0);
        s = __builtin_amdgcn_mfma_f32_32x32x16_bf16(a1, qf[h][1], s, 0, 0, 0);
        const float w = h < 4 ? wa[h & 3] : wb[h & 3];
#pragma unroll
        for (int i = 0; i < 16; ++i) { float t_ = sc[i] + w * fmaxf(s[i], 0.f); asm volatile("" : "+v"(t_)); sc[i] = t_; }
      }
#pragma unroll
      for (int q = 0; q < 4; ++q) { f32x4 o = {sc[4 * q], sc[4 * q + 1], sc[4 * q + 2], sc[4 * q + 3]}; *(f32x4*)(SCr + kt * 32 + 8 * q) = o; }
    }
    __threadfence_block();
  }
  __syncthreads();
#pragma unroll 1
  for (int i = 0; i < 8; ++i) { const int row = qt * 32 + wave * 8 + i, tk = b * 2048 + row;
    select_row((const float*)(ws + O_SC) + (size_t)tk * 2048, row, (unsigned long long*)(ws + O_DSAM) + (size_t)tk * 32, (unsigned*)lds + wave * 1024, lane); }
}

constexpr int CM_VROW = 136;
DI void cmp_item(PR p, int b, int g, int qt, unsigned char* lds) {
  const int tid = threadIdx.x, lane = tid & 63, wave = tid >> 6, r = lane & 31, hh = lane >> 5;
  unsigned char* ws = p.ws;
  const int h = g * 4 + wave, t = qt * 32 + r, tok = b * 2048 + t;
  bf16* Ks = (bf16*)lds;
  bf16* Vs = Ks + 128 * AT_ROW;
  float* imps = (float*)(Vs + 64 * CM_VROW);
  const bf16* Kg = (const bf16*)(ws + O_KCC) + (size_t)(b * 2 + g) * 128 * 64;
  const bf16* Vg = (const bf16*)(ws + O_VCCT) + (size_t)(b * 2 + g) * 64 * 128;
  __syncthreads();
#pragma unroll
  for (int i = 0; i < 4; ++i) { const int c = tid + 256 * i; { const int row = c >> 3, kc = c & 7; *(uint4*)(Ks + row * AT_ROW + kc * 8) = *(const uint4*)(Kg + row * 64 + kc * 8); }
    { const int row = c >> 4, kc = c & 15; *(uint4*)(Vs + row * CM_VROW + kc * 8) = *(const uint4*)(Vg + row * 128 + kc * 8); } }
  const bf16* Q = (const bf16*)(ws + O_QBR) + (size_t)tok * 512 + h * 64;
  bf16x8 qf[4];
#pragma unroll
  for (int ks = 0; ks < 4; ++ks) qf[ks] = *(const bf16x8*)(Q + ks * 16 + hh * 8);
  __syncthreads();
  f32x16 s[4];
#pragma unroll
  for (int mt = 0; mt < 4; ++mt) {
#pragma unroll
    for (int i = 0; i < 16; ++i) s[mt][i] = 0.f;
#pragma unroll
    for (int ks = 0; ks < 4; ++ks) { const bf16x8 a = *(const bf16x8*)(Ks + (mt * 32 + r) * AT_ROW + ks * 16 + hh * 8); s[mt] = __builtin_amdgcn_mfma_f32_32x32x16_bf16(a, qf[ks], s[mt], 0, 0, 0); }
    if (mt & 1) __builtin_amdgcn_sched_barrier(0);
  }
  const float c1 = 0.125f * 1.4426950408889634f;
  float mx = NEGF;
  int cthr = (t - 31) >> 4; cthr = (cthr > 126 ? 126 : cthr) - 4 * hh;
#pragma unroll
  for (int mt = 0; mt < 4; ++mt)
#pragma unroll
    for (int i = 0; i < 16; ++i) { const bool ok = (mt * 32 + 8 * (i >> 2) + (i & 3)) <= cthr; s[mt][i] = ok ? s[mt][i] * c1 : NEGF; mx = fmaxf(mx, s[mt][i]); }
  mx = fmaxf(mx, __shfl_xor(mx, 32));
  const float muse = (mx == NEGF) ? 0.f : mx;
  float ls = 0.f;
#pragma unroll
  for (int mt = 0; mt < 4; ++mt)
#pragma unroll
    for (int i = 0; i < 16; ++i) { s[mt][i] = __builtin_amdgcn_exp2f(s[mt][i] - muse); ls += s[mt][i]; }
  ls += __shfl_xor(ls, 32);
  const float inv = 1.f / fmaxf(ls, 1e-30f);
#pragma unroll
  for (int mt = 0; mt < 4; ++mt)
#pragma unroll
    for (int i = 0; i < 16; ++i) s[mt][i] *= inv;
  f32x16 o0, o1;
#pragma unroll
  for (int i = 0; i < 16; ++i) { o0[i] = 0.f; o1[i] = 0.f; }
#pragma unroll
  for (int mt = 0; mt < 4; ++mt)
#pragma unroll
    for (int sp = 0; sp < 2; ++sp) {
      uint4 pu; pu.x = pk2(s[mt][8 * sp], s[mt][8 * sp + 1]); pu.y = pk2(s[mt][8 * sp + 2], s[mt][8 * sp + 3]); pu.z = pk2(s[mt][8 * sp + 4], s[mt][8 * sp + 5]); pu.w = pk2(s[mt][8 * sp + 6], s[mt][8 * sp + 7]);
      const bf16x8 pb = __builtin_bit_cast(bf16x8, pu);
      const int kc = mt * 32 + 16 * sp + 4 * hh;
      uint4 vu;
      { const uint2 lo = *(const uint2*)(Vs + r * CM_VROW + kc), hi = *(const uint2*)(Vs + r * CM_VROW + kc + 8); vu.x = lo.x; vu.y = lo.y; vu.z = hi.x; vu.w = hi.y; }
      o0 = __builtin_amdgcn_mfma_f32_32x32x16_bf16(__builtin_bit_cast(bf16x8, vu), pb, o0, 0, 0, 0);
      { const uint2 lo = *(const uint2*)(Vs + (32 + r) * CM_VROW + kc), hi = *(const uint2*)(Vs + (32 + r) * CM_VROW + kc + 8); vu.x = lo.x; vu.y = lo.y; vu.z = hi.x; vu.w = hi.y; }
      o1 = __builtin_amdgcn_mfma_f32_32x32x16_bf16(__builtin_bit_cast(bf16x8, vu), pb, o1, 0, 0, 0);
      if (sp) __builtin_amdgcn_sched_barrier(0);
    }
  { const float g0 = ((const float*)(ws + O_GN))[(size_t)tok * 24 + h * 3];
    bf16* dst = (bf16*)(ws + O_OCMP) + (size_t)tok * 512 + h * 64 + 4 * hh;
#pragma unroll
    for (int q = 0; q < 4; ++q) { uint2 o; o.x = pk2(o0[4 * q] * g0, o0[4 * q + 1] * g0); o.y = pk2(o0[4 * q + 2] * g0, o0[4 * q + 3] * g0); *(uint2*)(dst + 8 * q) = o;
      o.x = pk2(o1[4 * q] * g0, o1[4 * q + 1] * g0); o.y = pk2(o1[4 * q + 2] * g0, o1[4 * q + 3] * g0); *(uint2*)(dst + 32 + 8 * q) = o; } }
  float* myimp = imps + (wave * 32 + r) * 33;
  float prevlast = 0.f;
#pragma unroll
  for (int mt = 0; mt < 4; ++mt)
#pragma unroll
    for (int q = 0; q < 4; ++q) {
      const float qs = (s[mt][4 * q] + s[mt][4 * q + 1]) + (s[mt][4 * q + 2] + s[mt][4 * q + 3]);
      const float other = __shfl_xor(s[mt][4 * q + 3], 32);
      const float prev = hh ? other : prevlast;
      myimp[mt * 8 + 2 * q + hh] = qs + prev;
      prevlast = other;
    }
  __syncthreads();
  {
    const int qq = tid >> 3, j0 = (tid & 7) * 4, tq = qt * 32 + qq, cur = tq >> 6;
    float v[4];
#pragma unroll
    for (int i = 0; i < 4; ++i) { const int j = j0 + i; const float im = (imps[(0 * 32 + qq) * 33 + j] + imps[(1 * 32 + qq) * 33 + j]) + (imps[(2 * 32 + qq) * 33 + j] + imps[(3 * 32 + qq) * 33 + j]);
      const bool forced = (j == 0) || (cur - j >= 0 && cur - j < 2), causal = (j * 64) <= tq; v[i] = forced ? 1e9f : (causal ? im : NEGF); }
    __syncthreads();
    float* vv = imps + qq * 33;
#pragma unroll
    for (int i = 0; i < 4; ++i) vv[j0 + i] = v[i];
    __syncthreads();
    unsigned bits = 0;
#pragma unroll
    for (int i = 0; i < 4; ++i) { const int j = j0 + i; int rank = 0;
      for (int k = 0; k < 32; ++k) { const float vk = vv[k]; rank += (vk > v[i] || (vk == v[i] && k < j)) ? 1 : 0; }
      if (rank < 16) bits |= 1u << j; }
    bits |= (unsigned)__shfl_xor((int)bits, 1); bits |= (unsigned)__shfl_xor((int)bits, 2); bits |= (unsigned)__shfl_xor((int)bits, 4);
    if ((tid & 7) == 0) ((unsigned*)(ws + O_SELM))[(size_t)(b * 2048 + tq) * 2 + g] = bits;
  }
}

DI float gelu_tanh(float x) { float u = 0.7978845608028654f * (x + 0.044715f * x * x * x); return 0.5f * x * (1.f + tanhf(u)); }
DI void cmp1_tile(PR p, int it, bf16* smem) {
  const int which = it >> 6, bg = (it >> 1) & 31, nt = it & 1, n0 = nt * 128;
  const int lane = threadIdx.x & 63, wave = threadIdx.x >> 6, wm = wave >> 1, wn = wave & 1;
  f32x16 acc[2][2]; acc_zero(acc);
  ALPlain al{(const bf16*)(p.ws + (which ? O_VC : O_KC)) + (size_t)bg * 2048 * 64, 1024};
  ALPlain bl{(const bf16*)(p.ws + (which ? O_WT_C1V : O_WT_C1K)) + (size_t)n0 * 2048, 2048};
  gemm_mainloop_dma(acc, al, bl, 64, (unsigned char*)smem);
  const float* cb = (const float*)(p.ws + O_CMPB) + which * 32 * 256;
  bf16* H1 = (bf16*)(p.ws + O_H1) + ((size_t)which * 4096 + bg * 128) * 256;
#pragma unroll
  for (int ni = 0; ni < 2; ++ni) {
    const int n = n0 + wn * 64 + ni * 32 + (lane & 31);
    float bias = 0.f;
    for (int kc = 0; kc < 32; ++kc) bias += cb[kc * 256 + n];
#pragma unroll
    for (int mi = 0; mi < 2; ++mi) { float v[16];
#pragma unroll
      for (int r = 0; r < 16; ++r) v[r] = gelu_tanh(acc[mi][ni][r] + bias);
      st16_bf16(H1 + (size_t)(wm * 64 + mi * 32 + 4 * (lane >> 5)) * 256 + n, 256, v); }
  }
}
DI void cmp2_tile(PR p, int it, bf16* smem) {
  const int which = it >> 5, bg = it & 31;
  const int lane = threadIdx.x & 63, wave = threadIdx.x >> 6, wm = wave >> 1, wn = wave & 1;
  f32x16 acc[2][2]; acc_zero(acc);
  ALPlain al{(const bf16*)(p.ws + O_H1) + ((size_t)which * 4096 + bg * 128) * 256, 256};
  ALPlain bl{(const bf16*)(p.ws + (which ? O_WT_C2V : O_WT_C2K)), 256};
  gemm_mainloop_dma(acc, al, bl, 8, (unsigned char*)smem);
  if (wn == 0) {
#pragma unroll
    for (int ni = 0; ni < 2; ++ni) { const int d = ni * 32 + (lane & 31);
#pragma unroll
      for (int mi = 0; mi < 2; ++mi) { const int c0 = wm * 64 + mi * 32 + 4 * (lane >> 5); float v[16];
#pragma unroll
        for (int r = 0; r < 16; ++r) v[r] = (c0 + 8 * (r >> 2) + (r & 3)) < 127 ? acc[mi][ni][r] : 0.f;
        if (which == 0) st16_bf16((bf16*)(p.ws + O_KCC) + ((size_t)bg * 128 + c0) * 64 + d, 64, v);
        else { bf16* d_ = (bf16*)(p.ws + O_VCCT) + ((size_t)bg * 64 + d) * 128 + c0; asm volatile("" : "+v"(d_));
#pragma unroll
          for (int q = 0; q < 4; ++q) { uint2 o_; o_.x = pk2(v[4 * q], v[4 * q + 1]); o_.y = pk2(v[4 * q + 2], v[4 * q + 3]); *(uint2*)(d_ + 8 * q) = o_; } } } }
  }
}

DI void merge_tile(PR p, int it, bf16* smem) {
  const int nt = it >> 8, mt = it & 255, m0 = mt * 128, n0 = nt * 128;
  const int lane = threadIdx.x & 63, wave = threadIdx.x >> 6, wm = wave >> 1, wn = wave & 1;
  f32x16 acc[2][2], acb[2][2]; acc_zero(acc); acc_zero(acb);
  { ALPlain al{(const bf16*)(p.ws + O_OA) + (size_t)m0 * 512, 512}; ALPlain bl{(const bf16*)(p.ws + O_WT_BRA) + (size_t)n0 * 512, 512}; gemm_mainloop_dma(acc, al, bl, 16, (unsigned char*)smem); }
  { ALPlain al{(const bf16*)(p.ws + O_OB) + (size_t)m0 * 512, 512}; ALPlain bl{(const bf16*)(p.ws + O_WT_BRB) + (size_t)n0 * 512, 512}; gemm_mainloop_dma(acb, al, bl, 16, (unsigned char*)smem); }
  bf16* tA = smem; bf16* tB = smem + 128 * 136;
  { const int c = lane & 31, h4 = 4 * (lane >> 5);
#pragma unroll
    for (int mi = 0; mi < 2; ++mi)
#pragma unroll
      for (int ni = 0; ni < 2; ++ni) { const int o = (wm * 64 + mi * 32 + h4) * 136 + wn * 64 + ni * 32 + c;
#pragma unroll
        for (int r = 0; r < 16; ++r) { const int oo = o + (8 * (r >> 2) + (r & 3)) * 136; tA[oo] = (bf16)pk2(acc[mi][ni][r], 0.f); tB[oo] = (bf16)pk2(acb[mi][ni][r], 0.f); } } }
  __syncthreads();
  const bf16* SGA = (const bf16*)(p.ws + O_SGA); const bf16* SGB = (const bf16*)(p.ws + O_SGB); bf16* M = (bf16*)(p.ws + O_MERGED);
#pragma unroll 2
  for (int j = 0; j < 8; ++j) { const int u = threadIdx.x + 256 * j, row = u >> 4, cg = u & 15;
    const size_t o = (size_t)(m0 + row) * 1024 + n0 + cg * 8;
    const uint4 a = *(const uint4*)(tA + row * 136 + cg * 8), bq = *(const uint4*)(tB + row * 136 + cg * 8), ga = __builtin_bit_cast(uint4, NT_LD16(SGA + o)), gb = __builtin_bit_cast(uint4, NT_LD16(SGB + o));
#define MG(av, bv, gav, gbv, out) { const float lo_ = __uint_as_float(gav << 16) * __uint_as_float(av << 16) + __uint_as_float(gbv << 16) * __uint_as_float(bv << 16); \
      const float hi_ = __uint_as_float(gav & 0xffff0000u) * __uint_as_float(av & 0xffff0000u) + __uint_as_float(gbv & 0xffff0000u) * __uint_as_float(bv & 0xffff0000u); out = pk2(lo_, hi_); }
    uint4 r; MG(a.x, bq.x, ga.x, gb.x, r.x) MG(a.y, bq.y, ga.y, gb.y, r.y) MG(a.z, bq.z, ga.z, gb.z, r.z) MG(a.w, bq.w, ga.w, gb.w, r.w)
#undef MG
    *(uint4*)(M + o) = r; }
}
DI void out_tile(PR p, int it, bf16* smem) {
  const int nt = it >> 7, mt = it & 127, m0 = mt * 256, n0 = nt * 128;
  const int lane = threadIdx.x & 63, wave = threadIdx.x >> 6, wm = wave >> 1, wn = wave & 1;
  f32x16 acc[4][2];
#pragma unroll
  for (int mi = 0; mi < 4; ++mi)
#pragma unroll
    for (int r = 0; r < 16; ++r) { acc[mi][0][r] = 0.f; acc[mi][1][r] = 0.f; }
  ALPlain al{(const bf16*)(p.ws + O_MERGED) + (size_t)m0 * 1024, 1024}; ALPlain bl{(const bf16*)(p.ws + O_WT_OUT) + (size_t)n0 * 1024, 1024};
  gemm_mainloop_dma_m256(acc, al, bl, 32, (unsigned char*)smem);
  const float* g1 = (const float*)(p.ws + O_MOD) + (m0 >> 11) * 6144 + 2048 + n0; float* Y = (float*)(p.ws + O_Y);
  float* st = (float*)smem;
#pragma unroll 1
  for (int h = 0; h < 2; ++h) {
    if (wm == h) {
#pragma unroll
      for (int mi = 0; mi < 4; ++mi)
#pragma unroll
        for (int ni = 0; ni < 2; ++ni) { float* bq = st + (mi * 32 + 4 * (lane >> 5)) * ST_LD + wn * 64 + ni * 32 + (lane & 31);
#pragma unroll
          for (int r = 0; r < 16; ++r) bq[(8 * (r >> 2) + (r & 3)) * ST_LD] = acc[mi][ni][r]; }
    }
    __syncthreads();
#pragma unroll 4
    for (int j = 0; j < 16; ++j) { const int u = threadIdx.x + 256 * j, row = u >> 5, c4 = u & 31;
      const size_t o = (size_t)(m0 + h * 128 + row) * 1024 + n0 + c4 * 4;
      const f32x4 a = *(const f32x4*)(st + row * ST_LD + c4 * 4), xv = __builtin_nontemporal_load((const f32x4*)(p.x + o)), gv = *(const f32x4*)(g1 + c4 * 4);
      f32x4 y; y[0] = DN_ALPHA * xv[0] + gv[0] * a[0]; y[1] = DN_ALPHA * xv[1] + gv[1] * a[1]; y[2] = DN_ALPHA * xv[2] + gv[2] * a[2]; y[3] = DN_ALPHA * xv[3] + gv[3] * a[3];
      *(f32x4*)(Y + o) = y; }
    __syncthreads();
  }
}

DI void ln1_row(PR p, int tok, int lane) {
  const int b = tok >> 11;
  const float4* yr = (const float4*)((const float*)(p.ws + O_Y) + (size_t)tok * 1024);
  float4 v[4]; float s = 0.f;
#pragma unroll
  for (int j = 0; j < 4; ++j) { const f32x4 yv = __builtin_nontemporal_load((const f32x4*)yr + lane + 64 * j); v[j].x = yv[0]; v[j].y = yv[1]; v[j].z = yv[2]; v[j].w = yv[3]; s += (v[j].x + v[j].y) + (v[j].z + v[j].w); }
  const float mean = wave_sum(s) * (1.f / 1024.f); float s2 = 0.f;
#pragma unroll
  for (int j = 0; j < 4; ++j) { v[j].x -= mean; v[j].y -= mean; v[j].z -= mean; v[j].w -= mean; s2 += (v[j].x * v[j].x + v[j].y * v[j].y) + (v[j].z * v[j].z + v[j].w * v[j].w); }
  const float rstd = 1.f / sqrtf(wave_sum(s2) * (1.f / 1024.f) + LN_EPS);
  const float* mod = (const float*)(p.ws + O_MOD) + b * 6144;
  float* X1 = (float*)(p.ws + O_X1) + (size_t)tok * 1024; bf16* HH = (bf16*)(p.ws + O_HHI) + (size_t)tok * 1024; bf16* HL = (bf16*)(p.ws + O_HLO) + (size_t)tok * 1024;
#pragma unroll
  for (int j = 0; j < 4; ++j) {
    const int col = (lane + 64 * j) * 4;
    const float4 g = *(const float4*)(p.ln1_g + col), bb = *(const float4*)(p.ln1_b + col);
    const float4 sh = *(const float4*)(mod + 3072 + col), sc = *(const float4*)(mod + 4096 + col);
    float4 x1; x1.x = v[j].x * rstd * g.x + bb.x; x1.y = v[j].y * rstd * g.y + bb.y; x1.z = v[j].z * rstd * g.z + bb.z; x1.w = v[j].w * rstd * g.w + bb.w;
    { f32x4 xo = {x1.x, x1.y, x1.z, x1.w}; __builtin_nontemporal_store(xo, (f32x4*)(X1 + col)); }
    const float h0 = x1.x * (1.f + sc.x) + sh.x, h1 = x1.y * (1.f + sc.y) + sh.y, h2 = x1.z * (1.f + sc.z) + sh.z, h3 = x1.w * (1.f + sc.w) + sh.w;
    ushort4 hi, lo;
    hi.x = f2bf(h0); hi.y = f2bf(h1); hi.z = f2bf(h2); hi.w = f2bf(h3);
    lo.x = f2bf(h0 - bf2f(hi.x)); lo.y = f2bf(h1 - bf2f(hi.y)); lo.z = f2bf(h2 - bf2f(hi.z)); lo.w = f2bf(h3 - bf2f(hi.w));
    *(ushort4*)(HH + col) = hi; *(ushort4*)(HL + col) = lo;
  }
}

DI void router_tile(PR p, int it, bf16* smem) {
  const int nt = it >> 8, mt = it & 255, m0 = mt * 128, n0 = nt * 128;
  const int lane = threadIdx.x & 63, wave = threadIdx.x >> 6, wm = wave >> 1, wn = wave & 1;
  f32x16 acc[2][2]; acc_zero(acc);
  ALRouter al{(const bf16*)(p.ws + O_HHI) + (size_t)m0 * 1024}; BLRouterB bl{(const bf16*)(p.ws + O_WT_RT) + (size_t)n0 * 2048};
  gemm_mainloop_dma(acc, al, bl, 96, (unsigned char*)smem);
  float* L = (float*)(p.ws + O_LOGITS);
  float* st = (float*)smem; stage_acc(st, acc);
  __syncthreads();
#pragma unroll 4
  for (int j = 0; j < 16; ++j) { const int u = threadIdx.x + 256 * j, row = u >> 5, c4 = u & 31;
    __builtin_nontemporal_store(*(const f32x4*)(st + row * ST_LD + c4 * 4), (f32x4*)(L + (size_t)(m0 + row) * 256 + n0 + c4 * 4)); }
}
DI void gateup_store(f32x16 (&acc)[2][2], bf16* dst  , int nvalid, int hc0, float* st) {
  const int lane = threadIdx.x & 63, wave = threadIdx.x >> 6, wm = wave >> 1, wn = wave & 1;
#pragma unroll
  for (int mi = 0; mi < 2; ++mi) {
    float* b = st + (wm * 64 + mi * 32 + 4 * (lane >> 5)) * 68 + wn * 32 + (lane & 31);
#pragma unroll
    for (int r = 0; r < 16; ++r) b[(8 * (r >> 2) + (r & 3)) * 68] = siluf_(acc[mi][0][r]) * acc[mi][1][r]; }
  __syncthreads();
#pragma unroll
  for (int j = 0; j < 4; ++j) { const int u = threadIdx.x + 256 * j, row = u >> 3, cg = u & 7;
    if (row < nvalid) *(uint4*)(dst + (size_t)row * 256 + hc0 + cg * 8) = pack8(st + row * 68 + cg * 8); }
}
DI void sh1_tile(PR p, int it, bf16* smem) {
  const int nt = it >> 8, mt = it & 255, m0 = mt * 128;
  f32x16 acc[2][2]; acc_zero(acc);
  ALPlain al{(const bf16*)(p.ws + O_HHI) + (size_t)m0 * 1024, 1024}; ALPlain bl{(const bf16*)(p.ws + O_WT_SGU) + (size_t)nt * 128 * 1024, 1024};
  gemm_mainloop_dma(acc, al, bl, 32, (unsigned char*)smem);
  gateup_store(acc, (bf16*)(p.ws + O_ACTSH) + (size_t)m0 * 256, 128, nt * 64, (float*)smem);
}
DI void sh2_tile(PR p, int it, bf16* smem) {
  const int nt = it >> 8, mt = it & 255, m0 = mt * 128, n0 = nt * 128;
  const int lane = threadIdx.x & 63, wave = threadIdx.x >> 6, wm = wave >> 1, wn = wave & 1;
  f32x16 acc[2][2]; acc_zero(acc);
  ALPlain al{(const bf16*)(p.ws + O_ACTSH) + (size_t)m0 * 256, 256}; ALPlain bl{(const bf16*)(p.ws + O_WT_SD) + (size_t)n0 * 256, 256};
  gemm_mainloop_dma(acc, al, bl, 8, (unsigned char*)smem);
  bf16* Y = (bf16*)(p.ws + O_YSH);
  float* st = (float*)smem; stage_acc(st, acc);
  __syncthreads();
#pragma unroll 2
  for (int j = 0; j < 8; ++j) { const int u = threadIdx.x + 256 * j, row = u >> 4, cg = u & 15;
    *(uint4*)(Y + (size_t)(m0 + row) * 1024 + n0 + cg * 8) = pack8(st + row * ST_LD + cg * 8); }
}

DI void route_token(unsigned char* ws, const float* __restrict__ logit, const float* __restrict__ bias, int tok, int lane) {
  const f32x4 lgv = __builtin_nontemporal_load((const f32x4*)(logit + 4 * lane)); float4 lg; lg.x = lgv[0]; lg.y = lgv[1]; lg.z = lgv[2]; lg.w = lgv[3]; const float4 bi = *(const float4*)(bias + 4 * lane);
  float sv[4] = {sigmoidf_(lg.x), sigmoidf_(lg.y), sigmoidf_(lg.z), sigmoidf_(lg.w)};
  float cv[4] = {sv[0] + bi.x, sv[1] + bi.y, sv[2] + bi.z, sv[3] + bi.w};
  float m1 = fmaxf(fmaxf(cv[0], cv[1]), fmaxf(cv[2], cv[3]));
  float m2;
  { float a = fmaxf(cv[0], cv[1]), bq = fminf(cv[0], cv[1]), c = fmaxf(cv[2], cv[3]), d = fminf(cv[2], cv[3]); m2 = fmaxf(fminf(a, c), fmaxf(bq, d)); }
#pragma unroll
  for (int o = 1; o < 8; o <<= 1) { float o1 = __shfl_xor(m1, o), o2 = __shfl_xor(m2, o); float n1 = fmaxf(m1, o1), n2 = fmaxf(fminf(m1, o1), fmaxf(m2, o2)); m1 = n1; m2 = n2; }
  const float gs = m1 + m2; const int grp = lane >> 3;
  int rank = 0;
#pragma unroll
  for (int g2 = 0; g2 < 8; ++g2) { float og = __shfl(gs, g2 * 8); rank += (og > gs || (og == gs && g2 < grp)) ? 1 : 0; }
  const bool keep = rank < 4;
#pragma unroll
  for (int j = 0; j < 4; ++j) if (!keep) cv[j] = NEGF;
  float wsum = 0.f, myw = 0.f; int myidx = 0;
#pragma unroll
  for (int r = 0; r < 8; ++r) {
    float bv = cv[0]; int bj = 0;
#pragma unroll
    for (int j = 1; j < 4; ++j) if (cv[j] > bv) { bv = cv[j]; bj = j; }
    float wv = bv; int wi = 4 * lane + bj;
#pragma unroll
    for (int o = 1; o < 64; o <<= 1) { float ov = __shfl_xor(wv, o); int oi = __shfl_xor(wi, o); if (ov > wv || (ov == wv && oi < wi)) { wv = ov; wi = oi; } }
    const int owner = wi >> 2, oj = wi & 3;
    float sj = (oj == 0) ? sv[0] : (oj == 1) ? sv[1] : (oj == 2) ? sv[2] : sv[3];
    const float ssel = __shfl(sj, owner);
    if (lane == owner) { if (oj == 0) cv[0] = -3e38f; else if (oj == 1) cv[1] = -3e38f; else if (oj == 2) cv[2] = -3e38f; else cv[3] = -3e38f; }
    wsum += ssel;
    if (lane == r) { myw = ssel; myidx = wi; }
  }
  if (lane < 8) {
    const float wgt = myw / wsum * 2.5f;
    ((int*)(ws + O_RIDX))[(size_t)tok * 8 + lane] = myidx;
    ((float*)(ws + O_RW))[(size_t)tok * 8 + lane] = wgt;
    const int pos = atomicAdd((int*)(ws + O_CTL) + CW_CNT + myidx * CNT_STRIDE, 1);
    ((int*)(ws + O_LIST))[(size_t)myidx * 32768 + pos] = tok * 8 + lane;
  }
}

DI void moe_offsets(const int* cnt, int* offs, int* stoffs) {
  __syncthreads();
  const int t = threadIdx.x; const int c = cnt[t * CNT_STRIDE];
  offs[t + 1] = c; if (t == 0) offs[0] = 0;
  __syncthreads();
  for (int o = 1; o < 256; o <<= 1) {
    int a = 0; if (t + 1 > o) a = offs[t + 1 - o];
    __syncthreads();
    if (t + 1 > o) offs[t + 1] += a;
    __syncthreads();
  }
  if (t < 8) { int a = 0; for (int j = 0; j < 32; ++j) { stoffs[t * 33 + j] = a; const int e = t + 8 * j; a += (offs[e + 1] - offs[e] + 255) >> 8; } stoffs[t * 33 + 32] = a; }
  __syncthreads();
}
DI int find_le32(const int* arr, int v) { int lo = 0, hi = 31; while (lo < hi) { int mid = (lo + hi + 1) >> 1; if (arr[mid] <= v) lo = mid; else hi = mid - 1; } return lo; }

DI void ph_moe1(PR p, bf16* smem, int* misc, int* ctrs) {
  int* offs = misc + 16; int* stoffs = misc + 280; int* shv = misc;
  moe_offsets((const int*)(p.ws + O_CTL) + CW_CNT, offs, stoffs);
  const int myx = xcc_id(); int off = 0, x, idx;
  constexpr int NSPL = 2, NPER = 4 / NSPL;
  while (shard_next(ctrs, myx, off, [stoffs](int xx) { return stoffs[xx * 33 + 32] * NSPL + 128; }, shv, x, idx)) {
    const int n_routed = stoffs[x * 33 + 32] * NSPL;
    if (idx >= n_routed) { const int i2 = idx - n_routed, g = i2 >> 5, rem = i2 & 31, nt = rem >> 3, mt = x * 32 + g * 8 + (rem & 7); sh1_tile(p, nt * 256 + mt, smem); continue; }
    int tid = threadIdx.x; asm volatile("" : "+v"(tid));
    const int lane = tid & 63, wave = tid >> 6, wm = wave >> 1, wn = wave & 1;
    const int arow = tid >> 2, akc = tid & 3, kg = tid >> 5, n4 = tid & 31;
    const int r = lane & 31, hh = lane >> 5;
    const int aoff = (wm * 128 + r) * 40 + hh * 8;
    const int nb0 = wn * 64 + r, nb1 = nb0 + 32;
    const int boff0 = M2_A_ELEMS + (hh * 128 + (nb0 ^ ((nb0 >> 3) & 3))) * 8, boff1 = M2_A_ELEMS + (hh * 128 + (nb1 ^ ((nb1 >> 3) & 3))) * 8;
    const int j = find_le32(stoffs + x * 33, idx / NSPL), e = x + 8 * j;
    const int me = stoffs[x * 33 + j + 1] - stoffs[x * 33 + j], local = idx - stoffs[x * 33 + j] * NSPL, nt_lo = (local / me) * NPER, mt = local % me;
    const int cnt = offs[e + 1] - offs[e], nvalid = min(256, cnt - mt * 256);
    const int* list = (const int*)(p.ws + O_LIST) + (size_t)e * 32768 + mt * 256;
    const bf16* abase = (const bf16*)(p.ws + O_HHI);
    unsigned ao0, ao1, ao2, ao3;
    { const int r0 = arow < nvalid ? arow : nvalid - 1, r1 = arow + 64 < nvalid ? arow + 64 : nvalid - 1, r2 = arow + 128 < nvalid ? arow + 128 : nvalid - 1, r3 = arow + 192 < nvalid ? arow + 192 : nvalid - 1;
      const int t0 = list[r0], t1 = list[r1], t2 = list[r2], t3 = list[r3];
      ao0 = (unsigned)(t0 >> 3) * 1024u + akc * 8; ao1 = (unsigned)(t1 >> 3) * 1024u + akc * 8; ao2 = (unsigned)(t2 >> 3) * 1024u + akc * 8; ao3 = (unsigned)(t3 >> 3) * 1024u + akc * 8; }
    const long du = (long)(p.w_exp_up - p.w_exp_gate);
    const float* wb = p.w_exp_gate + (size_t)e * 262144 + (long)(((n4 * 4) >> 5) & 1) * du + ((n4 * 4) >> 6) * 32 + ((n4 * 4) & 31) + (size_t)(kg * 4) * 256;
    uint4 ra0, ra1, ra2, ra3; f32x4 rb[4];
#define GLOADX(nt, kt) { const bf16* ab_ = abase + (kt) * 32; ra0 = *(const uint4*)(ab_ + ao0); ra1 = *(const uint4*)(ab_ + ao1); ra2 = *(const uint4*)(ab_ + ao2); ra3 = *(const uint4*)(ab_ + ao3); \
      const float* bp_ = wb + (nt) * 64 + (size_t)((kt) * 32) * 256; _Pragma("unroll") for (int r_ = 0; r_ < 4; ++r_) rb[r_] = *(const f32x4*)(bp_ + r_ * 256); }
#define LSTOREX(buf) { bf16* A_ = smem + (buf) * M2_STAGE_ELEMS; bf16* B_ = A_ + M2_A_ELEMS; const int o_ = arow * 40 + akc * 8; \
      *(uint4*)(A_ + o_) = ra0; *(uint4*)(A_ + o_ + 64 * 40) = ra1; *(uint4*)(A_ + o_ + 128 * 40) = ra2; *(uint4*)(A_ + o_ + 192 * 40) = ra3; \
      _Pragma("unroll") for (int c_ = 0; c_ < 4; ++c_) { uint2 v_; v_.x = pk2(rb[0][c_], rb[1][c_]); v_.y = pk2(rb[2][c_], rb[3][c_]); const int n_ = n4 * 4 + c_; \
        *(uint2*)(B_ + ((kg >> 1) * 128 + (n_ ^ ((n_ >> 3) & 3))) * 8 + (kg & 1) * 4) = v_; } }
    GLOADX(nt_lo, 0); LSTOREX(0); __syncthreads();
    float* st = (float*)smem;
#pragma unroll 1
    for (int nt = nt_lo; nt < nt_lo + NPER; ++nt) {
      f32x16 acc[4][2];
#pragma unroll
      for (int mi = 0; mi < 4; ++mi)
#pragma unroll
        for (int q = 0; q < 16; ++q) { acc[mi][0][q] = 0.f; acc[mi][1][q] = 0.f; }
#pragma unroll 1
      for (int kt = 0; kt < 32; ++kt) {
        if (kt + 1 < 32) GLOADX(nt, kt + 1)
        const bf16* S = smem + (kt & 1) * M2_STAGE_ELEMS;
        if (wm * 128 < nvalid)
#pragma unroll
        for (int ks = 0; ks < 2; ++ks) {
          const bf16x8 b0 = *(const bf16x8*)(S + boff0 + ks * 2 * 128 * 8), b1 = *(const bf16x8*)(S + boff1 + ks * 2 * 128 * 8);
#pragma unroll
          for (int mi = 0; mi < 4; ++mi) { const bf16x8 a = *(const bf16x8*)(S + aoff + mi * 32 * 40 + ks * 16);
            acc[mi][0] = __builtin_amdgcn_mfma_f32_32x32x16_bf16(a, b0, acc[mi][0], 0, 0, 0);
            acc[mi][1] = __builtin_amdgcn_mfma_f32_32x32x16_bf16(a, b1, acc[mi][1], 0, 0, 0); }
          __builtin_amdgcn_sched_barrier(0);
        }
        if (kt + 1 < 32) LSTOREX((kt + 1) & 1);
        __syncthreads();
      }
#pragma unroll
      for (int mi = 0; mi < 4; ++mi) {
        float* bq = st + (wm * 128 + mi * 32 + 4 * (lane >> 5)) * 68 + wn * 32 + (lane & 31);
#pragma unroll
        for (int q = 0; q < 16; ++q) bq[(8 * (q >> 2) + (q & 3)) * 68] = siluf_(acc[mi][0][q]) * acc[mi][1][q]; }
      if (nt + 1 < nt_lo + NPER) GLOADX(nt + 1, 0)
      __syncthreads();
      bf16* dst = (bf16*)(p.ws + O_ACT) + (size_t)(offs[e] + mt * 256) * 256 + nt * 64;
#pragma unroll 2
      for (int jq = 0; jq < 8; ++jq) { const int u = tid + 256 * jq, row = u >> 3, cg = u & 7;
        if (row < nvalid) NT_ST16(pack8(st + row * 68 + cg * 8), dst + (size_t)row * 256 + cg * 8) }
      __syncthreads();
      if (nt + 1 < nt_lo + NPER) { LSTOREX(0); __syncthreads(); }
    }
#undef GLOADX
#undef LSTOREX
  }
}
DI void ph_moe2(PR p, bf16* smem, int* misc, int* ctrs) {
  int* offs = misc + 16; int* stoffs = misc + 280; int* shv = misc;
  int* lasg = (int*)((unsigned char*)smem + 67584); float* lw = (float*)((unsigned char*)smem + 67584 + 1024);
  moe_offsets((const int*)(p.ws + O_CTL) + CW_CNT, offs, stoffs);
  const int tid = threadIdx.x, lane = tid & 63, wave = tid >> 6, wm = wave >> 1, wn = wave & 1;
  const int arow = tid >> 2, akc = tid & 3, kg = tid >> 5, n4 = tid & 31;
  const int r = lane & 31, hh = lane >> 5;
  const int aoff = (wm * 128 + r) * 40 + hh * 8;
  const int nb0 = wn * 64 + r, nb1 = nb0 + 32;
  const int boff0 = M2_A_ELEMS + (hh * 128 + (nb0 ^ ((nb0 >> 3) & 3))) * 8, boff1 = M2_A_ELEMS + (hh * 128 + (nb1 ^ ((nb1 >> 3) & 3))) * 8;
  const int myx = xcc_id(); int off = 0, x, idx;
  constexpr int NSPL = 4, NPER = 8 / NSPL;
  while (shard_next(ctrs, myx, off, [stoffs](int xx) { return stoffs[xx * 33 + 32] * NSPL + 256; }, shv, x, idx)) {
    const int n_routed = stoffs[x * 33 + 32] * NSPL;
    if (idx >= n_routed) { const int i2 = idx - n_routed, g = i2 >> 6, rem = i2 & 63, nt = rem >> 3, mt = x * 32 + g * 8 + (rem & 7); sh2_tile(p, nt * 256 + mt, smem); continue; }
    const int j = find_le32(stoffs + x * 33, idx / NSPL), e = x + 8 * j;
    const int me = stoffs[x * 33 + j + 1] - stoffs[x * 33 + j], local = idx - stoffs[x * 33 + j] * NSPL, nt_lo = (local / me) * NPER, mt = local % me;
    const int cnt = offs[e + 1] - offs[e], nvalid = min(256, cnt - mt * 256);
    { const int rr = tid < nvalid ? tid : 0; const int asg = ((const int*)(p.ws + O_LIST))[(size_t)e * 32768 + mt * 256 + rr]; lasg[tid] = asg; lw[tid] = ((const float*)(p.ws + O_RW))[asg]; }
    const bf16* abase = (const bf16*)(p.ws + O_ACT) + (size_t)(offs[e] + mt * 256) * 256;
    const unsigned ao0 = (unsigned)(arow * 256 + akc * 8), ao1 = ao0 + 64 * 256, ao2 = ao0 + 128 * 256, ao3 = ao0 + 192 * 256;
    const float* wb = p.w_exp_down + (size_t)e * 262144 + n4 * 4 + (size_t)(kg * 4) * 1024;
    uint4 ra0, ra1, ra2, ra3; f32x4 rb[4];
#define GLOADX(nt, kt) { const bf16* ab_ = abase + (kt) * 32; ra0 = *(const uint4*)(ab_ + ao0); ra1 = *(const uint4*)(ab_ + ao1); ra2 = *(const uint4*)(ab_ + ao2); ra3 = *(const uint4*)(ab_ + ao3); \
      const float* bp_ = wb + (nt) * 128 + (size_t)((kt) * 32) * 1024; _Pragma("unroll") for (int r_ = 0; r_ < 4; ++r_) rb[r_] = *(const f32x4*)(bp_ + r_ * 1024); }
#define LSTOREX(buf) { bf16* A_ = smem + (buf) * M2_STAGE_ELEMS; bf16* B_ = A_ + M2_A_ELEMS; const int o_ = arow * 40 + akc * 8; \
      *(uint4*)(A_ + o_) = ra0; *(uint4*)(A_ + o_ + 64 * 40) = ra1; *(uint4*)(A_ + o_ + 128 * 40) = ra2; *(uint4*)(A_ + o_ + 192 * 40) = ra3; \
      _Pragma("unroll") for (int c_ = 0; c_ < 4; ++c_) { uint2 v_; v_.x = pk2(rb[0][c_], rb[1][c_]); v_.y = pk2(rb[2][c_], rb[3][c_]); const int n_ = n4 * 4 + c_; \
        *(uint2*)(B_ + ((kg >> 1) * 128 + (n_ ^ ((n_ >> 3) & 3))) * 8 + (kg & 1) * 4) = v_; } }
    GLOADX(nt_lo, 0); LSTOREX(0); __syncthreads();
    bf16* YK = (bf16*)(p.ws + O_YK);
    float* st = (float*)smem;
#pragma unroll 1
    for (int nt = nt_lo; nt < nt_lo + NPER; ++nt) {
      f32x16 acc[4][2];
#pragma unroll
      for (int mi = 0; mi < 4; ++mi)
#pragma unroll
        for (int q = 0; q < 16; ++q) { acc[mi][0][q] = 0.f; acc[mi][1][q] = 0.f; }
#pragma unroll 1
      for (int kt = 0; kt < 8; ++kt) {
        if (kt + 1 < 8) GLOADX(nt, kt + 1)
        const bf16* S = smem + (kt & 1) * M2_STAGE_ELEMS;
        if (wm * 128 < nvalid)
#pragma unroll
        for (int ks = 0; ks < 2; ++ks) {
          const bf16x8 b0 = *(const bf16x8*)(S + boff0 + ks * 2 * 128 * 8), b1 = *(const bf16x8*)(S + boff1 + ks * 2 * 128 * 8);
#pragma unroll
          for (int mi = 0; mi < 4; ++mi) { const bf16x8 a = *(const bf16x8*)(S + aoff + mi * 32 * 40 + ks * 16);
            acc[mi][0] = __builtin_amdgcn_mfma_f32_32x32x16_bf16(a, b0, acc[mi][0], 0, 0, 0);
            acc[mi][1] = __builtin_amdgcn_mfma_f32_32x32x16_bf16(a, b1, acc[mi][1], 0, 0, 0); }
          __builtin_amdgcn_sched_barrier(0);
        }
        if (kt + 1 < 8) LSTOREX((kt + 1) & 1);
        __syncthreads();
      }
      const int n0 = nt * 128;
#pragma unroll 1
      for (int h = 0; h < 2; ++h) {
        if (wm == h) {
#pragma unroll
          for (int mi = 0; mi < 4; ++mi)
#pragma unroll
            for (int ni = 0; ni < 2; ++ni) { float* bq = st + (mi * 32 + 4 * (lane >> 5)) * ST_LD + wn * 64 + ni * 32 + (lane & 31);
#pragma unroll
              for (int q = 0; q < 16; ++q) bq[(8 * (q >> 2) + (q & 3)) * ST_LD] = acc[mi][ni][q]; }
        }
        if (h == 1 && nt + 1 < nt_lo + NPER) GLOADX(nt + 1, 0)
        __syncthreads();
#pragma unroll 2
        for (int jq = 0; jq < 8; ++jq) { const int u = tid + 256 * jq, row = u >> 4, cg = u & 15, grow = h * 128 + row;
          if (grow < nvalid) { const float w = lw[grow]; const float* s = st + row * ST_LD + cg * 8; const f32x4 a = *(const f32x4*)s, bq = *(const f32x4*)(s + 4);
            uint4 o; o.x = pk2(w * a[0], w * a[1]); o.y = pk2(w * a[2], w * a[3]); o.z = pk2(w * bq[0], w * bq[1]); o.w = pk2(w * bq[2], w * bq[3]);
            { typedef unsigned u32x4_t __attribute__((ext_vector_type(4))); u32x4_t ov = {o.x, o.y, o.z, o.w}; __builtin_nontemporal_store(ov, (u32x4_t*)(YK + (size_t)lasg[grow] * 1024 + n0 + cg * 8)); } } }
        __syncthreads();
      }
      if (nt + 1 < nt_lo + NPER) { LSTOREX(0); __syncthreads(); }
    }
#undef GLOADX
#undef LSTOREX
  }
}

DI void final_row(PR p, int tok, int lane) {
  const int b = tok >> 11;
  const float* mod = (const float*)(p.ws + O_MOD) + b * 6144;
  const float* X1 = (const float*)(p.ws + O_X1) + (size_t)tok * 1024;
  const bf16* YK = (const bf16*)(p.ws + O_YK) + (size_t)tok * 8 * 1024; const bf16* YS = (const bf16*)(p.ws + O_YSH) + (size_t)tok * 1024;
  float4 v[4]; float s = 0.f;
#pragma unroll
  for (int j = 0; j < 4; ++j) {
    const int col = (lane + 64 * j) * 4;
    typedef unsigned u32x2_t __attribute__((ext_vector_type(2)));
    const u32x2_t ysq = __builtin_nontemporal_load((const u32x2_t*)(YS + col));
    float f0 = __uint_as_float(ysq.x << 16), f1 = __uint_as_float(ysq.x & 0xffff0000u), f2 = __uint_as_float(ysq.y << 16), f3 = __uint_as_float(ysq.y & 0xffff0000u);
#pragma unroll
    for (int k = 0; k < 8; ++k) { typedef unsigned u32x2_t __attribute__((ext_vector_type(2))); const u32x2_t yq = __builtin_nontemporal_load((const u32x2_t*)(YK + (size_t)k * 1024 + col)); f0 += __uint_as_float(yq.x << 16); f1 += __uint_as_float(yq.x & 0xffff0000u); f2 += __uint_as_float(yq.y << 16); f3 += __uint_as_float(yq.y & 0xffff0000u); }
    const f32x4 x1v = __builtin_nontemporal_load((const f32x4*)(X1 + col)); float4 x1; x1.x = x1v[0]; x1.y = x1v[1]; x1.z = x1v[2]; x1.w = x1v[3]; const float4 g2 = *(const float4*)(mod + 5120 + col);
    v[j].x = DN_ALPHA * x1.x + g2.x * f0; v[j].y = DN_ALPHA * x1.y + g2.y * f1; v[j].z = DN_ALPHA * x1.z + g2.z * f2; v[j].w = DN_ALPHA * x1.w + g2.w * f3;
    s += (v[j].x + v[j].y) + (v[j].z + v[j].w);
  }
  const float mean = wave_sum(s) * (1.f / 1024.f); float s2 = 0.f;
#pragma unroll
  for (int j = 0; j < 4; ++j) { v[j].x -= mean; v[j].y -= mean; v[j].z -= mean; v[j].w -= mean; s2 += (v[j].x * v[j].x + v[j].y * v[j].y) + (v[j].z * v[j].z + v[j].w * v[j].w); }
  const float rstd = 1.f / sqrtf(wave_sum(s2) * (1.f / 1024.f) + LN_EPS);
#pragma unroll
  for (int j = 0; j < 4; ++j) {
    const int col = (lane + 64 * j) * 4;
    const float4 g = *(const float4*)(p.ln2_g + col), bb = *(const float4*)(p.ln2_b + col);
    float4 o; o.x = v[j].x * rstd * g.x + bb.x; o.y = v[j].y * rstd * g.y + bb.y; o.z = v[j].z * rstd * g.z + bb.z; o.w = v[j].w * rstd * g.w + bb.w;
    { f32x4 ov = {o.x, o.y, o.z, o.w}; __builtin_nontemporal_store(ov, (f32x4*)(p.out + (size_t)tok * 1024 + col)); }
  }
}

__global__ void __launch_bounds__(256, 2) mega(P p_arg) {
  PR p = *(const __attribute__((address_space(4))) P*)__builtin_amdgcn_kernarg_segment_ptr();
  extern __shared__ __attribute__((aligned(16))) unsigned char lds[];
  cg::grid_group grid = cg::this_grid();
  bf16* smem = (bf16*)lds; int* misc = (int*)(lds + MISC_OFF); int* shv = misc;
  int* qc = (int*)(p.ws + O_CTL) + CW_Q;
#define NREP(k) 1
#define QC(k) (qc + (k) + 32 * rep_)
#define SQ(k) ((int*)(p.ws + O_CTL) + 32768 + (k) * 512 + rep_ * 256)
#define PH_BEGIN(k) if (p.ph_lo <= (k) && (k) < p.ph_hi) { int tx_ = threadIdx.x; asm volatile("" : "+v"(tx_)); const int lane = tx_ & 63, wave = tx_ >> 6, gw = blockIdx.x * 4 + wave, NGW = gridDim.x * 4; (void)lane; (void)gw; (void)NGW; \
  for (int rep_ = 0; rep_ < NREP(k); ++rep_) { if (rep_) { xcd_barrier(gbar, myxcc, xst); }
#define PH_STAMP(k)
#define PH_END(k) } if ((k) + 1 < p.ph_hi) { xcd_barrier(gbar, myxcc, xst); PH_STAMP(k) } }
  unsigned* gbar = (unsigned*)(p.ws + O_CTL) + 65536; const unsigned myxcc = (unsigned)__builtin_amdgcn_s_getreg((3 << 11) | 20) & 0xFu;
  volatile unsigned* xst = (volatile unsigned*)(misc + 1000);
  if (threadIdx.x == 0) { xst[0] = 0u; xst[1] = 0u; }
  if (threadIdx.x == 0) (void)xb_add(&gbar[XB_XCNT(myxcc)], 1u);
  PH_STAMP(-1)
  if (p.ph_lo <= 0 && 0 < p.ph_hi) { { const int rep_ = 0; (void)rep_; ph_prologue(p, lds, QC(0), shv); } if (1 < p.ph_hi) { grid.sync(); PH_STAMP(0) } }
  PH_BEGIN(1) ph_u(p); PH_END(1)
  PH_BEGIN(2) ph_inproj(p, smem, SQ(2), shv); PH_END(2)
  PH_BEGIN(3)
    { const int myx = xcc_id(); int off = 0, x, idx;
      while (shard_next(SQ(3), myx, off, [](int) { return 144; }, shv, x, idx)) { const int it = idx * 8 + x;
        if (it < 128) cmp1_tile(p, it, smem); else { const int j = it - 128; idx_item(p, j & 15, 63 - (j >> 4), lds); } } }
  PH_END(3)
  PH_BEGIN(4)
    for (;;) { const int it = sched_next(QC(4), shv); if (it >= 64) break; cmp2_tile(p, it, smem); }
  PH_END(4)
  PH_BEGIN(5)
    { const int myx = xcc_id(); int off = 0, x, idx;
    while (shard_next(SQ(5), myx, off, [](int) { return 768; }, shv, x, idx)) { const int it = idx * 8 + ((x + idx) & 7);
      if (it < 4096) { const int ty = it & 1, j = it >> 1, qt = 63 - (j >> 5), bg = j & 31;
        if (ty == 0) attn_item<0>(p, bg >> 1, bg & 1, qt, smem); else attn_item<1>(p, bg >> 1, bg & 1, qt, smem); }
      else { const int j = it - 4096, qt = j >> 5, bg = j & 31; cmp_item(p, bg >> 1, bg & 1, qt, lds); } } }
  PH_END(5)
  PH_BEGIN(6) { const int myx = xcc_id(); int off = 0, x, idx; while (shard_next(SQ(6), myx, off, [](int) { return 256; }, shv, x, idx)) { const int it = idx * 8 + x; const int qt = 63 - (it >> 5), bg = it & 31; attn_item<2>(p, bg >> 1, bg & 1, qt, smem); } } PH_END(6)
  PH_BEGIN(7) { const int myx = xcc_id(); int off = 0, x, idx; while (shard_next(SQ(7), myx, off, [](int) { return 256; }, shv, x, idx)) { const int g = idx >> 6, rem = idx & 63; merge_tile(p, (rem >> 3) * 256 + x * 32 + g * 8 + (rem & 7), smem); } } PH_END(7)
  PH_BEGIN(8) { const int myx = xcc_id(); int off = 0, x, idx; while (shard_next(SQ(8), myx, off, [](int) { return 128; }, shv, x, idx)) { const int g = idx >> 6, rem = idx & 63; out_tile(p, (rem >> 3) * 128 + x * 16 + g * 8 + (rem & 7), smem); } } PH_END(8)
  PH_BEGIN(9) for (int w = gw; w < T; w += NGW) ln1_row(p, w, lane); PH_END(9)
  PH_BEGIN(10) { const int myx = xcc_id(); int off = 0, x, idx; while (shard_next(SQ(10), myx, off, [](int) { return 64; }, shv, x, idx)) { const int g = idx >> 4, rem = idx & 15; router_tile(p, (rem >> 3) * 256 + x * 32 + g * 8 + (rem & 7), smem); } } PH_END(10)
  PH_BEGIN(11) for (int w = gw; w < T; w += NGW) route_token(p.ws, (const float*)(p.ws + O_LOGITS) + (size_t)w * 256, p.router_bias, w, lane); PH_END(11)
  PH_BEGIN(12) ph_moe1(p, smem, misc, SQ(12)); PH_END(12)
  PH_BEGIN(13) ph_moe2(p, smem, misc, SQ(13)); PH_END(13)
  PH_BEGIN(14) for (int w = gw; w < T; w += NGW) final_row(p, w, lane); PH_END(14)
}

extern "C" void kernel_launch(void* const* d_in, const int* in_sizes, int n_in, void* d_out, int out_size, void* d_ws, size_t ws_size, hipStream_t stream) {
  if (n_in != 27 || ws_size < WS_NEED2) { fprintf(stderr, "kernel_launch: unexpected n_in %d / ws_size %zu (need %zu)\n", n_in, ws_size, (size_t)WS_NEED2); return; }
  static int grid_blocks = 0;
  if (!grid_blocks) {
    int dev = 0, cus = 0, per_cu = 0;
    (void)hipGetDevice(&dev);
    (void)hipDeviceGetAttribute(&cus, hipDeviceAttributeMultiprocessorCount, dev);
    (void)hipFuncSetAttribute((const void*)mega, hipFuncAttributeMaxDynamicSharedMemorySize, LDS_BYTES);
    (void)hipOccupancyMaxActiveBlocksPerMultiprocessor(&per_cu, mega, 256, LDS_BYTES);
    if (per_cu < 1) per_cu = 1;
    grid_blocks = cus * per_cu;
    fprintf(stderr, "kernel_launch: cus %d per_cu %d grid %d\n", cus, per_cu, grid_blocks);
  }
  P p{};
  p.x = (const float*)d_in[0]; p.c = (const float*)d_in[1]; p.pos = (const int*)d_in[2];
  p.w_ada = (const float*)d_in[3]; p.b_ada = (const float*)d_in[4]; p.w_in = (const float*)d_in[5]; p.w_br_a = (const float*)d_in[6]; p.w_br_b = (const float*)d_in[7];
  p.w_out = (const float*)d_in[8]; p.cmp_pos_k = (const float*)d_in[9]; p.cmp_pos_v = (const float*)d_in[10]; p.cmp_k_w1 = (const float*)d_in[11]; p.cmp_k_w2 = (const float*)d_in[12];
  p.cmp_v_w1 = (const float*)d_in[13]; p.cmp_v_w2 = (const float*)d_in[14]; p.ln1_g = (const float*)d_in[15]; p.ln1_b = (const float*)d_in[16]; p.w_router = (const float*)d_in[17];
  p.router_bias = (const float*)d_in[18]; p.w_exp_gate = (const float*)d_in[19]; p.w_exp_up = (const float*)d_in[20]; p.w_exp_down = (const float*)d_in[21];
  p.w_sh_gate = (const float*)d_in[22]; p.w_sh_up = (const float*)d_in[23]; p.w_sh_down = (const float*)d_in[24]; p.ln2_g = (const float*)d_in[25]; p.ln2_b = (const float*)d_in[26];
  p.out = (float*)d_out; p.ws = (unsigned char*)d_ws;
  p.ph_lo = 0; p.ph_hi = NPHASE;
  (void)hipMemsetAsync((char*)d_ws + O_CTL, 0, 1 * MiB, stream);
  void* args[] = {&p};
  hipError_t e = hipLaunchCooperativeKernel((void*)mega, dim3(grid_blocks), dim3(256), args, LDS_BYTES, stream);
  if (e != hipSuccess) fprintf(stderr, "cooperative launch failed: %s (grid %d)\n", hipGetErrorString(e), grid_blocks);
}
```

```cpp
#include <hip/hip_runtime.h>
#include <hip/hip_cooperative_groups.h>
#include <stdint.h>
#include <stdio.h>
namespace cg = cooperative_groups;

typedef unsigned short bf16;
typedef float f32x16 __attribute__((ext_vector_type(16)));
typedef float f32x4 __attribute__((ext_vector_type(4)));
typedef float f32x2 __attribute__((ext_vector_type(2)));
typedef short bf16x8 __attribute__((ext_vector_type(8)));
typedef __bf16 bf16x2_t __attribute__((ext_vector_type(2)));
typedef unsigned u32x4 __attribute__((ext_vector_type(4)));
#define NT_LD16(p_) __builtin_nontemporal_load((const u32x4*)(p_))
#define NT_ST16(v_, p_) { const uint4 t__ = (v_); u32x4 q__ = {t__.x, t__.y, t__.z, t__.w}; __builtin_nontemporal_store(q__, (u32x4*)(p_)); }
#define DI __device__ __forceinline__

constexpr int D = 1024, NB = 16, S = 2048, T = NB * S, NIN = 4416;
constexpr float DN_ALPHA = 1.189207115002721f;
constexpr float LN_EPS = 1e-5f;
constexpr float NEGF = -1e30f;

constexpr size_t MiB = 1ull << 20;
constexpr size_t O_CTL = 0;
constexpr size_t O_MOD = 1 * MiB;
constexpr size_t O_ROPEH = 2 * MiB;
constexpr size_t O_ROPEI = 4 * MiB;
constexpr size_t O_CMPB = 5 * MiB;
constexpr size_t O_SELM = 6 * MiB;
constexpr size_t O_DSAM = 8 * MiB;
constexpr size_t O_RIDX = 16 * MiB;
constexpr size_t O_RW = 17 * MiB;
constexpr size_t O_LIST = 18 * MiB;
constexpr size_t O_H1 = 50 * MiB;
constexpr size_t BASE = 64 * MiB;
constexpr size_t O_U = BASE + 0 * MiB;
constexpr size_t O_SGA = BASE + 64 * MiB;
constexpr size_t O_SGB = BASE + 128 * MiB;
constexpr size_t O_QA = BASE + 192 * MiB;
constexpr size_t O_QBR = BASE + 224 * MiB;
constexpr size_t O_QBT = BASE + 256 * MiB;
constexpr size_t O_QI = BASE + 288 * MiB;
constexpr size_t O_KA = BASE + 304 * MiB;
constexpr size_t O_VAT = BASE + 312 * MiB;
constexpr size_t O_KS = BASE + 320 * MiB;
constexpr size_t O_VST = BASE + 328 * MiB;
constexpr size_t O_KW = BASE + 336 * MiB;
constexpr size_t O_VWT = BASE + 344 * MiB;
constexpr size_t O_KC = BASE + 352 * MiB;
constexpr size_t O_VC = BASE + 361 * MiB;
constexpr size_t O_KI = BASE + 370 * MiB;
constexpr size_t O_WI = BASE + 372 * MiB;
constexpr size_t O_GN = BASE + 373 * MiB;
constexpr size_t O_KCC = BASE + 376 * MiB;
constexpr size_t O_VCCT = BASE + 377 * MiB;
constexpr size_t O_OA = BASE + 378 * MiB;
constexpr size_t O_OCMP = BASE + 410 * MiB;
constexpr size_t O_OB = BASE + 442 * MiB;
constexpr size_t O_OWIN = BASE + 826 * MiB;
constexpr size_t O_MERGED = BASE + 474 * MiB;
constexpr size_t O_SC = BASE + 538 * MiB;
constexpr size_t O_Y = O_SC;
constexpr size_t O_X1 = BASE + 0 * MiB;
constexpr size_t O_HHI = BASE + 128 * MiB;
constexpr size_t O_HLO = BASE + 192 * MiB;
constexpr size_t O_YSH = O_HLO;
constexpr size_t O_ACTSH = BASE + 256 * MiB;
constexpr size_t O_ACT = BASE + 272 * MiB;
constexpr size_t O_YK = BASE + 400 * MiB;
constexpr size_t O_LOGITS = O_YK;
constexpr size_t WS_NEED = BASE + 912 * MiB;
constexpr size_t O_WT = 976 * MiB;
constexpr size_t O_WT_IN = O_WT;
constexpr size_t O_WT_BRA = O_WT + 10 * MiB;
constexpr size_t O_WT_BRB = O_WT + 11 * MiB;
constexpr size_t O_WT_OUT = O_WT + 12 * MiB;
constexpr size_t O_WT_RT = O_WT + 14 * MiB;
constexpr size_t O_WT_SGU = O_WT + 15 * MiB;
constexpr size_t O_WT_SD = O_WT + 16 * MiB;
constexpr size_t O_WT_C1K = O_WT + 17 * MiB;
constexpr size_t O_WT_C1V = O_WT + 18 * MiB;
constexpr size_t O_WT_C2K = O_WT + 19 * MiB;
constexpr size_t O_WT_C2V = O_WT + 19 * MiB + 65536;
constexpr size_t WS_NEED2 = O_WT + 20 * MiB;

constexpr int CW_CNT = 16384, CNT_STRIDE = 32;
constexpr int CW_Q = 64;

constexpr int NPHASE = 15;
constexpr int LDS_ROW = 72;
constexpr int TILE_ELEMS = 128 * LDS_ROW;
constexpr int GEMM_LDS_BYTES = 4 * TILE_ELEMS * 2;
constexpr int MISC_OFF = GEMM_LDS_BYTES;
constexpr int LDS_BYTES = GEMM_LDS_BYTES + 4096;

struct P {
  const float *x, *c; const int* pos;
  const float *w_ada, *b_ada, *w_in, *w_br_a, *w_br_b, *w_out, *cmp_pos_k, *cmp_pos_v, *cmp_k_w1, *cmp_k_w2, *cmp_v_w1, *cmp_v_w2,
      *ln1_g, *ln1_b, *w_router, *router_bias, *w_exp_gate, *w_exp_up, *w_exp_down, *w_sh_gate, *w_sh_up, *w_sh_down, *ln2_g, *ln2_b;
  float* out; unsigned char* ws;
  int ph_lo, ph_hi;
};

typedef const __attribute__((address_space(4))) P& PR;

DI bf16 f2bf(float f) { unsigned u = __float_as_uint(f); u += 0x7fffu + ((u >> 16) & 1u); return (bf16)(u >> 16); }
DI float bf2f(bf16 h) { return __uint_as_float(((unsigned)h) << 16); }
DI unsigned pk2(float a, float b) { f32x2 v = {a, b}; bf16x2_t r = __builtin_convertvector(v, bf16x2_t); return __builtin_bit_cast(unsigned, r); }
DI size_t blk_off(int row, int k, int K) { return ((size_t)(row >> 7) * (K >> 5) + (k >> 5)) * 4096 + (row & 127) * 32 + (k & 31); }
DI float sigmoidf_(float v) { return 1.f / (1.f + __expf(-v)); }
DI float siluf_(float v) { return v / (1.f + __expf(-v)); }
DI float wave_sum(float v) {
#pragma unroll
  for (int o = 1; o < 64; o <<= 1) v += __shfl_xor(v, o);
  return v;
}
DI float wave_max(float v) {
#pragma unroll
  for (int o = 1; o < 64; o <<= 1) v = fmaxf(v, __shfl_xor(v, o));
  return v;
}
DI void grid_barrier(unsigned* bar, unsigned target) {
  asm volatile("s_waitcnt vmcnt(0)" ::: "memory");
  __syncthreads();
  if (threadIdx.x == 0) {
    __builtin_amdgcn_fence(__ATOMIC_RELEASE, "agent");
    asm volatile("s_waitcnt vmcnt(0)" ::: "memory");
    __hip_atomic_fetch_add(bar, 1u, __ATOMIC_RELAXED, __HIP_MEMORY_SCOPE_AGENT);
    while (__hip_atomic_load(bar, __ATOMIC_RELAXED, __HIP_MEMORY_SCOPE_AGENT) < target) __builtin_amdgcn_s_sleep(2);
    __builtin_amdgcn_fence(__ATOMIC_ACQUIRE, "agent");
    asm volatile("s_waitcnt vmcnt(0)" ::: "memory");
  }
  __syncthreads();
}
DI int xcc_id() { return (int)(__builtin_amdgcn_s_getreg((3 << 11) | 20) & 7u); }
template <class NSub>
DI bool shard_next(int* ctrs, int myx, int& off, NSub nsub, int* shv, int& x, int& idx) {
  __syncthreads();
  if (threadIdx.x == 0) {
    int o = off, rx = -1, ri = 0;
    while (o < 8) { const int xx = (myx + o) & 7; const int i = atomicAdd(&ctrs[xx * 32], 1); if (i < nsub(xx)) { rx = xx; ri = i; break; } ++o; }
    shv[0] = rx; shv[1] = ri; shv[2] = o;
  }
  __syncthreads();
  x = shv[0]; idx = shv[1]; off = shv[2];
  return x >= 0;
}

#define XB_TMO      128
#define XB_XCNT(j)  (256  + 64 * (j))
#define XB_XSUB(j)  (1280 + 64 * (j))
#define XB_XGEN(j)  (2304 + 64 * (j))
#define XB_TOP      3328
#define XB_TOPGEN   3392
#define XB_SPIN_CAP (1u << 22)
DI unsigned xb_ld(unsigned* p) { return __hip_atomic_load(p, __ATOMIC_RELAXED, __HIP_MEMORY_SCOPE_AGENT); }
DI unsigned xb_add(unsigned* p, unsigned v) { return __hip_atomic_fetch_add(p, v, __ATOMIC_RELAXED, __HIP_MEMORY_SCOPE_AGENT); }
#define XB_SPIN(cond, bar) do { unsigned _sp = 0; while (cond) { __builtin_amdgcn_s_sleep(1); \
    if ((++_sp & 255u) == 0u) { if (xb_ld(&(bar)[XB_TMO])) break; if (_sp > XB_SPIN_CAP) { atomicAdd(&(bar)[XB_TMO], 1u); break; } } } } while (0)
DI void xcd_barrier_complete(unsigned* bar, unsigned x, unsigned& nloc, unsigned& nx) {
  const unsigned G = gridDim.x;
  unsigned sum, cnt, mine, sp = 0u;
  for (;;) {
    sum = 0u; cnt = 0u; mine = 0u;
#pragma unroll
    for (unsigned j = 0; j < 16; ++j) { const unsigned c = xb_ld(&bar[XB_XCNT(j)]); sum += c; cnt += (c > 0u) ? 1u : 0u; mine = (j == x) ? c : mine; }
    if (sum == G) break;
    __builtin_amdgcn_s_sleep(1);
    if ((++sp & 255u) == 0u) { if (xb_ld(&bar[XB_TMO])) break; if (sp > XB_SPIN_CAP) { atomicAdd(&bar[XB_TMO], 1u); break; } }
  }
  nloc = mine > 0u ? mine : 1u; nx = cnt > 0u ? cnt : 1u;
}
DI void xcd_barrier(unsigned* bar, unsigned x, volatile unsigned* st) {
  asm volatile("s_waitcnt vmcnt(0)" ::: "memory");
  __syncthreads();
  if (threadIdx.x == 0) {
    __builtin_amdgcn_s_waitcnt(0);
    unsigned nloc = st[0], nx = st[1];
    if (nloc == 0u) { xcd_barrier_complete(bar, x, nloc, nx); st[0] = nloc; st[1] = nx; }
    const unsigned old = xb_add(&bar[XB_XSUB(x)], 1u);
    const unsigned gen = old / nloc;
    if (old + 1u == (gen + 1u) * nloc) {
      __builtin_amdgcn_fence(__ATOMIC_RELEASE, "agent");
      asm volatile("s_waitcnt vmcnt(0)" ::: "memory");
      const unsigned og = xb_add(&bar[XB_TOP], 1u);
      const unsigned tg = og / nx;
      if (og + 1u == (tg + 1u) * nx) xb_add(&bar[XB_TOPGEN], 1u);
      else XB_SPIN(xb_ld(&bar[XB_TOPGEN]) == tg, bar);
      __builtin_amdgcn_fence(__ATOMIC_ACQUIRE, "agent");
      xb_add(&bar[XB_XGEN(x)], 1u);
      asm volatile("s_waitcnt vmcnt(0)" ::: "memory");
    } else {
      XB_SPIN(xb_ld(&bar[XB_XGEN(x)]) == gen, bar);
      __builtin_amdgcn_fence(__ATOMIC_ACQUIRE, "agent");
      asm volatile("s_waitcnt vmcnt(0)" ::: "memory");
    }
  }
  __syncthreads();
}
DI int sched_next(int* ctr, int* shv) {
  __syncthreads();
  if (threadIdx.x == 0) *shv = atomicAdd(ctr, 1);
  __syncthreads();
  return *shv;
}

template <class AL, class BL>
DI void gemm_mainloop(f32x16 (&acc)[2][2], const AL& al, BL& bl, int ktiles, bf16* smem) {
  const int tid = threadIdx.x, lane = tid & 63, wave = tid >> 6, wm = wave >> 1, wn = wave & 1;
  const int arow = tid >> 3, akc = tid & 7, kg = tid >> 5, n4 = tid & 31;
  const bf16* ap0 = al.rowptr(arow) + akc * 8;
  const bf16* ap1 = al.rowptr(arow + 32) + akc * 8;
  const bf16* ap2 = al.rowptr(arow + 64) + akc * 8;
  const bf16* ap3 = al.rowptr(arow + 96) + akc * 8;
  bl.init(n4 * 4);
  uint4 ra0, ra1, ra2, ra3; f32x4 rb[8];
#define GLOAD(kt) { const int ko_ = al.koff(kt); ra0 = *(const uint4*)(ap0 + ko_); ra1 = *(const uint4*)(ap1 + ko_); ra2 = *(const uint4*)(ap2 + ko_); ra3 = *(const uint4*)(ap3 + ko_); \
    _Pragma("unroll") for (int r_ = 0; r_ < 8; ++r_) rb[r_] = bl.ld(kt, kg * 8 + r_); }
#define LSTORE(buf) { bf16* A_ = smem + (buf) * 2 * TILE_ELEMS; bf16* B_ = A_ + TILE_ELEMS; \
    *(uint4*)(A_ + (arow) * LDS_ROW + akc * 8) = ra0; *(uint4*)(A_ + (arow + 32) * LDS_ROW + akc * 8) = ra1; \
    *(uint4*)(A_ + (arow + 64) * LDS_ROW + akc * 8) = ra2; *(uint4*)(A_ + (arow + 96) * LDS_ROW + akc * 8) = ra3; \
    _Pragma("unroll") for (int c_ = 0; c_ < 4; ++c_) { uint4 v_; v_.x = pk2(rb[0][c_], rb[1][c_]); v_.y = pk2(rb[2][c_], rb[3][c_]); v_.z = pk2(rb[4][c_], rb[5][c_]); v_.w = pk2(rb[6][c_], rb[7][c_]); \
      *(uint4*)(B_ + (n4 * 4 + c_) * LDS_ROW + kg * 8) = v_; } }
  GLOAD(0); LSTORE(0); __syncthreads();
  const int aoff = (wm * 64 + (lane & 31)) * LDS_ROW + (lane >> 5) * 8;
  const int boff = (wn * 64 + (lane & 31)) * LDS_ROW + (lane >> 5) * 8;
  for (int kt = 0; kt < ktiles; ++kt) {
    if (kt + 1 < ktiles) GLOAD(kt + 1);
    const bf16* A = smem + (kt & 1) * 2 * TILE_ELEMS; const bf16* B = A + TILE_ELEMS;
    bf16x8 a0 = *(const bf16x8*)(A + aoff), a1 = *(const bf16x8*)(A + aoff + 32 * LDS_ROW);
    bf16x8 b0 = *(const bf16x8*)(B + boff), b1 = *(const bf16x8*)(B + boff + 32 * LDS_ROW);
#pragma unroll
    for (int ks = 0; ks < 4; ++ks) {
      bf16x8 na0 = a0, na1 = a1, nb0 = b0, nb1 = b1;
      if (ks < 3) { na0 = *(const bf16x8*)(A + aoff + (ks + 1) * 16); na1 = *(const bf16x8*)(A + aoff + 32 * LDS_ROW + (ks + 1) * 16);
        nb0 = *(const bf16x8*)(B + boff + (ks + 1) * 16); nb1 = *(const bf16x8*)(B + boff + 32 * LDS_ROW + (ks + 1) * 16); }
      acc[0][0] = __builtin_amdgcn_mfma_f32_32x32x16_bf16(a0, b0, acc[0][0], 0, 0, 0);
      acc[0][1] = __builtin_amdgcn_mfma_f32_32x32x16_bf16(a0, b1, acc[0][1], 0, 0, 0);
      acc[1][0] = __builtin_amdgcn_mfma_f32_32x32x16_bf16(a1, b0, acc[1][0], 0, 0, 0);
      acc[1][1] = __builtin_amdgcn_mfma_f32_32x32x16_bf16(a1, b1, acc[1][1], 0, 0, 0);
      __builtin_amdgcn_sched_barrier(0);
      a0 = na0; a1 = na1; b0 = nb0; b1 = nb1;
    }
    if (kt + 1 < ktiles) LSTORE((kt + 1) & 1);
    __syncthreads();
  }
#undef GLOAD
#undef LSTORE
}
template <class AL, class BLB>
DI void gemm_mainloop_bb(f32x16 (&acc)[2][2], const AL& al, const BLB& bl, int ktiles, bf16* smem) {
  const int tid = threadIdx.x, lane = tid & 63, wave = tid >> 6, wm = wave >> 1, wn = wave & 1;
  const int arow = tid >> 3, akc = tid & 7;
  const bf16* ap0 = al.rowptr(arow) + akc * 8;
  const bf16* ap1 = al.rowptr(arow + 32) + akc * 8;
  const bf16* ap2 = al.rowptr(arow + 64) + akc * 8;
  const bf16* ap3 = al.rowptr(arow + 96) + akc * 8;
  const bf16* bp0 = bl.rowptr(arow) + akc * 8;
  const bf16* bp1 = bl.rowptr(arow + 32) + akc * 8;
  const bf16* bp2 = bl.rowptr(arow + 64) + akc * 8;
  const bf16* bp3 = bl.rowptr(arow + 96) + akc * 8;
  uint4 ra0, ra1, ra2, ra3, rb0, rb1, rb2, rb3;
#define GLOAD(kt) { const int ko_ = al.koff(kt), kb_ = bl.koff(kt); ra0 = *(const uint4*)(ap0 + ko_); ra1 = *(const uint4*)(ap1 + ko_); ra2 = *(const uint4*)(ap2 + ko_); ra3 = *(const uint4*)(ap3 + ko_); \
    rb0 = *(const uint4*)(bp0 + kb_); rb1 = *(const uint4*)(bp1 + kb_); rb2 = *(const uint4*)(bp2 + kb_); rb3 = *(const uint4*)(bp3 + kb_); }
#define LSTORE(buf) { bf16* A_ = smem + (buf) * 2 * TILE_ELEMS; bf16* B_ = A_ + TILE_ELEMS; const int o_ = arow * LDS_ROW + akc * 8; \
    *(uint4*)(A_ + o_) = ra0; *(uint4*)(A_ + o_ + 32 * LDS_ROW) = ra1; *(uint4*)(A_ + o_ + 64 * LDS_ROW) = ra2; *(uint4*)(A_ + o_ + 96 * LDS_ROW) = ra3; \
    *(uint4*)(B_ + o_) = rb0; *(uint4*)(B_ + o_ + 32 * LDS_ROW) = rb1; *(uint4*)(B_ + o_ + 64 * LDS_ROW) = rb2; *(uint4*)(B_ + o_ + 96 * LDS_ROW) = rb3; }
  GLOAD(0); LSTORE(0); __syncthreads();
  const int aoff = (wm * 64 + (lane & 31)) * LDS_ROW + (lane >> 5) * 8;
  const int boff = (wn * 64 + (lane & 31)) * LDS_ROW + (lane >> 5) * 8;
  for (int kt = 0; kt < ktiles; ++kt) {
    if (kt + 1 < ktiles) GLOAD(kt + 1);
    const bf16* A = smem + (kt & 1) * 2 * TILE_ELEMS; const bf16* B = A + TILE_ELEMS;
#pragma unroll
    for (int ks = 0; ks < 4; ++ks) {
      const bf16x8 a0 = *(const bf16x8*)(A + aoff + ks * 16), a1 = *(const bf16x8*)(A + aoff + 32 * LDS_ROW + ks * 16);
      const bf16x8 b0 = *(const bf16x8*)(B + boff + ks * 16), b1 = *(const bf16x8*)(B + boff + 32 * LDS_ROW + ks * 16);
      acc[0][0] = __builtin_amdgcn_mfma_f32_32x32x16_bf16(a0, b0, acc[0][0], 0, 0, 0);
      acc[0][1] = __builtin_amdgcn_mfma_f32_32x32x16_bf16(a0, b1, acc[0][1], 0, 0, 0);
      acc[1][0] = __builtin_amdgcn_mfma_f32_32x32x16_bf16(a1, b0, acc[1][0], 0, 0, 0);
      acc[1][1] = __builtin_amdgcn_mfma_f32_32x32x16_bf16(a1, b1, acc[1][1], 0, 0, 0);
    }
    if (kt + 1 < ktiles) LSTORE((kt + 1) & 1);
    __syncthreads();
  }
#undef GLOAD
#undef LSTORE
}

#define WAIT_V(n) asm volatile("s_waitcnt vmcnt(%0)" ::"n"(n) : "memory")
#define RAW_BARRIER() do { asm volatile("s_waitcnt lgkmcnt(0)" ::: "memory"); __builtin_amdgcn_s_barrier(); } while (0)
template <class AL, class BLB>
DI void gemm_mainloop_dma(f32x16 (&acc)[2][2], const AL& al, const BLB& bl, int ktiles, unsigned char* lds) {
  const int tid = threadIdx.x, lane = tid & 63, wave = tid >> 6, wm = wave >> 1, wn = wave & 1;
  const int r0 = 16 * (wave * 2) + (lane >> 2), r1 = r0 + 16;
  const bf16* ga0 = al.rowptr(r0) + (((lane & 3) ^ ((r0 >> 2) & 3)) << 3);
  const bf16* ga1 = al.rowptr(r1) + (((lane & 3) ^ ((r1 >> 2) & 3)) << 3);
  const bf16* gb0 = bl.rowptr(r0) + (((lane & 3) ^ ((r0 >> 2) & 3)) << 3);
  const bf16* gb1 = bl.rowptr(r1) + (((lane & 3) ^ ((r1 >> 2) & 3)) << 3);
  unsigned char* dst = lds + wave * 2048;
#define DMA_STAGE(buf, kt) { const int kt_ = (kt) < ktiles ? (kt) : ktiles - 1; const int ka_ = al.koff32(kt_), kb_ = bl.koff32(kt_); unsigned char* d_ = dst + (buf) * 16384; \
    __builtin_amdgcn_global_load_lds((const unsigned*)(ga0 + ka_), (unsigned*)(d_), 16, 0, 0); \
    __builtin_amdgcn_global_load_lds((const unsigned*)(ga1 + ka_), (unsigned*)(d_ + 1024), 16, 0, 0); \
    __builtin_amdgcn_global_load_lds((const unsigned*)(gb0 + kb_), (unsigned*)(d_ + 8192), 16, 0, 0); \
    __builtin_amdgcn_global_load_lds((const unsigned*)(gb1 + kb_), (unsigned*)(d_ + 8192 + 1024), 16, 0, 0); }
  const int r = lane & 31, hh = lane >> 5, sw = (r >> 2) & 3;
  const int oa0 = (wm * 64 + r) * 64 + (((0 + hh) ^ sw) << 4), oa1 = (wm * 64 + r) * 64 + (((2 + hh) ^ sw) << 4);
  const int ob0 = 8192 + (wn * 64 + r) * 64 + (((0 + hh) ^ sw) << 4), ob1 = 8192 + (wn * 64 + r) * 64 + (((2 + hh) ^ sw) << 4);
  __syncthreads();
  DMA_STAGE(0, 0); DMA_STAGE(1, 1); DMA_STAGE(2, 2);
  for (int t = 0; t < ktiles; ++t) {
    WAIT_V(8);
    RAW_BARRIER();
    const unsigned char* S = lds + (t & 3) * 16384;
    {
      const bf16x8 a0 = *(const bf16x8*)(S + oa0), a1 = *(const bf16x8*)(S + oa0 + 2048), b0 = *(const bf16x8*)(S + ob0), b1 = *(const bf16x8*)(S + ob0 + 2048);
      const bf16x8 c0 = *(const bf16x8*)(S + oa1), c1 = *(const bf16x8*)(S + oa1 + 2048), d0 = *(const bf16x8*)(S + ob1), d1 = *(const bf16x8*)(S + ob1 + 2048);
      acc[0][0] = __builtin_amdgcn_mfma_f32_32x32x16_bf16(a0, b0, acc[0][0], 0, 0, 0);
      acc[0][1] = __builtin_amdgcn_mfma_f32_32x32x16_bf16(a0, b1, acc[0][1], 0, 0, 0);
      acc[1][0] = __builtin_amdgcn_mfma_f32_32x32x16_bf16(a1, b0, acc[1][0], 0, 0, 0);
      acc[1][1] = __builtin_amdgcn_mfma_f32_32x32x16_bf16(a1, b1, acc[1][1], 0, 0, 0);
      acc[0][0] = __builtin_amdgcn_mfma_f32_32x32x16_bf16(c0, d0, acc[0][0], 0, 0, 0);
      acc[0][1] = __builtin_amdgcn_mfma_f32_32x32x16_bf16(c0, d1, acc[0][1], 0, 0, 0);
      acc[1][0] = __builtin_amdgcn_mfma_f32_32x32x16_bf16(c1, d0, acc[1][0], 0, 0, 0);
      acc[1][1] = __builtin_amdgcn_mfma_f32_32x32x16_bf16(c1, d1, acc[1][1], 0, 0, 0);
    }
    __builtin_amdgcn_sched_barrier(0);
    DMA_STAGE((t + 3) & 3, t + 3);
    __builtin_amdgcn_sched_barrier(0);
  }
  WAIT_V(0);
  RAW_BARRIER();
#undef DMA_STAGE
}

constexpr int M2_A_ELEMS = 256 * 40, M2_STAGE_ELEMS = M2_A_ELEMS + 4 * 128 * 8;
template <class AL, class BL>
DI void gemm_mainloop_256(f32x16 (&acc)[4][2], const AL& al, BL& bl, int ktiles, bf16* smem) {
  const int tid = threadIdx.x, lane = tid & 63, wave = tid >> 6, wm = wave >> 1, wn = wave & 1;
  const int arow = tid >> 2, akc = tid & 3, kg = tid >> 5, n4 = tid & 31;
  const bf16* abase = al.base;
  const unsigned ao0 = al.rowoff(arow) + akc * 8, ao1 = al.rowoff(arow + 64) + akc * 8, ao2 = al.rowoff(arow + 128) + akc * 8, ao3 = al.rowoff(arow + 192) + akc * 8;
  bl.init(n4 * 4);
  uint4 ra0, ra1, ra2, ra3; f32x4 rb[4];
#define GLOAD(kt) { const bf16* ab_ = abase + (kt) * 32; ra0 = *(const uint4*)(ab_ + ao0); ra1 = *(const uint4*)(ab_ + ao1); ra2 = *(const uint4*)(ab_ + ao2); ra3 = *(const uint4*)(ab_ + ao3); \
    _Pragma("unroll") for (int r_ = 0; r_ < 4; ++r_) rb[r_] = bl.ld32(kt, kg * 4 + r_); }
#define LSTORE(buf) { bf16* A_ = smem + (buf) * M2_STAGE_ELEMS; bf16* B_ = A_ + M2_A_ELEMS; const int o_ = arow * 40 + akc * 8; \
    *(uint4*)(A_ + o_) = ra0; *(uint4*)(A_ + o_ + 64 * 40) = ra1; *(uint4*)(A_ + o_ + 128 * 40) = ra2; *(uint4*)(A_ + o_ + 192 * 40) = ra3; \
    _Pragma("unroll") for (int c_ = 0; c_ < 4; ++c_) { uint2 v_; v_.x = pk2(rb[0][c_], rb[1][c_]); v_.y = pk2(rb[2][c_], rb[3][c_]); const int n_ = n4 * 4 + c_; \
      *(uint2*)(B_ + ((kg >> 1) * 128 + (n_ ^ ((n_ >> 3) & 3))) * 8 + (kg & 1) * 4) = v_; } }
  GLOAD(0); LSTORE(0); __syncthreads();
  const int r = lane & 31, hh = lane >> 5;
  const int aoff = (wm * 128 + r) * 40 + hh * 8;
  const int nb0 = wn * 64 + r, nb1 = nb0 + 32;
  const int boff0 = M2_A_ELEMS + (hh * 128 + (nb0 ^ ((nb0 >> 3) & 3))) * 8, boff1 = M2_A_ELEMS + (hh * 128 + (nb1 ^ ((nb1 >> 3) & 3))) * 8;
  for (int kt = 0; kt < ktiles; ++kt) {
    if (kt + 1 < ktiles) GLOAD(kt + 1);
    const bf16* S = smem + (kt & 1) * M2_STAGE_ELEMS;
#pragma unroll
    for (int ks = 0; ks < 2; ++ks) {
      const bf16x8 b0 = *(const bf16x8*)(S + boff0 + ks * 2 * 128 * 8), b1 = *(const bf16x8*)(S + boff1 + ks * 2 * 128 * 8);
#pragma unroll
      for (int mi = 0; mi < 4; ++mi) { const bf16x8 a = *(const bf16x8*)(S + aoff + mi * 32 * 40 + ks * 16);
        acc[mi][0] = __builtin_amdgcn_mfma_f32_32x32x16_bf16(a, b0, acc[mi][0], 0, 0, 0);
        acc[mi][1] = __builtin_amdgcn_mfma_f32_32x32x16_bf16(a, b1, acc[mi][1], 0, 0, 0); }
      __builtin_amdgcn_sched_barrier(0);
    }
    if (kt + 1 < ktiles) LSTORE((kt + 1) & 1);
    __syncthreads();
  }
#undef GLOAD
#undef LSTORE
}

template <class AL, class BLB>
DI void gemm_mainloop_dma_m256(f32x16 (&acc)[4][2], const AL& al, const BLB& bl, int ktiles, unsigned char* lds) {
  const int tid = threadIdx.x, lane = tid & 63, wave = __builtin_amdgcn_readfirstlane(tid >> 6), wm = wave >> 1, wn = wave & 1;
  const int ra_ = 16 * (wave * 4) + (lane >> 2), rb_ = 16 * (wave * 2) + (lane >> 2);
  const bf16* abase = al.rowptr(0); const bf16* bbase = bl.rowptr(0);
  const unsigned ao0 = (unsigned)(al.rowptr(ra_) - abase) + (((lane & 3) ^ ((ra_ >> 2) & 3)) << 3);
  const unsigned ao1 = (unsigned)(al.rowptr(ra_ + 16) - abase) + (((lane & 3) ^ (((ra_ + 16) >> 2) & 3)) << 3);
  const unsigned ao2 = (unsigned)(al.rowptr(ra_ + 32) - abase) + (((lane & 3) ^ (((ra_ + 32) >> 2) & 3)) << 3);
  const unsigned ao3 = (unsigned)(al.rowptr(ra_ + 48) - abase) + (((lane & 3) ^ (((ra_ + 48) >> 2) & 3)) << 3);
  const unsigned bo0 = (unsigned)(bl.rowptr(rb_) - bbase) + (((lane & 3) ^ ((rb_ >> 2) & 3)) << 3);
  const unsigned bo1 = (unsigned)(bl.rowptr(rb_ + 16) - bbase) + (((lane & 3) ^ (((rb_ + 16) >> 2) & 3)) << 3);
  constexpr int STG = 24576;
#define DMA_STAGE3(buf, kt) { const int kt_ = (kt) < ktiles ? (kt) : ktiles - 1; const bf16* ap_ = abase + al.koff32(kt_); const bf16* bp_ = bbase + bl.koff32(kt_); unsigned char* d_ = lds + (buf) * STG; \
    __builtin_amdgcn_global_load_lds((const unsigned*)(ap_ + ao0), (unsigned*)(d_ + wave * 4096), 16, 0, 0); \
    __builtin_amdgcn_global_load_lds((const unsigned*)(ap_ + ao1), (unsigned*)(d_ + wave * 4096 + 1024), 16, 0, 0); \
    __builtin_amdgcn_global_load_lds((const unsigned*)(ap_ + ao2), (unsigned*)(d_ + wave * 4096 + 2048), 16, 0, 0); \
    __builtin_amdgcn_global_load_lds((const unsigned*)(ap_ + ao3), (unsigned*)(d_ + wave * 4096 + 3072), 16, 0, 0); \
    __builtin_amdgcn_global_load_lds((const unsigned*)(bp_ + bo0), (unsigned*)(d_ + 16384 + wave * 2048), 16, 0, 0); \
    __builtin_amdgcn_global_load_lds((const unsigned*)(bp_ + bo1), (unsigned*)(d_ + 16384 + wave * 2048 + 1024), 16, 0, 0); }
  const int r = lane & 31, hh = lane >> 5, sw = (r >> 2) & 3;
  const int oa0 = (wm * 128 + r) * 64 + (((0 + hh) ^ sw) << 4), oa1 = (wm * 128 + r) * 64 + (((2 + hh) ^ sw) << 4);
  const int ob0 = 16384 + (wn * 64 + r) * 64 + (((0 + hh) ^ sw) << 4), ob1 = 16384 + (wn * 64 + r) * 64 + (((2 + hh) ^ sw) << 4);
  __syncthreads();
  DMA_STAGE3(0, 0); DMA_STAGE3(1, 1);
  int buf = 0;
  for (int t = 0; t < ktiles; ++t) {
    WAIT_V(6);
    RAW_BARRIER();
    const unsigned char* S = lds + buf * STG;
#pragma unroll
    for (int ks = 0; ks < 2; ++ks) {
      const int oa = ks ? oa1 : oa0, ob = ks ? ob1 : ob0;
      const bf16x8 b0 = *(const bf16x8*)(S + ob), b1 = *(const bf16x8*)(S + ob + 2048);
#pragma unroll
      for (int mi = 0; mi < 4; ++mi) { const bf16x8 a = *(const bf16x8*)(S + oa + mi * 2048);
        acc[mi][0] = __builtin_amdgcn_mfma_f32_32x32x16_bf16(a, b0, acc[mi][0], 0, 0, 0);
        acc[mi][1] = __builtin_amdgcn_mfma_f32_32x32x16_bf16(a, b1, acc[mi][1], 0, 0, 0); }
    }
    __builtin_amdgcn_sched_barrier(0);
    { const int nb = buf == 0 ? 2 : buf - 1; DMA_STAGE3(nb, t + 2); }
    __builtin_amdgcn_sched_barrier(0);
    buf = buf == 2 ? 0 : buf + 1;
  }
  WAIT_V(0);
  RAW_BARRIER();
#undef DMA_STAGE3
}
struct ALBlk2 { const bf16* base; int kblocks; DI const bf16* rowptr(int r) const { return base + (size_t)(r >> 7) * kblocks * 4096 + (r & 127) * 32; } DI int koff32(int kt) const { return kt * 4096; } };
struct BLRouterB { const bf16* base; DI const bf16* rowptr(int r) const { return base + (size_t)r * 2048; }
  DI int koff(int kt) const { return kt < 16 ? kt * 64 : (kt < 32 ? (kt - 16) * 64 : 1024 + (kt - 32) * 64); }
  DI int koff32(int kt) const { return kt < 32 ? kt * 32 : (kt < 64 ? (kt - 32) * 32 : 1024 + (kt - 64) * 32); } };
template <class CM>
DI void transpose_block(const float* __restrict__ W, int N, bf16* __restrict__ WT, int ldt, int k0, int n0, float* scr, int lane, CM colmap) {
  const int sc = colmap(n0 + (lane & 31));
#pragma unroll 8
  for (int i = 0; i < 32; ++i) { const int kk = 2 * i + (lane >> 5); const float wv = __builtin_nontemporal_load(W + (size_t)(k0 + kk) * N + (sc >= 0 ? sc : 0)); scr[kk * 33 + (lane & 31)] = sc >= 0 ? wv : 0.f; }
  __builtin_amdgcn_wave_barrier();
  const int c = lane & 7;
#pragma unroll
  for (int j = 0; j < 4; ++j) { const int n = (lane >> 3) + 8 * j; const float* s = scr + (8 * c) * 33 + n;
    uint4 o; o.x = pk2(s[0 * 33], s[1 * 33]); o.y = pk2(s[2 * 33], s[3 * 33]); o.z = pk2(s[4 * 33], s[5 * 33]); o.w = pk2(s[6 * 33], s[7 * 33]);
    if (ldt < 0) *(uint4*)(WT + blk_off(n0 + n, k0 + 8 * c, -ldt)) = o; else *(uint4*)(WT + (size_t)(n0 + n) * ldt + k0 + 8 * c) = o; }
  __builtin_amdgcn_wave_barrier();
}
DI void acc_zero(f32x16 (&acc)[2][2]) {
#pragma unroll
  for (int i = 0; i < 2; ++i)
#pragma unroll
    for (int j = 0; j < 2; ++j)
#pragma unroll
      for (int r = 0; r < 16; ++r) acc[i][j][r] = 0.f;
}
DI int crow(int r, int lane) { return 8 * (r >> 2) + 4 * (lane >> 5) + (r & 3); }


DI void st16_bf16(bf16* base, int ld, const float (&v)[16]) {
#pragma unroll
  for (int q = 0; q < 4; ++q) { bf16* pq = base + (size_t)(8 * q) * ld; asm volatile("" : "+v"(pq));
#pragma unroll
    for (int i = 0; i < 4; ++i) pq[(size_t)i * ld] = f2bf(v[4 * q + i]); }
}
DI void st16_f32(float* base, int ld, const float (&v)[16]) {
#pragma unroll
  for (int q = 0; q < 4; ++q) { float* pq = base + (size_t)(8 * q) * ld; asm volatile("" : "+v"(pq));
#pragma unroll
    for (int i = 0; i < 4; ++i) pq[(size_t)i * ld] = v[4 * q + i]; }
}

struct ALBlk { const bf16* base; DI const bf16* rowptr(int r) const { return base + r * 32; } DI int koff32(int kt) const { return kt * 4096; } };

constexpr int ST_LD = 132;
DI void stage_block(float* st, int ldst, int mi, int ni, const float (&v)[16]) {
  const int lane = threadIdx.x & 63, wave = threadIdx.x >> 6, wm = wave >> 1, wn = wave & 1;
  float* b = st + (wm * 64 + mi * 32 + 4 * (lane >> 5)) * ldst + wn * 64 + ni * 32 + (lane & 31);
#pragma unroll
  for (int r = 0; r < 16; ++r) b[(8 * (r >> 2) + (r & 3)) * ldst] = v[r];
}
DI void stage_acc(float* st, f32x16 (&acc)[2][2]) {
#pragma unroll
  for (int mi = 0; mi < 2; ++mi)
#pragma unroll
    for (int ni = 0; ni < 2; ++ni) { float v[16];
#pragma unroll
      for (int r = 0; r < 16; ++r) v[r] = acc[mi][ni][r];
      stage_block(st, ST_LD, mi, ni, v); }
}
DI uint4 pack8(const float* s) { const f32x4 a = *(const f32x4*)s, b = *(const f32x4*)(s + 4); uint4 o; o.x = pk2(a[0], a[1]); o.y = pk2(a[2], a[3]); o.z = pk2(b[0], b[1]); o.w = pk2(b[2], b[3]); return o; }
struct ALPlain { const bf16* base; int ld; DI const bf16* rowptr(int r) const { return base + (size_t)r * ld; } DI int koff(int kt) const { return kt * 64; } DI int koff32(int kt) const { return kt * 32; } };
struct ALGather256 { const bf16* base; const int* list; int nvalid; DI unsigned rowoff(int r) const { int rr = r < nvalid ? r : nvalid - 1; return (unsigned)(list[rr] >> 3) * 1024u; } };
struct ALRows { const bf16* base; int ld; DI unsigned rowoff(int r) const { return (unsigned)(r * ld); } };
struct ALGather { const bf16* H; const int* list; int nvalid; DI const bf16* rowptr(int r) const { int rr = r < nvalid ? r : nvalid - 1; return H + (size_t)(list[rr] >> 3) * 1024; } DI int koff(int kt) const { return kt * 64; } };
struct ALRouter { const bf16* base; DI const bf16* rowptr(int r) const { return base + (size_t)r * 1024; }
  DI int koff(int kt) const { return kt < 16 ? kt * 64 : (kt < 32 ? (int)((O_HLO - O_HHI) / 2) + (kt - 16) * 64 : (kt - 32) * 64); }
  DI int koff32(int kt) const { return kt < 32 ? kt * 32 : (kt < 64 ? (int)((O_HLO - O_HHI) / 2) + (kt - 32) * 32 : (kt - 64) * 32); } };

template <int LDB> struct BLPlain { const float* W; int n0, nmax; const float* pt; bool ok;
  DI void init(int ncol) { int n = n0 + ncol; ok = n < nmax; pt = W + (ok ? n : 0); }
  DI f32x4 ld(int kt, int krow) const { f32x4 z = {0.f, 0.f, 0.f, 0.f}; return ok ? *(const f32x4*)(pt + (size_t)(kt * 64 + krow) * LDB) : z; }
  DI f32x4 ld32(int kt, int krow) const { return *(const f32x4*)(pt + (size_t)(kt * 32 + krow) * LDB); } };
DI int srccol(int n) { return n < 1064 ? n : (n < 1088 ? n + 1280 : (n < 2368 ? n - 24 : n)); }
struct BLInproj { const float* W; int n0; const float* pt; bool ok;
  DI void init(int ncol) { int n = n0 + ncol; ok = n < NIN; pt = W + (ok ? srccol(n) : 0); }
  DI f32x4 ld(int kt, int krow) const { f32x4 z = {0.f, 0.f, 0.f, 0.f}; return ok ? *(const f32x4*)(pt + (size_t)(kt * 64 + krow) * NIN) : z; } };
struct BLGateUp { const float* Wg; long du; int hc0; const float* pt;
  DI void init(int ncol) { int wn = ncol >> 6, ni = (ncol >> 5) & 1, c = ncol & 31; pt = Wg + (long)ni * du + hc0 + wn * 32 + c; }
  DI f32x4 ld(int kt, int krow) const { return *(const f32x4*)(pt + (size_t)(kt * 64 + krow) * 256); }
  DI f32x4 ld32(int kt, int krow) const { return *(const f32x4*)(pt + (size_t)(kt * 32 + krow) * 256); } };
struct BLRouter { const float* W; int n0; const float* pt;
  DI void init(int ncol) { pt = W + n0 + ncol; }
  DI f32x4 ld(int kt, int krow) const { f32x4 w = *(const f32x4*)(pt + (size_t)((kt & 15) * 64 + krow) * 256);
    if (kt >= 32) { w[0] -= bf2f(f2bf(w[0])); w[1] -= bf2f(f2bf(w[1])); w[2] -= bf2f(f2bf(w[2])); w[3] -= bf2f(f2bf(w[3])); } return w; } };

DI float inv_freq(int i) {
  switch (i) {
    case 0: return 1.0f; case 1: return 0.1939227432012558f; case 2: return 0.03760603070259094f; case 3: return 0.007292664609849453f;
    case 4: return 0.0014142135623842478f; case 5: return 0.00027424818836152554f; case 6: return 5.3182957344688475e-05f; case 7: return 1.0313385246263351e-05f;
    case 8: return 1.0f; case 9: return 0.03760603070259094f; case 10: return 0.0014142135623842478f; default: return 5.3182957344688475e-05f;
  }
}

DI void conv_wave_item(PR p, int w, float* scr, int lane) {
  unsigned char* ws = p.ws;
  if (w < 2240) { const int nb = w % 140, kb = w / 140;
    transpose_block(p.w_in, NIN, (bf16*)(ws + O_WT_IN), -1024, kb * 64, nb * 32, scr, lane, [](int n) { return n < NIN ? srccol(n) : -1; }); return; }
  w -= 2240;
  if (w < 512) { const int which = w >> 8, q = w & 255, nb = q & 31, kb = q >> 5;
    transpose_block(which ? p.w_br_b : p.w_br_a, 1024, (bf16*)(ws + (which ? O_WT_BRB : O_WT_BRA)), 512, kb * 64, nb * 32, scr, lane, [](int n) { return n; }); return; }
  w -= 512;
  if (w < 512) { const int nb = w & 31, kb = w >> 5;
    transpose_block(p.w_out, 1024, (bf16*)(ws + O_WT_OUT), 1024, kb * 64, nb * 32, scr, lane, [](int n) { return n; }); return; }
  w -= 512;
  if (w < 256) {
    const int lo = w >> 7, q = w & 127, nb = q & 7, kb = q >> 3, k0 = kb * 64, n0 = nb * 32;
#pragma unroll 8
    for (int i = 0; i < 32; ++i) { const int kk = 2 * i + (lane >> 5); float v = p.w_router[(size_t)(k0 + kk) * 256 + n0 + (lane & 31)]; if (lo) v -= bf2f(f2bf(v)); scr[kk * 33 + (lane & 31)] = v; }
    __builtin_amdgcn_wave_barrier();
    const int c = lane & 7; bf16* WT = (bf16*)(ws + O_WT_RT) + lo * 1024;
#pragma unroll
    for (int j = 0; j < 4; ++j) { const int n = (lane >> 3) + 8 * j; const float* s = scr + (8 * c) * 33 + n;
      uint4 o; o.x = pk2(s[0 * 33], s[1 * 33]); o.y = pk2(s[2 * 33], s[3 * 33]); o.z = pk2(s[4 * 33], s[5 * 33]); o.w = pk2(s[6 * 33], s[7 * 33]);
      *(uint4*)(WT + (size_t)(n0 + n) * 2048 + k0 + 8 * c) = o; }
    __builtin_amdgcn_wave_barrier();
    return; }
  w -= 256;
  if (w < 256) {
    const int nb = w & 15, kb = w >> 4, nt = nb >> 2, wn = (nb >> 1) & 1, ni = nb & 1, sc0 = nt * 64 + wn * 32 - nb * 32;
    transpose_block(ni ? p.w_sh_up : p.w_sh_gate, 256, (bf16*)(ws + O_WT_SGU), 1024, kb * 64, nb * 32, scr, lane, [sc0](int n) { return n + sc0; }); return; }
  w -= 256;
  if (w < 128) { const int nb = w & 31, kb = w >> 5;
    transpose_block(p.w_sh_down, 1024, (bf16*)(ws + O_WT_SD), 256, kb * 64, nb * 32, scr, lane, [](int n) { return n; }); return; }
  w -= 128;
  if (w < 512) { const int which = w >> 8, q = w & 255, nb = q & 7, kb = q >> 3;
    transpose_block(which ? p.cmp_v_w1 : p.cmp_k_w1, 256, (bf16*)(ws + (which ? O_WT_C1V : O_WT_C1K)), 2048, kb * 64, nb * 32, scr, lane, [](int n) { return n; }); return; }
  w -= 512;
  if (w < 32) { const int which = w >> 4, q = w & 15, nb = q & 3, kb = q >> 2;
    transpose_block(which ? p.cmp_v_w2 : p.cmp_k_w2, 64, (bf16*)(ws + (which ? O_WT_C2V : O_WT_C2K)), 256, kb * 64, nb * 32, scr, lane, [](int n) { return n < 64 ? n : -1; }); return; }
}
constexpr int N_CONV_WAVE = 2240 + 512 + 512 + 256 + 256 + 128 + 512 + 32;
DI void ph_prologue(PR p, unsigned char* smem, int* qctr, int* shv) {
  float* sc = (float*)smem;
  constexpr int N_MOD = 96, N_TAB = T * 12 / 256, N_CB = 64, N_CV = N_CONV_WAVE / 4;
  const int G = gridDim.x; constexpr int NR = N_TAB + N_CB + N_CV; const bool split = G >= 2 * N_MOD;
  for (int s = 0;; ++s) {
    int it;
    if (split) { if ((int)blockIdx.x < N_MOD) { if (s) break; it = blockIdx.x; } else { const int r = ((int)blockIdx.x - N_MOD) + s * (G - N_MOD); if (r >= NR) break; it = N_MOD + r; } }
    else { it = blockIdx.x + s * G; if (it >= N_MOD + NR) break; }
    __syncthreads();
    if (it < N_MOD) {
      { f32x4 cv[16];
#pragma unroll
        for (int u = 0; u < 16; ++u) cv[u] = *(const f32x4*)(p.c + (threadIdx.x + 256 * u) * 4);
#pragma unroll
        for (int u = 0; u < 16; ++u) { f32x4 s; s[0] = siluf_(cv[u][0]); s[1] = siluf_(cv[u][1]); s[2] = siluf_(cv[u][2]); s[3] = siluf_(cv[u][3]); *(f32x4*)(sc + (threadIdx.x + 256 * u) * 4) = s; } }
      __syncthreads();
      const int kq = threadIdx.x >> 6, cidx = threadIdx.x & 63, j = it * 64 + cidx;
      float a[16];
#pragma unroll
      for (int b = 0; b < 16; ++b) a[b] = 0.f;
      const float* wp = p.w_ada + (size_t)(kq * 256) * 6144 + j;
      float wb[16];
#pragma unroll
      for (int u = 0; u < 16; ++u) wb[u] = __builtin_nontemporal_load(wp + (size_t)u * 6144);
      for (int k0 = 0; k0 < 256; k0 += 16) {
        float wn[16];
#pragma unroll
        for (int u = 0; u < 16; ++u) wn[u] = (k0 + 16 < 256) ? __builtin_nontemporal_load(wp + (size_t)(k0 + 16 + u) * 6144) : 0.f;
#pragma unroll
        for (int u = 0; u < 16; ++u) {
#pragma unroll
          for (int b = 0; b < 16; ++b) a[b] += sc[b * 1024 + kq * 256 + k0 + u] * wb[u]; }
#pragma unroll
        for (int u = 0; u < 16; ++u) wb[u] = wn[u];
      }
      __syncthreads();
      float* part = sc;
#pragma unroll
      for (int b = 0; b < 16; ++b) part[(kq * 16 + b) * 64 + cidx] = a[b];
      __syncthreads();
      for (int o = threadIdx.x; o < 1024; o += 256) { const int b = o >> 6, cc = o & 63, jj = it * 64 + cc;
        const float s = ((part[(0 * 16 + b) * 64 + cc] + part[(1 * 16 + b) * 64 + cc]) + (part[(2 * 16 + b) * 64 + cc] + part[(3 * 16 + b) * 64 + cc]));
        ((float*)(p.ws + O_MOD))[b * 6144 + jj] = s + p.b_ada[jj]; }
    } else if (it < N_MOD + N_TAB) {
      const int idx = (it - N_MOD) * 256 + threadIdx.x; const int tok = idx / 12, i = idx % 12;
      const float ang = (float)p.pos[tok] * inv_freq(i);
      double rev = (double)ang * 0.15915494309189535; rev -= rint(rev);
      const float a = (float)(rev * 6.283185307179586);
      const float sn = sinf(a), cs = cosf(a);
      if (i < 8) { float* r = (float*)(p.ws + O_ROPEH) + (size_t)tok * 16; r[i] = cs; r[8 + i] = sn; }
      else { float* r = (float*)(p.ws + O_ROPEI) + (size_t)tok * 8; r[i - 8] = cs; r[4 + i - 8] = sn; }
    } else if (it >= N_MOD + N_TAB + N_CB) {
      conv_wave_item(p, (it - N_MOD - N_TAB - N_CB) * 4 + (threadIdx.x >> 6), (float*)smem + (threadIdx.x >> 6) * (64 * 33), threadIdx.x & 63);
    } else {
      const int q = it - N_MOD - N_TAB, which = q >> 5, kc = q & 31, j = threadIdx.x;
      const float* pos = which ? p.cmp_pos_v : p.cmp_pos_k; const float* w1 = which ? p.cmp_v_w1 : p.cmp_k_w1;
      float acc = 0.f;
      for (int k = kc * 64; k < kc * 64 + 64; ++k) acc += pos[k] * w1[(size_t)k * 256 + j];
      ((float*)(p.ws + O_CMPB))[(which * 32 + kc) * 256 + j] = acc;
    }
  }
}
DI void ph_u(PR p) {
  const float* modb = (const float*)(p.ws + O_MOD); bf16* U = (bf16*)(p.ws + O_U);
  const size_t nthr = (size_t)gridDim.x * 256;
  for (size_t i4 = (size_t)blockIdx.x * 256 + threadIdx.x; i4 < (size_t)T * 256; i4 += 4 * nthr) {
    float4 xv[4];
#pragma unroll
    for (int u = 0; u < 4; ++u) { const f32x4 t_ = __builtin_nontemporal_load((const f32x4*)(p.x + (i4 + u * nthr) * 4)); xv[u].x = t_[0]; xv[u].y = t_[1]; xv[u].z = t_[2]; xv[u].w = t_[3]; }
#pragma unroll
    for (int u = 0; u < 4; ++u) {
      const size_t e = (i4 + u * nthr) * 4; const int tok = (int)(e >> 10), col = (int)(e & 1023), b = tok >> 11;
      const float* mod = modb + b * 6144;
      const float4 sh = *(const float4*)(mod + col), sc = *(const float4*)(mod + 1024 + col);
      uint2 o; o.x = pk2(xv[u].x * (1.f + sc.x) + sh.x, xv[u].y * (1.f + sc.y) + sh.y); o.y = pk2(xv[u].z * (1.f + sc.z) + sh.z, xv[u].w * (1.f + sc.w) + sh.w);
      *(uint2*)(U + blk_off(tok, col, 1024)) = o;
    }
  }
}
DI bool is_rope_head_seg(int n) { return n < 640 || (n >= 1088 && n < 1600) || (n >= 1856 && n < 1984) || (n >= 2112 && n < 2240); }
DI float rope_h(const float* ropeH, int tok, int d, float v, float vp) { int i = d & 7; float cs = ropeH[(size_t)tok * 16 + i], sn = ropeH[(size_t)tok * 16 + 8 + i]; return (d < 8) ? v * cs - vp * sn : v * cs + vp * sn; }
DI float rope_i(const float* ropeI, int tok, int d, float v, float vp) { int i = d & 3; float cs = ropeI[(size_t)tok * 8 + i], sn = ropeI[(size_t)tok * 8 + 4 + i]; return (d < 4) ? v * cs - vp * sn : v * cs + vp * sn; }

DI bf16* inproj_dst(unsigned char* ws, int tok, int n, bool raw) {
  if (n < 512) return (bf16*)(ws + O_QA) + (size_t)tok * 512 + n;
  if (n < 640) return (bf16*)(ws + O_KA) + (size_t)tok * 128 + n - 512;
  if (n < 1024) return (bf16*)(ws + O_QI) + (size_t)tok * 256 + n - 768;
  if (n < 1056) return (bf16*)(ws + O_KI) + (size_t)tok * 32 + n - 1024;
  if (n < 1600) return (bf16*)(ws + (raw ? O_QBR : O_QBT)) + (size_t)tok * 512 + n - 1088;
  if (n < 1856) { const int cc = (n - 1600) & 127; return (bf16*)(ws + (n < 1728 ? O_KC : O_VC)) + ((size_t)((tok >> 11) * 2 + (cc >> 6)) * 2048 + (tok & 2047)) * 64 + (cc & 63); }
  if (n < 1984) return (bf16*)(ws + O_KS) + (size_t)tok * 128 + n - 1856;
  if (n < 2240) return (bf16*)(ws + O_KW) + (size_t)tok * 128 + n - 2112;
  if (n < 3392) return (bf16*)(ws + O_SGA) + (size_t)tok * 1024 + n - 2368;
  return (bf16*)(ws + O_SGB) + (size_t)tok * 1024 + n - 3392;
}
DI void inproj_copyout(unsigned char* ws, const float* st, int m0, int n0, bool raw_pass) {
  const int bidx = m0 >> 11;
#pragma unroll 1
  for (int sub = 0; sub < 4; ++sub) {
    const int nsub = n0 + sub * 32;
    if (nsub >= NIN) break;
    if (nsub == 1056) continue;
    if (raw_pass && !(nsub >= 1088 && nsub < 1600)) continue;
    const int tseg = (nsub >= 640 && nsub < 768) ? 0 : ((nsub >= 1984 && nsub < 2112) ? 1 : ((nsub >= 2240 && nsub < 2368) ? 2 : -1));
#pragma unroll
    for (int j = 0; j < 2; ++j) { const int u = threadIdx.x + 256 * j;
      if (tseg < 0) { const int row = u >> 2, cg = u & 3;
        *(uint4*)inproj_dst(ws, m0 + row, nsub + cg * 8, raw_pass) = pack8(st + row * ST_LD + sub * 32 + cg * 8);
      } else {
        const int d = u & 31, rg = u >> 5; const float* s = st + (rg * 8) * ST_LD + sub * 32 + d;
        uint4 o; o.x = pk2(s[0], s[ST_LD]); o.y = pk2(s[2 * ST_LD], s[3 * ST_LD]); o.z = pk2(s[4 * ST_LD], s[5 * ST_LD]); o.w = pk2(s[6 * ST_LD], s[7 * ST_LD]);
        const int cc = nsub - (tseg == 0 ? 640 : (tseg == 1 ? 1984 : 2240)) + d;
        bf16* dst = (bf16*)(ws + (tseg == 0 ? O_VAT : (tseg == 1 ? O_VST : O_VWT))) + ((size_t)(bidx * 2 + (cc >> 6)) * 64 + (cc & 63)) * 2048 + (m0 & 2047) + rg * 8;
        *(uint4*)dst = o; }
    }
  }
}
DI void inproj_epilogue(PR p, f32x16 (&acc)[2][2], int m0, int n0, float* st) {
  unsigned char* ws = p.ws;
  const int lane = threadIdx.x & 63, wave = threadIdx.x >> 6, wm = wave >> 1, wn = wave & 1, c = lane & 31, h4 = 4 * (lane >> 5);
  const float* ropeH = (const float*)(ws + O_ROPEH); const float* ropeI = (const float*)(ws + O_ROPEI);
#pragma unroll
  for (int ni = 0; ni < 2; ++ni) {
    const int nsub = n0 + wn * 64 + ni * 32;
    if (nsub >= NIN) continue;
    const bool hrope = is_rope_head_seg(nsub) && ((nsub & 63) == 0);
    const bool irope = nsub >= 768 && nsub < 1056;
#pragma unroll
    for (int mi = 0; mi < 2; ++mi) {
      const int tok0 = m0 + wm * 64 + mi * 32 + h4;
      float v[16], vr[16];
#pragma unroll
      for (int r = 0; r < 16; ++r) { v[r] = acc[mi][ni][r]; vr[r] = v[r]; }
      if (hrope) {
        const float* rp = ropeH + (size_t)tok0 * 16 + (c & 7); asm volatile("" : "+v"(rp));
#pragma unroll
        for (int r = 0; r < 16; ++r) { const float vp = __shfl_xor(v[r], 8); const int ro = (8 * (r >> 2) + (r & 3)) * 16;
          const float cs = rp[ro], sn = rp[ro + 8]; const float vrot = (c < 8) ? v[r] * cs - vp * sn : v[r] * cs + vp * sn; vr[r] = (c < 16) ? vrot : v[r]; }
      } else if (irope) {
        const float* rp = ropeI + (size_t)tok0 * 8 + (c & 3); asm volatile("" : "+v"(rp));
#pragma unroll
        for (int r = 0; r < 16; ++r) { const float vp = __shfl_xor(v[r], 4); const int ro = (8 * (r >> 2) + (r & 3)) * 8;
          const float cs = rp[ro], sn = rp[ro + 4]; const float vrot = (c < 4) ? v[r] * cs - vp * sn : v[r] * cs + vp * sn; vr[r] = (c < 8) ? vrot : v[r]; }
      }
      if (nsub == 1056) {
        if (c < 8) {
#pragma unroll
          for (int r = 0; r < 16; ++r) vr[r] = v[r] * 0.0625f;
          st16_f32((float*)(ws + O_WI) + (size_t)tok0 * 8 + c, 8, vr);
        } else {
#pragma unroll
          for (int r = 0; r < 16; ++r) vr[r] = sigmoidf_(v[r]);
          st16_f32((float*)(ws + O_GN) + (size_t)tok0 * 24 + c - 8, 24, vr);
        }
      } else {
        if (nsub >= 2368) {
#pragma unroll
          for (int r = 0; r < 16; ++r) vr[r] = sigmoidf_(v[r]);
        }
        stage_block(st, ST_LD, mi, ni, vr);
      }
    }
  }
  __syncthreads();
  inproj_copyout(ws, st, m0, n0, false);
  if (n0 + 128 > 1088 && n0 < 1600) {
    __syncthreads();
#pragma unroll
    for (int ni = 0; ni < 2; ++ni) { const int nsub = n0 + wn * 64 + ni * 32;
      if (nsub >= 1088 && nsub < 1600) {
#pragma unroll
        for (int mi = 0; mi < 2; ++mi) { float v[16];
#pragma unroll
          for (int r = 0; r < 16; ++r) v[r] = acc[mi][ni][r];
          stage_block(st, ST_LD, mi, ni, v); } } }
    __syncthreads();
    inproj_copyout(ws, st, m0, n0, true);
  }
}
DI void inproj_copyout2(unsigned char* ws, const float* st, int m0, int n0) {
  const int bidx = m0 >> 11;
  const float* ropeH = (const float*)(ws + O_ROPEH); const float* ropeI = (const float*)(ws + O_ROPEI);
#pragma unroll 1
  for (int sub = 0; sub < 4; ++sub) {
    const int nsub = n0 + sub * 32;
    if (nsub >= NIN) break;
    if (nsub == 1056) {
#pragma unroll
      for (int j = 0; j < 2; ++j) { const int u = threadIdx.x + 256 * j, row = u >> 2, cg = u & 3, tok = m0 + row;
        const float* s = st + row * ST_LD + sub * 32 + cg * 8; f32x4 va = *(const f32x4*)s, vb = *(const f32x4*)(s + 4);
        if (cg == 0) { va *= 0.0625f; vb *= 0.0625f; float* d = (float*)(ws + O_WI) + (size_t)tok * 8; *(f32x4*)d = va; *(f32x4*)(d + 4) = vb; }
        else { float* d = (float*)(ws + O_GN) + (size_t)tok * 24 + (cg - 1) * 8;
          f32x4 ga, gb; ga[0] = sigmoidf_(va[0]); ga[1] = sigmoidf_(va[1]); ga[2] = sigmoidf_(va[2]); ga[3] = sigmoidf_(va[3]); gb[0] = sigmoidf_(vb[0]); gb[1] = sigmoidf_(vb[1]); gb[2] = sigmoidf_(vb[2]); gb[3] = sigmoidf_(vb[3]);
          *(f32x4*)d = ga; *(f32x4*)(d + 4) = gb; } }
      continue;
    }
    const int tseg = (nsub >= 640 && nsub < 768) ? 0 : ((nsub >= 1984 && nsub < 2112) ? 1 : ((nsub >= 2240 && nsub < 2368) ? 2 : -1));
    const bool hrope = is_rope_head_seg(nsub) && ((nsub & 63) == 0), irope = nsub >= 768 && nsub < 1056, qb = nsub >= 1088 && nsub < 1600;
#pragma unroll
    for (int j = 0; j < 2; ++j) { const int u = threadIdx.x + 256 * j;
      if (tseg < 0) { const int row = u >> 2, cg = u & 3, tok = m0 + row;
        const float* s = st + row * ST_LD + sub * 32 + cg * 8;
        const f32x4 va = *(const f32x4*)s, vb = *(const f32x4*)(s + 4);
        float o[8] = {va[0], va[1], va[2], va[3], vb[0], vb[1], vb[2], vb[3]};
        if (nsub >= 2368) {
#pragma unroll
          for (int e = 0; e < 8; ++e) o[e] = __builtin_amdgcn_rcpf(1.f + __expf(-o[e])); }
        if (qb) { uint4 ro; ro.x = pk2(o[0], o[1]); ro.y = pk2(o[2], o[3]); ro.z = pk2(o[4], o[5]); ro.w = pk2(o[6], o[7]); *(uint4*)inproj_dst(ws, tok, nsub + cg * 8, true) = ro; }
        if (hrope && cg < 2) {
          const float* ps = st + row * ST_LD + sub * 32 + (cg ^ 1) * 8; const f32x4 pa = *(const f32x4*)ps, pb = *(const f32x4*)(ps + 4);
          const float* rp = ropeH + (size_t)tok * 16; const f32x4 ca = *(const f32x4*)rp, cb = *(const f32x4*)(rp + 4), sa = *(const f32x4*)(rp + 8), sb = *(const f32x4*)(rp + 12);
          const float sg = cg == 0 ? -1.f : 1.f;
#pragma unroll
          for (int e = 0; e < 4; ++e) { o[e] = o[e] * ca[e] + sg * pa[e] * sa[e]; o[4 + e] = o[4 + e] * cb[e] + sg * pb[e] * sb[e]; }
        } else if (irope && cg == 0) {
          const float* rp = ropeI + (size_t)tok * 8; const f32x4 cs = *(const f32x4*)rp, sn = *(const f32x4*)(rp + 4);
#pragma unroll
          for (int e = 0; e < 4; ++e) { const float x1 = o[e], x2 = o[4 + e]; o[e] = x1 * cs[e] - x2 * sn[e]; o[4 + e] = x2 * cs[e] + x1 * sn[e]; }
        }
        uint4 r; r.x = pk2(o[0], o[1]); r.y = pk2(o[2], o[3]); r.z = pk2(o[4], o[5]); r.w = pk2(o[6], o[7]);
        if (nsub >= 2368) { typedef unsigned u32x4_t __attribute__((ext_vector_type(4))); u32x4_t rv = {r.x, r.y, r.z, r.w}; __builtin_nontemporal_store(rv, (u32x4_t*)inproj_dst(ws, tok, nsub + cg * 8, false)); }
        else *(uint4*)inproj_dst(ws, tok, nsub + cg * 8, false) = r;
      } else {
        const int d = u & 31, rg = u >> 5; const float* s = st + (rg * 8) * ST_LD + sub * 32 + d;
        uint4 o; o.x = pk2(s[0], s[ST_LD]); o.y = pk2(s[2 * ST_LD], s[3 * ST_LD]); o.z = pk2(s[4 * ST_LD], s[5 * ST_LD]); o.w = pk2(s[6 * ST_LD], s[7 * ST_LD]);
        const int cc = nsub - (tseg == 0 ? 640 : (tseg == 1 ? 1984 : 2240)) + d;
        bf16* dst = (bf16*)(ws + (tseg == 0 ? O_VAT : (tseg == 1 ? O_VST : O_VWT))) + ((size_t)(bidx * 2 + (cc >> 6)) * 64 + (cc & 63)) * 2048 + (m0 & 2047) + rg * 8;
        *(uint4*)dst = o; }
    }
  }
}
DI void inproj_epilogue_m256(PR p, f32x16 (&acc)[4][2], int m0, int n0, float* st) {
  unsigned char* ws = p.ws;
  const int lane = threadIdx.x & 63, wave = threadIdx.x >> 6, wm = wave >> 1, wn = wave & 1, c = lane & 31, h4 = 4 * (lane >> 5);
#pragma unroll 1
  for (int h = 0; h < 2; ++h) {
    if (wm == h) {
#pragma unroll
      for (int ni = 0; ni < 2; ++ni) {
        const int nsub = n0 + wn * 64 + ni * 32;
        if (nsub >= NIN) continue;
#pragma unroll
        for (int mi = 0; mi < 4; ++mi) { float* bq = st + (mi * 32 + h4) * ST_LD + wn * 64 + ni * 32 + c;
#pragma unroll
          for (int r = 0; r < 16; ++r) bq[(8 * (r >> 2) + (r & 3)) * ST_LD] = acc[mi][ni][r]; }
      }
    }
    __syncthreads();
    inproj_copyout2(ws, st, m0 + h * 128, n0);
    __syncthreads();
  }
}
DI void ph_inproj(PR p, bf16* smem, int* ctrs, int* shv) {
  const int myx = xcc_id(); int off = 0, x, idx;
  while (shard_next(ctrs, myx, off, [](int) { return 560; }, shv, x, idx)) {
    const int g = idx / 280, rem = idx % 280, nt = rem >> 3, mt = x * 16 + g * 8 + (rem & 7), m0 = mt * 256, n0 = nt * 128;
    f32x16 acc[4][2];
#pragma unroll
    for (int mi = 0; mi < 4; ++mi)
#pragma unroll
      for (int r = 0; r < 16; ++r) { acc[mi][0][r] = 0.f; acc[mi][1][r] = 0.f; }
    ALBlk2 al{(const bf16*)(p.ws + O_U) + (size_t)m0 * 1024, 32};
    ALBlk bl{(const bf16*)(p.ws + O_WT_IN) + (size_t)n0 * 1024};
    gemm_mainloop_dma_m256(acc, al, bl, 32, (unsigned char*)smem);
    inproj_epilogue_m256(p, acc, m0, n0, (float*)smem);
  }
}

DI void idx_scores_item(PR p, int it, float* qs  ) {
  const int tok = it >> 3, kb = it & 7, t = tok & 2047, b = tok >> 11, s = kb * 256 + threadIdx.x;
  if (kb * 256 > t) return;
  qs[threadIdx.x] = bf2f(((const bf16*)(p.ws + O_QI))[(size_t)tok * 256 + threadIdx.x]);
  if (threadIdx.x < 8) qs[256 + threadIdx.x] = ((const float*)(p.ws + O_WI))[(size_t)tok * 8 + threadIdx.x];
  __syncthreads();
  if (s <= t) {
    const bf16* kr = (const bf16*)(p.ws + O_KI) + (size_t)(b * 2048 + s) * 32;
    float kf[32];
#pragma unroll
    for (int d8 = 0; d8 < 4; ++d8) { const uint4 u = *(const uint4*)(kr + d8 * 8);
      kf[d8 * 8 + 0] = __uint_as_float(u.x << 16); kf[d8 * 8 + 1] = __uint_as_float(u.x & 0xffff0000u); kf[d8 * 8 + 2] = __uint_as_float(u.y << 16); kf[d8 * 8 + 3] = __uint_as_float(u.y & 0xffff0000u);
      kf[d8 * 8 + 4] = __uint_as_float(u.z << 16); kf[d8 * 8 + 5] = __uint_as_float(u.z & 0xffff0000u); kf[d8 * 8 + 6] = __uint_as_float(u.w << 16); kf[d8 * 8 + 7] = __uint_as_float(u.w & 0xffff0000u); }
    float sc = 0.f;
#pragma unroll
    for (int h = 0; h < 8; ++h) { float dt = 0.f;
#pragma unroll
      for (int d = 0; d < 32; ++d) dt += qs[h * 32 + d] * kf[d];
      sc += qs[256 + h] * fmaxf(dt, 0.f); }
    ((float*)(p.ws + O_SC))[(size_t)tok * 2048 + s] = sc;
  }
  __syncthreads();
}

DI unsigned fkey(float f) { f += 0.f; unsigned u = __float_as_uint(f); return (u & 0x80000000u) ? ~u : (u | 0x80000000u); }
DI void select_row(const float* __restrict__ sc, int t, unsigned long long* __restrict__ mrow, unsigned* hist, int lane) {
  if (t < 256) {
    if (lane < 32) { int lo = lane * 64; unsigned long long w = (t >= lo + 63) ? ~0ull : (t < lo ? 0ull : ((2ull << (t - lo)) - 1ull)); mrow[lane] = w; }
    return;
  }
  unsigned key[32];
#pragma unroll
  for (int i = 0; i < 32; ++i) key[i] = __float_as_uint(sc[i * 64 + lane]);
#pragma unroll
  for (int i = 0; i < 32; ++i) { const int s = i * 64 + lane; const unsigned k = fkey(__uint_as_float(key[i])); key[i] = (s <= t) ? k : 0u; }
  unsigned prefix = 0; int krem = 256, cbin = 0;
#pragma unroll
  for (int pass = 0; pass < 4; ++pass) {
    const int shift = 24 - 8 * pass;
    const unsigned mhi = pass == 0 ? 0u : (0xFFFFFFFFu << (shift + 8));
#pragma unroll
    for (int z = 0; z < 16; ++z) hist[lane + 64 * z] = 0;
    __builtin_amdgcn_wave_barrier();
#pragma unroll
    for (int i = 0; i < 32; ++i) { unsigned k = key[i]; if (k != 0u && ((k ^ prefix) & mhi) == 0u) atomicAdd(&hist[(lane & 3) * 256 + ((k >> shift) & 255u)], 1u); }
    __builtin_amdgcn_wave_barrier();
    int c0 = 0, c1 = 0, c2 = 0, c3 = 0;
#pragma unroll
    for (int z = 0; z < 4; ++z) { const uint4 hv = *(const uint4*)(hist + z * 256 + 4 * lane); c0 += hv.x; c1 += hv.y; c2 += hv.z; c3 += hv.w; }
    __builtin_amdgcn_wave_barrier();
    const int tot = c0 + c1 + c2 + c3; int suf = tot;
#pragma unroll
    for (int o = 1; o < 64; o <<= 1) { int v = __shfl_down(suf, o); if (lane + o < 64) suf += v; }
    const int a3 = suf - tot, a2 = a3 + c3, a1 = a2 + c2, a0 = a1 + c1;
    int fj = -1, fa = 0, fc = 0;
    if (a3 < krem && krem <= a3 + c3) { fj = 3; fa = a3; fc = c3; }
    else if (a2 < krem && krem <= a2 + c2) { fj = 2; fa = a2; fc = c2; }
    else if (a1 < krem && krem <= a1 + c1) { fj = 1; fa = a1; fc = c1; }
    else if (a0 < krem && krem <= a0 + c0) { fj = 0; fa = a0; fc = c0; }
    const unsigned long long bal = __ballot(fj >= 0);
    const int fl = bal ? (__ffsll((long long)bal) - 1) : 0;
    const int pk_ = __shfl((fj << 28) | (fc << 14) | fa, fl);
    prefix |= (unsigned)(4 * fl + ((pk_ >> 28) & 3)) << shift;
    krem -= pk_ & 0x3fff; cbin = (pk_ >> 14) & 0x3fff;
    if (cbin == krem) break;
  }
  int running = 0; unsigned long long myw = 0ull;
  if (cbin == krem) {
#pragma unroll
    for (int i = 0; i < 32; ++i) { const unsigned long long bs = __ballot(key[i] >= prefix); if (lane == i) myw = bs; }
  } else
#pragma unroll
  for (int i = 0; i < 32; ++i) {
    const bool eq = key[i] == prefix;
    const unsigned long long be = __ballot(eq);
    const int rank = running + __popcll(be & ((1ull << lane) - 1ull));
    const bool sel = key[i] > prefix || (eq && rank < krem);
    running += __popcll(be);
    const unsigned long long bs = __ballot(sel);
    if (lane == i) myw = bs;
  }
  if (lane < 32) mrow[lane] = myw;
}

template <class Pred>
DI float attn_wave(const bf16* __restrict__ Kb, const bf16* __restrict__ Vt, float q, int s_lo, int s_hi, Pred pred, int lane) {
  float m = NEGF, l = 0.f, acc = 0.f;
  for (int s = s_lo; s <= s_hi; ++s) {
    if (!pred(s)) continue;
    float sc = wave_sum(q * bf2f(Kb[(size_t)s * 128 + lane])) * 0.125f;
    float mn = fmaxf(m, sc), corr = __expf(m - mn), pp = __expf(sc - mn);
    l = l * corr + pp; acc = acc * corr + pp * bf2f(Vt[(size_t)lane * 2048 + s]); m = mn;
  }
  return l > 0.f ? acc / l : 0.f;
}
DI void dsa_naive_wave(PR p, int wid, int lane) {
  const int tok = wid >> 3, h = wid & 7, g = h >> 2, b = tok >> 11, t = tok & 2047;
  const unsigned* mrow = (const unsigned*)(p.ws + O_DSAM) + (size_t)tok * 64;
  float q = bf2f(((const bf16*)(p.ws + O_QA))[(size_t)tok * 512 + h * 64 + lane]);
  float o = attn_wave((const bf16*)(p.ws + O_KA) + (size_t)b * 2048 * 128 + g * 64, (const bf16*)(p.ws + O_VAT) + (size_t)(b * 2 + g) * 64 * 2048, q, 0, t,
                      [&](int s) { return (mrow[s >> 5] >> (s & 31)) & 1u; }, lane);
  ((bf16*)(p.ws + O_OA))[(size_t)tok * 512 + h * 64 + lane] = f2bf(o);
}
DI void cmpattn_naive_wave(PR p, int wid, int lane, float* qsh  , float* psh  ) {
  const int tok = wid >> 1, g = wid & 1, b = tok >> 11, t = tok & 2047;
  const bf16* kcc = (const bf16*)(p.ws + O_KCC) + (size_t)(b * 2 + g) * 128 * 64;
  const bf16* vct = (const bf16*)(p.ws + O_VCCT) + (size_t)(b * 2 + g) * 64 * 128;
  const float* gn = (const float*)(p.ws + O_GN) + (size_t)tok * 24;
  const int c0 = lane, c1 = lane + 64;
  const bool v0 = (16 * c0 + 31) <= t, v1 = (c1 < 127) && ((16 * c1 + 31) <= t);
  float ps0 = 0.f, ps1 = 0.f;
  for (int r = 0; r < 4; ++r) {
    const int h = g * 4 + r;
    qsh[lane] = bf2f(((const bf16*)(p.ws + O_QBR))[(size_t)tok * 512 + h * 64 + lane]);
    __builtin_amdgcn_wave_barrier();
    float d0 = 0.f, d1 = 0.f;
    for (int d = 0; d < 64; ++d) { float qd = qsh[d]; d0 += qd * bf2f(kcc[c0 * 64 + d]); d1 += qd * bf2f(kcc[(c1 & 127) * 64 + d]); }
    float s0 = v0 ? d0 * 0.125f : NEGF, s1 = v1 ? d1 * 0.125f : NEGF;
    float m = wave_max(fmaxf(s0, s1));
    float e0 = v0 ? __expf(s0 - m) : 0.f, e1 = v1 ? __expf(s1 - m) : 0.f;
    float sum = wave_sum(e0 + e1), inv = 1.f / fmaxf(sum, 1e-30f);
    float p0 = e0 * inv, p1 = e1 * inv;
    ps0 += p0; ps1 += p1;
    float o = 0.f;
    for (int c = 0; c < 127; ++c) { float pc = __shfl(c < 64 ? p0 : p1, c & 63); o += pc * bf2f(vct[lane * 128 + c]); }
    ((bf16*)(p.ws + O_OCMP))[(size_t)tok * 512 + h * 64 + lane] = f2bf(gn[h * 3 + 0] * o);
    __builtin_amdgcn_wave_barrier();
  }
  psh[c0] = ps0; psh[c1] = ps1;
  __builtin_amdgcn_wave_barrier();
  const int j = lane & 31, cur = t >> 6;
  float imp = 0.f;
  for (int c = 4 * j - 1; c <= 4 * j + 3; ++c) if (c >= 0 && c < 127) imp += psh[c];
  const bool forced = (j == 0) || (cur - j >= 0 && cur - j < 2), causal = (j * 64) <= t;
  const float v = forced ? 1e9f : (causal ? imp : NEGF);
  int rank = 0;
  for (int i = 0; i < 32; ++i) { float vi = __shfl(v, i); rank += (vi > v || (vi == v && i < j)) ? 1 : 0; }
  const unsigned long long bal = __ballot(rank < 16);
  if (lane == 0) ((unsigned*)(p.ws + O_SELM))[(size_t)tok * 2 + g] = (unsigned)(bal & 0xFFFFFFFFull);
  __builtin_amdgcn_wave_barrier();
}
DI void selwin_naive_wave(PR p, int wid, int lane) {
  const int tok = wid >> 3, h = wid & 7, g = h >> 2, b = tok >> 11, t = tok & 2047;
  const unsigned sm = ((const unsigned*)(p.ws + O_SELM))[(size_t)tok * 2 + g];
  const float* gn = (const float*)(p.ws + O_GN) + (size_t)tok * 24;
  float q = bf2f(((const bf16*)(p.ws + O_QBT))[(size_t)tok * 512 + h * 64 + lane]);
  float os = attn_wave((const bf16*)(p.ws + O_KS) + (size_t)b * 2048 * 128 + g * 64, (const bf16*)(p.ws + O_VST) + (size_t)(b * 2 + g) * 64 * 2048, q, 0, t,
                       [&](int s) { return (sm >> (s >> 6)) & 1u; }, lane);
  int lo = t - 511; if (lo < 0) lo = 0;
  float ow = attn_wave((const bf16*)(p.ws + O_KW) + (size_t)b * 2048 * 128 + g * 64, (const bf16*)(p.ws + O_VWT) + (size_t)(b * 2 + g) * 64 * 2048, q, lo, t,
                       [&](int) { return true; }, lane);
  const size_t oi = (size_t)tok * 512 + h * 64 + lane;
  float oc = bf2f(((const bf16*)(p.ws + O_OCMP))[oi]);
  ((bf16*)(p.ws + O_OB))[oi] = f2bf(oc + gn[h * 3 + 1] * os + gn[h * 3 + 2] * ow);
}


constexpr int AT_ROW = 72;
constexpr int AT_TILE = 64 * AT_ROW;
template <int TY>
DI void attn_item(PR p, int b, int g, int qt, bf16* smem) {
  const int tid = threadIdx.x, lane = tid & 63, wave = tid >> 6, r = lane & 31, hh = lane >> 5;
  const int h = g * 4 + wave, t = qt * 32 + r, tok = b * 2048 + t;
  unsigned char* ws = p.ws;
  const bf16* Q = (const bf16*)(ws + (TY == 0 ? O_QA : O_QBT)) + (size_t)tok * 512 + h * 64;
  const bf16* K = (const bf16*)(ws + (TY == 0 ? O_KA : (TY == 1 ? O_KW : O_KS))) + (size_t)b * 2048 * 128 + g * 64;
  const bf16* VT = (const bf16*)(ws + (TY == 0 ? O_VAT : (TY == 1 ? O_VWT : O_VST))) + (size_t)(b * 2 + g) * 64 * 2048;
  bf16x8 qf[4];
#pragma unroll
  for (int ks = 0; ks < 4; ++ks) { const uint4 qu = *(const uint4*)(Q + ks * 16 + hh * 8); const float c1q = 0.125f * 1.4426950408889634f;
    uint4 qs; qs.x = pk2(__uint_as_float(qu.x << 16) * c1q, __uint_as_float(qu.x & 0xffff0000u) * c1q); qs.y = pk2(__uint_as_float(qu.y << 16) * c1q, __uint_as_float(qu.y & 0xffff0000u) * c1q);
    qs.z = pk2(__uint_as_float(qu.z << 16) * c1q, __uint_as_float(qu.z & 0xffff0000u) * c1q); qs.w = pk2(__uint_as_float(qu.w << 16) * c1q, __uint_as_float(qu.w & 0xffff0000u) * c1q);
    qf[ks] = __builtin_bit_cast(bf16x8, qs); }
  const int kt_hi = qt >> 1;
  const unsigned upto = (kt_hi == 31) ? 0xFFFFFFFFu : ((2u << kt_hi) - 1u);
  unsigned active = upto; unsigned sm = 0;
  if (TY == 1) { const int lo = qt * 32 - 511; const int kt_lo = lo > 0 ? (lo >> 6) : 0; active = upto & ~((1u << kt_lo) - 1u); }
  if (TY == 2) { sm = ((const unsigned*)(ws + O_SELM))[(size_t)tok * 2 + g]; unsigned o = sm;
#pragma unroll
    for (int off = 1; off < 32; off <<= 1) o |= (unsigned)__shfl_xor((int)o, off);
    active = (unsigned)__builtin_amdgcn_readfirstlane((int)o) & upto; }
  const unsigned* mrow = (const unsigned*)(ws + O_DSAM) + (size_t)tok * 64;
  const int srow = tid >> 3, skc = tid & 7;
  const bf16* kg0 = K + (size_t)srow * 128 + skc * 8;
  const bf16* vg0 = VT + (size_t)srow * 2048 + skc * 8;
  uint4 rk0, rk1, rv0, rv1;
#define AT_GLOAD(kt) { rk0 = *(const uint4*)(kg0 + (size_t)(kt) * 64 * 128); rk1 = *(const uint4*)(kg0 + (size_t)(kt) * 64 * 128 + 32 * 128); \
    rv0 = *(const uint4*)(vg0 + (kt) * 64); rv1 = *(const uint4*)(vg0 + (kt) * 64 + 32 * 2048); }
#define AT_LSTORE(buf) { bf16* Ks_ = smem + (buf) * 2 * AT_TILE; bf16* Vs_ = Ks_ + AT_TILE; \
    *(uint4*)(Ks_ + srow * AT_ROW + skc * 8) = rk0; *(uint4*)(Ks_ + (srow + 32) * AT_ROW + skc * 8) = rk1; \
    *(uint4*)(Vs_ + srow * AT_ROW + skc * 8) = rv0; *(uint4*)(Vs_ + (srow + 32) * AT_ROW + skc * 8) = rv1; }
  f32x16 o0, o1;
#pragma unroll
  for (int i = 0; i < 16; ++i) { o0[i] = 0.f; o1[i] = 0.f; }
  float mrun = NEGF, lrun = 0.f;
  const float c1 = 0.125f * 1.4426950408889634f;
  unsigned rem = active; int buf = 0;
  int kt = __builtin_ctz(rem); rem &= rem - 1;
  __syncthreads();
  AT_GLOAD(kt); AT_LSTORE(0); __syncthreads();
  for (;;) {
    const int ktn = rem ? __builtin_ctz(rem) : -1;
    if (ktn >= 0) AT_GLOAD(ktn);
    const bf16* Ks = smem + buf * 2 * AT_TILE; const bf16* Vs = Ks + AT_TILE;
    f32x16 s0, s1;
#pragma unroll
    for (int i = 0; i < 16; ++i) { s0[i] = 0.f; s1[i] = 0.f; }
#pragma unroll
    for (int ks = 0; ks < 4; ++ks) {
      const bf16x8 a0 = *(const bf16x8*)(Ks + r * AT_ROW + ks * 16 + hh * 8), a1 = *(const bf16x8*)(Ks + (32 + r) * AT_ROW + ks * 16 + hh * 8);
      s0 = __builtin_amdgcn_mfma_f32_32x32x16_bf16(a0, qf[ks], s0, 0, 0, 0);
      s1 = __builtin_amdgcn_mfma_f32_32x32x16_bf16(a1, qf[ks], s1, 0, 0, 0);
    }
    const int kbase = kt * 64 + 4 * hh;
    unsigned w0 = 0, w1 = 0;
    if (TY == 0) {
      const uint2 mw = *(const uint2*)(mrow + kt * 2);
      w0 = mw.x >> (4 * hh); w1 = mw.y >> (4 * hh);
    } else if (TY == 1) {
      const bool full = (kt * 64 + 63 <= qt * 32) && (kt * 64 >= qt * 32 + 31 - 511);
      if (!full) {
#pragma unroll
        for (int i = 0; i < 16; ++i) { const int k0 = kbase + 8 * (i >> 2) + (i & 3), k1 = k0 + 32;
          s0[i] = (k0 <= t && k0 > t - 512) ? s0[i] : NEGF; s1[i] = (k1 <= t && k1 > t - 512) ? s1[i] : NEGF; }
      }
    } else {
      const bool bsel = (sm >> kt) & 1u;
      const bool interior = kt * 64 + 63 <= qt * 32;
      if (interior) {
        if (!__all(bsel)) {
#pragma unroll
          for (int i = 0; i < 16; ++i) { s0[i] = bsel ? s0[i] : NEGF; s1[i] = bsel ? s1[i] : NEGF; }
        }
      } else {
#pragma unroll
        for (int i = 0; i < 16; ++i) { const int k0 = kbase + 8 * (i >> 2) + (i & 3), k1 = k0 + 32;
          s0[i] = (bsel && k0 <= t) ? s0[i] : NEGF; s1[i] = (bsel && k1 <= t) ? s1[i] : NEGF; }
      }
    }
    float mx = s0[0];
#pragma unroll
    for (int i = 1; i < 16; ++i) mx = fmaxf(mx, s0[i]);
#pragma unroll
    for (int i = 0; i < 16; ++i) mx = fmaxf(mx, s1[i]);
    mx = fmaxf(mx, __shfl_xor(mx, 32));
    const float mnew = fmaxf(mrun, mx);
    const float muse = (mnew == NEGF) ? 0.f : mnew;
    const float corr = __builtin_amdgcn_exp2f(mrun - mnew);
    mrun = mnew;
    float ls = 0.f;
#pragma unroll
    for (int i = 0; i < 16; ++i) { s0[i] = __builtin_amdgcn_exp2f(s0[i] - muse); s1[i] = __builtin_amdgcn_exp2f(s1[i] - muse); }
    if (TY == 0) {
#pragma unroll
      for (int i = 0; i < 16; ++i) { const int bit = 8 * (i >> 2) + (i & 3);
        s0[i] = __uint_as_float(__float_as_uint(s0[i]) & (unsigned)__builtin_amdgcn_sbfe((int)w0, bit, 1)); s1[i] = __uint_as_float(__float_as_uint(s1[i]) & (unsigned)__builtin_amdgcn_sbfe((int)w1, bit, 1)); }
    }
#pragma unroll
    for (int i = 0; i < 16; ++i) ls += s0[i] + s1[i];
    lrun = lrun * corr + ls;
    if (__any(corr != 1.f)) {
#pragma unroll
      for (int i = 0; i < 16; ++i) { o0[i] *= corr; o1[i] *= corr; }
    }
#pragma unroll
    for (int mt = 0; mt < 2; ++mt)
#pragma unroll
      for (int sp = 0; sp < 2; ++sp) {
        uint4 pu;
        if (mt == 0) { pu.x = pk2(s0[8 * sp], s0[8 * sp + 1]); pu.y = pk2(s0[8 * sp + 2], s0[8 * sp + 3]); pu.z = pk2(s0[8 * sp + 4], s0[8 * sp + 5]); pu.w = pk2(s0[8 * sp + 6], s0[8 * sp + 7]); }
        else { pu.x = pk2(s1[8 * sp], s1[8 * sp + 1]); pu.y = pk2(s1[8 * sp + 2], s1[8 * sp + 3]); pu.z = pk2(s1[8 * sp + 4], s1[8 * sp + 5]); pu.w = pk2(s1[8 * sp + 6], s1[8 * sp + 7]); }
        const bf16x8 pb = __builtin_bit_cast(bf16x8, pu);
        const int kc = mt * 32 + 16 * sp + 4 * hh;
        uint4 vu;
        { const uint2 lo = *(const uint2*)(Vs + r * AT_ROW + kc), hi = *(const uint2*)(Vs + r * AT_ROW + kc + 8); vu.x = lo.x; vu.y = lo.y; vu.z = hi.x; vu.w = hi.y; }
        o0 = __builtin_amdgcn_mfma_f32_32x32x16_bf16(__builtin_bit_cast(bf16x8, vu), pb, o0, 0, 0, 0);
        { const uint2 lo = *(const uint2*)(Vs + (32 + r) * AT_ROW + kc), hi = *(const uint2*)(Vs + (32 + r) * AT_ROW + kc + 8); vu.x = lo.x; vu.y = lo.y; vu.z = hi.x; vu.w = hi.y; }
        o1 = __builtin_amdgcn_mfma_f32_32x32x16_bf16(__builtin_bit_cast(bf16x8, vu), pb, o1, 0, 0, 0);
      }
    if (ktn < 0) break;
    AT_LSTORE(buf ^ 1);
    __syncthreads();
    buf ^= 1; kt = ktn; rem &= rem - 1;
  }
#undef AT_GLOAD
#undef AT_LSTORE
  const float ltot = lrun + __shfl_xor(lrun, 32);
  float inv = ltot > 0.f ? 1.f / ltot : 0.f;
  const float* gn = (const float*)(ws + O_GN) + (size_t)tok * 24 + h * 3;
  if (TY == 1) inv *= gn[2];
  if (TY == 2) inv *= gn[1];
  const size_t ob = (size_t)tok * 512 + h * 64 + 4 * hh;
  bf16* dst = (bf16*)(ws + (TY == 0 ? O_OA : (TY == 1 ? O_OWIN : O_OB))) + ob;
#pragma unroll
  for (int dt = 0; dt < 2; ++dt)
#pragma unroll
    for (int q = 0; q < 4; ++q) {
      float v0, v1, v2, v3;
      if (dt == 0) { v0 = o0[4 * q] * inv; v1 = o0[4 * q + 1] * inv; v2 = o0[4 * q + 2] * inv; v3 = o0[4 * q + 3] * inv; }
      else { v0 = o1[4 * q] * inv; v1 = o1[4 * q + 1] * inv; v2 = o1[4 * q + 2] * inv; v3 = o1[4 * q + 3] * inv; }
      if (TY == 2) {
        const uint2 a = *(const uint2*)((const bf16*)(ws + O_OCMP) + ob + dt * 32 + 8 * q), w = *(const uint2*)((const bf16*)(ws + O_OWIN) + ob + dt * 32 + 8 * q);
        v0 += __uint_as_float(a.x << 16) + __uint_as_float(w.x << 16); v1 += __uint_as_float(a.x & 0xffff0000u) + __uint_as_float(w.x & 0xffff0000u);
        v2 += __uint_as_float(a.y << 16) + __uint_as_float(w.y << 16); v3 += __uint_as_float(a.y & 0xffff0000u) + __uint_as_float(w.y & 0xffff0000u);
      }
      uint2 o; o.x = pk2(v0, v1); o.y = pk2(v2, v3);
      *(uint2*)(dst + dt * 32 + 8 * q) = o;
    }
}


DI void idx_item(PR p, int b, int qt, unsigned char* lds) {
  int tid = threadIdx.x; asm volatile("" : "+v"(tid));
  const int lane = tid & 63, wave = tid >> 6, r = lane & 31, hh = lane >> 5;
  unsigned char* ws = p.ws;
  const int t = qt * 32 + r, tok = b * 2048 + t;
  if (qt >= 8) {
    const bf16* Qi = (const bf16*)(ws + O_QI) + (size_t)tok * 256;
    bf16x8 qf[8][2];
#pragma unroll
    for (int h = 0; h < 8; ++h) { qf[h][0] = *(const bf16x8*)(Qi + h * 32 + hh * 8); qf[h][1] = *(const bf16x8*)(Qi + h * 32 + 16 + hh * 8); }
    const f32x4 wa = *(const f32x4*)((const float*)(ws + O_WI) + (size_t)tok * 8), wb = *(const f32x4*)((const float*)(ws + O_WI) + (size_t)tok * 8 + 4);
    const bf16* Ki = (const bf16*)(ws + O_KI) + (size_t)b * 2048 * 32;
    float* SCr = (float*)(ws + O_SC) + (size_t)tok * 2048 + 4 * hh;
#pragma unroll 1
    for (int kt = wave; kt <= qt; kt += 4) {
      const bf16* kr = Ki + (size_t)(kt * 32 + r) * 32 + hh * 8;
      const bf16x8 a0 = *(const bf16x8*)kr, a1 = *(const bf16x8*)(kr + 16);
      f32x16 sc;
#pragma unroll
      for (int i = 0; i < 16; ++i) sc[i] = 0.f;
#pragma unroll
      for (int h = 0; h < 8; ++h) {
        f32x16 s;
#pragma unroll
        for (int i = 0; i < 16; ++i) s[i] = 0.f;
        s = __builtin_amdgcn_mfma_f32_32x32x16_bf16(a0, qf[h][0], s, 0, 0, 0);
        s = __builtin_amdgcn_mfma_f32_32x32x16_bf16(a1, qf[h][1], s, 0, 0, 0);
        const float w = h < 4 ? wa[h & 3] : wb[h & 3];
#pragma unroll
        for (int i = 0; i < 16; ++i) { float t_ = sc[i] + w * fmaxf(s[i], 0.f); asm volatile("" : "+v"(t_)); sc[i] = t_; }
      }
#pragma unroll
      for (int q = 0; q < 4; ++q) { f32x4 o = {sc[4 * q], sc[4 * q + 1], sc[4 * q + 2], sc[4 * q + 3]}; *(f32x4*)(SCr + kt * 32 + 8 * q) = o; }
    }
    __threadfence_block();
  }
  __syncthreads();
#pragma unroll 1
  for (int i = 0; i < 8; ++i) { const int row = qt * 32 + wave * 8 + i, tk = b * 2048 + row;
    select_row((const float*)(ws + O_SC) + (size_t)tk * 2048, row, (unsigned long long*)(ws + O_DSAM) + (size_t)tk * 32, (unsigned*)lds + wave * 1024, lane); }
}

constexpr int CM_VROW = 136;
DI void cmp_item(PR p, int b, int g, int qt, unsigned char* lds) {
  const int tid = threadIdx.x, lane = tid & 63, wave = tid >> 6, r = lane & 31, hh = lane >> 5;
  unsigned char* ws = p.ws;
  const int h = g * 4 + wave, t = qt * 32 + r, tok = b * 2048 + t;
  bf16* Ks = (bf16*)lds;
  bf16* Vs = Ks + 128 * AT_ROW;
  float* imps = (float*)(Vs + 64 * CM_VROW);
  const bf16* Kg = (const bf16*)(ws + O_KCC) + (size_t)(b * 2 + g) * 128 * 64;
  const bf16* Vg = (const bf16*)(ws + O_VCCT) + (size_t)(b * 2 + g) * 64 * 128;
  __syncthreads();
#pragma unroll
  for (int i = 0; i < 4; ++i) { const int c = tid + 256 * i; { const int row = c >> 3, kc = c & 7; *(uint4*)(Ks + row * AT_ROW + kc * 8) = *(const uint4*)(Kg + row * 64 + kc * 8); }
    { const int row = c >> 4, kc = c & 15; *(uint4*)(Vs + row * CM_VROW + kc * 8) = *(const uint4*)(Vg + row * 128 + kc * 8); } }
  const bf16* Q = (const bf16*)(ws + O_QBR) + (size_t)tok * 512 + h * 64;
  bf16x8 qf[4];
#pragma unroll
  for (int ks = 0; ks < 4; ++ks) qf[ks] = *(const bf16x8*)(Q + ks * 16 + hh * 8);
  __syncthreads();
  f32x16 s[4];
#pragma unroll
  for (int mt = 0; mt < 4; ++mt) {
#pragma unroll
    for (int i = 0; i < 16; ++i) s[mt][i] = 0.f;
#pragma unroll
    for (int ks = 0; ks < 4; ++ks) { const bf16x8 a = *(const bf16x8*)(Ks + (mt * 32 + r) * AT_ROW + ks * 16 + hh * 8); s[mt] = __builtin_amdgcn_mfma_f32_32x32x16_bf16(a, qf[ks], s[mt], 0, 0, 0); }
    if (mt & 1) __builtin_amdgcn_sched_barrier(0);
  }
  const float c1 = 0.125f * 1.4426950408889634f;
  float mx = NEGF;
  int cthr = (t - 31) >> 4; cthr = (cthr > 126 ? 126 : cthr) - 4 * hh;
#pragma unroll
  for (int mt = 0; mt < 4; ++mt)
#pragma unroll
    for (int i = 0; i < 16; ++i) { const bool ok = (mt * 32 + 8 * (i >> 2) + (i & 3)) <= cthr; s[mt][i] = ok ? s[mt][i] * c1 : NEGF; mx = fmaxf(mx, s[mt][i]); }
  mx = fmaxf(mx, __shfl_xor(mx, 32));
  const float muse = (mx == NEGF) ? 0.f : mx;
  float ls = 0.f;
#pragma unroll
  for (int mt = 0; mt < 4; ++mt)
#pragma unroll
    for (int i = 0; i < 16; ++i) { s[mt][i] = __builtin_amdgcn_exp2f(s[mt][i] - muse); ls += s[mt][i]; }
  ls += __shfl_xor(ls, 32);
  const float inv = 1.f / fmaxf(ls, 1e-30f);
#pragma unroll
  for (int mt = 0; mt < 4; ++mt)
#pragma unroll
    for (int i = 0; i < 16; ++i) s[mt][i] *= inv;
  f32x16 o0, o1;
#pragma unroll
  for (int i = 0; i < 16; ++i) { o0[i] = 0.f; o1[i] = 0.f; }
#pragma unroll
  for (int mt = 0; mt < 4; ++mt)
#pragma unroll
    for (int sp = 0; sp < 2; ++sp) {
      uint4 pu; pu.x = pk2(s[mt][8 * sp], s[mt][8 * sp + 1]); pu.y = pk2(s[mt][8 * sp + 2], s[mt][8 * sp + 3]); pu.z = pk2(s[mt][8 * sp + 4], s[mt][8 * sp + 5]); pu.w = pk2(s[mt][8 * sp + 6], s[mt][8 * sp + 7]);
      const bf16x8 pb = __builtin_bit_cast(bf16x8, pu);
      const int kc = mt * 32 + 16 * sp + 4 * hh;
      uint4 vu;
      { const uint2 lo = *(const uint2*)(Vs + r * CM_VROW + kc), hi = *(const uint2*)(Vs + r * CM_VROW + kc + 8); vu.x = lo.x; vu.y = lo.y; vu.z = hi.x; vu.w = hi.y; }
      o0 = __builtin_amdgcn_mfma_f32_32x32x16_bf16(__builtin_bit_cast(bf16x8, vu), pb, o0, 0, 0, 0);
      { const uint2 lo = *(const uint2*)(Vs + (32 + r) * CM_VROW + kc), hi = *(const uint2*)(Vs + (32 + r) * CM_VROW + kc + 8); vu.x = lo.x; vu.y = lo.y; vu.z = hi.x; vu.w = hi.y; }
      o1 = __builtin_amdgcn_mfma_f32_32x32x16_bf16(__builtin_bit_cast(bf16x8, vu), pb, o1, 0, 0, 0);
      if (sp) __builtin_amdgcn_sched_barrier(0);
    }
  { const float g0 = ((const float*)(ws + O_GN))[(size_t)tok * 24 + h * 3];
    bf16* dst = (bf16*)(ws + O_OCMP) + (size_t)tok * 512 + h * 64 + 4 * hh;
#pragma unroll
    for (int q = 0; q < 4; ++q) { uint2 o; o.x = pk2(o0[4 * q] * g0, o0[4 * q + 1] * g0); o.y = pk2(o0[4 * q + 2] * g0, o0[4 * q + 3] * g0); *(uint2*)(dst + 8 * q) = o;
      o.x = pk2(o1[4 * q] * g0, o1[4 * q + 1] * g0); o.y = pk2(o1[4 * q + 2] * g0, o1[4 * q + 3] * g0); *(uint2*)(dst + 32 + 8 * q) = o; } }
  float* myimp = imps + (wave * 32 + r) * 33;
  float prevlast = 0.f;
#pragma unroll
  for (int mt = 0; mt < 4; ++mt)
#pragma unroll
    for (int q = 0; q < 4; ++q) {
      const float qs = (s[mt][4 * q] + s[mt][4 * q + 1]) + (s[mt][4 * q + 2] + s[mt][4 * q + 3]);
      const float other = __shfl_xor(s[mt][4 * q + 3], 32);
      const float prev = hh ? other : prevlast;
      myimp[mt * 8 + 2 * q + hh] = qs + prev;
      prevlast = other;
    }
  __syncthreads();
  {
    const int qq = tid >> 3, j0 = (tid & 7) * 4, tq = qt * 32 + qq, cur = tq >> 6;
    float v[4];
#pragma unroll
    for (int i = 0; i < 4; ++i) { const int j = j0 + i; const float im = (imps[(0 * 32 + qq) * 33 + j] + imps[(1 * 32 + qq) * 33 + j]) + (imps[(2 * 32 + qq) * 33 + j] + imps[(3 * 32 + qq) * 33 + j]);
      const bool forced = (j == 0) || (cur - j >= 0 && cur - j < 2), causal = (j * 64) <= tq; v[i] = forced ? 1e9f : (causal ? im : NEGF); }
    __syncthreads();
    float* vv = imps + qq * 33;
#pragma unroll
    for (int i = 0; i < 4; ++i) vv[j0 + i] = v[i];
    __syncthreads();
    unsigned bits = 0;
#pragma unroll
    for (int i = 0; i < 4; ++i) { const int j = j0 + i; int rank = 0;
      for (int k = 0; k < 32; ++k) { const float vk = vv[k]; rank += (vk > v[i] || (vk == v[i] && k < j)) ? 1 : 0; }
      if (rank < 16) bits |= 1u << j; }
    bits |= (unsigned)__shfl_xor((int)bits, 1); bits |= (unsigned)__shfl_xor((int)bits, 2); bits |= (unsigned)__shfl_xor((int)bits, 4);
    if ((tid & 7) == 0) ((unsigned*)(ws + O_SELM))[(size_t)(b * 2048 + tq) * 2 + g] = bits;
  }
}

DI float gelu_tanh(float x) { float u = 0.7978845608028654f * (x + 0.044715f * x * x * x); return 0.5f * x * (1.f + tanhf(u)); }
DI void cmp1_tile(PR p, int it, bf16* smem) {
  const int which = it >> 6, bg = (it >> 1) & 31, nt = it & 1, n0 = nt * 128;
  const int lane = threadIdx.x & 63, wave = threadIdx.x >> 6, wm = wave >> 1, wn = wave & 1;
  f32x16 acc[2][2]; acc_zero(acc);
  ALPlain al{(const bf16*)(p.ws + (which ? O_VC : O_KC)) + (size_t)bg * 2048 * 64, 1024};
  ALPlain bl{(const bf16*)(p.ws + (which ? O_WT_C1V : O_WT_C1K)) + (size_t)n0 * 2048, 2048};
  gemm_mainloop_dma(acc, al, bl, 64, (unsigned char*)smem);
  const float* cb = (const float*)(p.ws + O_CMPB) + which * 32 * 256;
  bf16* H1 = (bf16*)(p.ws + O_H1) + ((size_t)which * 4096 + bg * 128) * 256;
#pragma unroll
  for (int ni = 0; ni < 2; ++ni) {
    const int n = n0 + wn * 64 + ni * 32 + (lane & 31);
    float bias = 0.f;
    for (int kc = 0; kc < 32; ++kc) bias += cb[kc * 256 + n];
#pragma unroll
    for (int mi = 0; mi < 2; ++mi) { float v[16];
#pragma unroll
      for (int r = 0; r < 16; ++r) v[r] = gelu_tanh(acc[mi][ni][r] + bias);
      st16_bf16(H1 + (size_t)(wm * 64 + mi * 32 + 4 * (lane >> 5)) * 256 + n, 256, v); }
  }
}
DI void cmp2_tile(PR p, int it, bf16* smem) {
  const int which = it >> 5, bg = it & 31;
  const int lane = threadIdx.x & 63, wave = threadIdx.x >> 6, wm = wave >> 1, wn = wave & 1;
  f32x16 acc[2][2]; acc_zero(acc);
  ALPlain al{(const bf16*)(p.ws + O_H1) + ((size_t)which * 4096 + bg * 128) * 256, 256};
  ALPlain bl{(const bf16*)(p.ws + (which ? O_WT_C2V : O_WT_C2K)), 256};
  gemm_mainloop_dma(acc, al, bl, 8, (unsigned char*)smem);
  if (wn == 0) {
#pragma unroll
    for (int ni = 0; ni < 2; ++ni) { const int d = ni * 32 + (lane & 31);
#pragma unroll
      for (int mi = 0; mi < 2; ++mi) { const int c0 = wm * 64 + mi * 32 + 4 * (lane >> 5); float v[16];
#pragma unroll
        for (int r = 0; r < 16; ++r) v[r] = (c0 + 8 * (r >> 2) + (r & 3)) < 127 ? acc[mi][ni][r] : 0.f;
        if (which == 0) st16_bf16((bf16*)(p.ws + O_KCC) + ((size_t)bg * 128 + c0) * 64 + d, 64, v);
        else { bf16* d_ = (bf16*)(p.ws + O_VCCT) + ((size_t)bg * 64 + d) * 128 + c0; asm volatile("" : "+v"(d_));
#pragma unroll
          for (int q = 0; q < 4; ++q) { uint2 o_; o_.x = pk2(v[4 * q], v[4 * q + 1]); o_.y = pk2(v[4 * q + 2], v[4 * q + 3]); *(uint2*)(d_ + 8 * q) = o_; } } } }
  }
}

DI void merge_tile(PR p, int it, bf16* smem) {
  const int nt = it >> 8, mt = it & 255, m0 = mt * 128, n0 = nt * 128;
  const int lane = threadIdx.x & 63, wave = threadIdx.x >> 6, wm = wave >> 1, wn = wave & 1;
  f32x16 acc[2][2], acb[2][2]; acc_zero(acc); acc_zero(acb);
  { ALPlain al{(const bf16*)(p.ws + O_OA) + (size_t)m0 * 512, 512}; ALPlain bl{(const bf16*)(p.ws + O_WT_BRA) + (size_t)n0 * 512, 512}; gemm_mainloop_dma(acc, al, bl, 16, (unsigned char*)smem); }
  { ALPlain al{(const bf16*)(p.ws + O_OB) + (size_t)m0 * 512, 512}; ALPlain bl{(const bf16*)(p.ws + O_WT_BRB) + (size_t)n0 * 512, 512}; gemm_mainloop_dma(acb, al, bl, 16, (unsigned char*)smem); }
  bf16* tA = smem; bf16* tB = smem + 128 * 136;
  { const int c = lane & 31, h4 = 4 * (lane >> 5);
#pragma unroll
    for (int mi = 0; mi < 2; ++mi)
#pragma unroll
      for (int ni = 0; ni < 2; ++ni) { const int o = (wm * 64 + mi * 32 + h4) * 136 + wn * 64 + ni * 32 + c;
#pragma unroll
        for (int r = 0; r < 16; ++r) { const int oo = o + (8 * (r >> 2) + (r & 3)) * 136; tA[oo] = (bf16)pk2(acc[mi][ni][r], 0.f); tB[oo] = (bf16)pk2(acb[mi][ni][r], 0.f); } } }
  __syncthreads();
  const bf16* SGA = (const bf16*)(p.ws + O_SGA); const bf16* SGB = (const bf16*)(p.ws + O_SGB); bf16* M = (bf16*)(p.ws + O_MERGED);
#pragma unroll 2
  for (int j = 0; j < 8; ++j) { const int u = threadIdx.x + 256 * j, row = u >> 4, cg = u & 15;
    const size_t o = (size_t)(m0 + row) * 1024 + n0 + cg * 8;
    const uint4 a = *(const uint4*)(tA + row * 136 + cg * 8), bq = *(const uint4*)(tB + row * 136 + cg * 8), ga = __builtin_bit_cast(uint4, NT_LD16(SGA + o)), gb = __builtin_bit_cast(uint4, NT_LD16(SGB + o));
#define MG(av, bv, gav, gbv, out) { const float lo_ = __uint_as_float(gav << 16) * __uint_as_float(av << 16) + __uint_as_float(gbv << 16) * __uint_as_float(bv << 16); \
      const float hi_ = __uint_as_float(gav & 0xffff0000u) * __uint_as_float(av & 0xffff0000u) + __uint_as_float(gbv & 0xffff0000u) * __uint_as_float(bv & 0xffff0000u); out = pk2(lo_, hi_); }
    uint4 r; MG(a.x, bq.x, ga.x, gb.x, r.x) MG(a.y, bq.y, ga.y, gb.y, r.y) MG(a.z, bq.z, ga.z, gb.z, r.z) MG(a.w, bq.w, ga.w, gb.w, r.w)
#undef MG
    *(uint4*)(M + o) = r; }
}
DI void out_tile(PR p, int it, bf16* smem) {
  const int nt = it >> 7, mt = it & 127, m0 = mt * 256, n0 = nt * 128;
  const int lane = threadIdx.x & 63, wave = threadIdx.x >> 6, wm = wave >> 1, wn = wave & 1;
  f32x16 acc[4][2];
#pragma unroll
  for (int mi = 0; mi < 4; ++mi)
#pragma unroll
    for (int r = 0; r < 16; ++r) { acc[mi][0][r] = 0.f; acc[mi][1][r] = 0.f; }
  ALPlain al{(const bf16*)(p.ws + O_MERGED) + (size_t)m0 * 1024, 1024}; ALPlain bl{(const bf16*)(p.ws + O_WT_OUT) + (size_t)n0 * 1024, 1024};
  gemm_mainloop_dma_m256(acc, al, bl, 32, (unsigned char*)smem);
  const float* g1 = (const float*)(p.ws + O_MOD) + (m0 >> 11) * 6144 + 2048 + n0; float* Y = (float*)(p.ws + O_Y);
  float* st = (float*)smem;
#pragma unroll 1
  for (int h = 0; h < 2; ++h) {
    if (wm == h) {
#pragma unroll
      for (int mi = 0; mi < 4; ++mi)
#pragma unroll
        for (int ni = 0; ni < 2; ++ni) { float* bq = st + (mi * 32 + 4 * (lane >> 5)) * ST_LD + wn * 64 + ni * 32 + (lane & 31);
#pragma unroll
          for (int r = 0; r < 16; ++r) bq[(8 * (r >> 2) + (r & 3)) * ST_LD] = acc[mi][ni][r]; }
    }
    __syncthreads();
#pragma unroll 4
    for (int j = 0; j < 16; ++j) { const int u = threadIdx.x + 256 * j, row = u >> 5, c4 = u & 31;
      const size_t o = (size_t)(m0 + h * 128 + row) * 1024 + n0 + c4 * 4;
      const f32x4 a = *(const f32x4*)(st + row * ST_LD + c4 * 4), xv = __builtin_nontemporal_load((const f32x4*)(p.x + o)), gv = *(const f32x4*)(g1 + c4 * 4);
      f32x4 y; y[0] = DN_ALPHA * xv[0] + gv[0] * a[0]; y[1] = DN_ALPHA * xv[1] + gv[1] * a[1]; y[2] = DN_ALPHA * xv[2] + gv[2] * a[2]; y[3] = DN_ALPHA * xv[3] + gv[3] * a[3];
      *(f32x4*)(Y + o) = y; }
    __syncthreads();
  }
}

DI void ln1_row(PR p, int tok, int lane) {
  const int b = tok >> 11;
  const float4* yr = (const float4*)((const float*)(p.ws + O_Y) + (size_t)tok * 1024);
  float4 v[4]; float s = 0.f;
#pragma unroll
  for (int j = 0; j < 4; ++j) { const f32x4 yv = __builtin_nontemporal_load((const f32x4*)yr + lane + 64 * j); v[j].x = yv[0]; v[j].y = yv[1]; v[j].z = yv[2]; v[j].w = yv[3]; s += (v[j].x + v[j].y) + (v[j].z + v[j].w); }
  const float mean = wave_sum(s) * (1.f / 1024.f); float s2 = 0.f;
#pragma unroll
  for (int j = 0; j < 4; ++j) { v[j].x -= mean; v[j].y -= mean; v[j].z -= mean; v[j].w -= mean; s2 += (v[j].x * v[j].x + v[j].y * v[j].y) + (v[j].z * v[j].z + v[j].w * v[j].w); }
  const float rstd = 1.f / sqrtf(wave_sum(s2) * (1.f / 1024.f) + LN_EPS);
  const float* mod = (const float*)(p.ws + O_MOD) + b * 6144;
  float* X1 = (float*)(p.ws + O_X1) + (size_t)tok * 1024; bf16* HH = (bf16*)(p.ws + O_HHI) + (size_t)tok * 1024; bf16* HL = (bf16*)(p.ws + O_HLO) + (size_t)tok * 1024;
#pragma unroll
  for (int j = 0; j < 4; ++j) {
    const int col = (lane + 64 * j) * 4;
    const float4 g = *(const float4*)(p.ln1_g + col), bb = *(const float4*)(p.ln1_b + col);
    const float4 sh = *(const float4*)(mod + 3072 + col), sc = *(const float4*)(mod + 4096 + col);
    float4 x1; x1.x = v[j].x * rstd * g.x + bb.x; x1.y = v[j].y * rstd * g.y + bb.y; x1.z = v[j].z * rstd * g.z + bb.z; x1.w = v[j].w * rstd * g.w + bb.w;
    { f32x4 xo = {x1.x, x1.y, x1.z, x1.w}; __builtin_nontemporal_store(xo, (f32x4*)(X1 + col)); }
    const float h0 = x1.x * (1.f + sc.x) + sh.x, h1 = x1.y * (1.f + sc.y) + sh.y, h2 = x1.z * (1.f + sc.z) + sh.z, h3 = x1.w * (1.f + sc.w) + sh.w;
    ushort4 hi, lo;
    hi.x = f2bf(h0); hi.y = f2bf(h1); hi.z = f2bf(h2); hi.w = f2bf(h3);
    lo.x = f2bf(h0 - bf2f(hi.x)); lo.y = f2bf(h1 - bf2f(hi.y)); lo.z = f2bf(h2 - bf2f(hi.z)); lo.w = f2bf(h3 - bf2f(hi.w));
    *(ushort4*)(HH + col) = hi; *(ushort4*)(HL + col) = lo;
  }
}

DI void router_tile(PR p, int it, bf16* smem) {
  const int nt = it >> 8, mt = it & 255, m0 = mt * 128, n0 = nt * 128;
  const int lane = threadIdx.x & 63, wave = threadIdx.x >> 6, wm = wave >> 1, wn = wave & 1;
  f32x16 acc[2][2]; acc_zero(acc);
  ALRouter al{(const bf16*)(p.ws + O_HHI) + (size_t)m0 * 1024}; BLRouterB bl{(const bf16*)(p.ws + O_WT_RT) + (size_t)n0 * 2048};
  gemm_mainloop_dma(acc, al, bl, 96, (unsigned char*)smem);
  float* L = (float*)(p.ws + O_LOGITS);
  float* st = (float*)smem; stage_acc(st, acc);
  __syncthreads();
#pragma unroll 4
  for (int j = 0; j < 16; ++j) { const int u = threadIdx.x + 256 * j, row = u >> 5, c4 = u & 31;
    __builtin_nontemporal_store(*(const f32x4*)(st + row * ST_LD + c4 * 4), (f32x4*)(L + (size_t)(m0 + row) * 256 + n0 + c4 * 4)); }
}
DI void gateup_store(f32x16 (&acc)[2][2], bf16* dst  , int nvalid, int hc0, float* st) {
  const int lane = threadIdx.x & 63, wave = threadIdx.x >> 6, wm = wave >> 1, wn = wave & 1;
#pragma unroll
  for (int mi = 0; mi < 2; ++mi) {
    float* b = st + (wm * 64 + mi * 32 + 4 * (lane >> 5)) * 68 + wn * 32 + (lane & 31);
#pragma unroll
    for (int r = 0; r < 16; ++r) b[(8 * (r >> 2) + (r & 3)) * 68] = siluf_(acc[mi][0][r]) * acc[mi][1][r]; }
  __syncthreads();
#pragma unroll
  for (int j = 0; j < 4; ++j) { const int u = threadIdx.x + 256 * j, row = u >> 3, cg = u & 7;
    if (row < nvalid) *(uint4*)(dst + (size_t)row * 256 + hc0 + cg * 8) = pack8(st + row * 68 + cg * 8); }
}
DI void sh1_tile(PR p, int it, bf16* smem) {
  const int nt = it >> 8, mt = it & 255, m0 = mt * 128;
  f32x16 acc[2][2]; acc_zero(acc);
  ALPlain al{(const bf16*)(p.ws + O_HHI) + (size_t)m0 * 1024, 1024}; ALPlain bl{(const bf16*)(p.ws + O_WT_SGU) + (size_t)nt * 128 * 1024, 1024};
  gemm_mainloop_dma(acc, al, bl, 32, (unsigned char*)smem);
  gateup_store(acc, (bf16*)(p.ws + O_ACTSH) + (size_t)m0 * 256, 128, nt * 64, (float*)smem);
}
DI void sh2_tile(PR p, int it, bf16* smem) {
  const int nt = it >> 8, mt = it & 255, m0 = mt * 128, n0 = nt * 128;
  const int lane = threadIdx.x & 63, wave = threadIdx.x >> 6, wm = wave >> 1, wn = wave & 1;
  f32x16 acc[2][2]; acc_zero(acc);
  ALPlain al{(const bf16*)(p.ws + O_ACTSH) + (size_t)m0 * 256, 256}; ALPlain bl{(const bf16*)(p.ws + O_WT_SD) + (size_t)n0 * 256, 256};
  gemm_mainloop_dma(acc, al, bl, 8, (unsigned char*)smem);
  bf16* Y = (bf16*)(p.ws + O_YSH);
  float* st = (float*)smem; stage_acc(st, acc);
  __syncthreads();
#pragma unroll 2
  for (int j = 0; j < 8; ++j) { const int u = threadIdx.x + 256 * j, row = u >> 4, cg = u & 15;
    *(uint4*)(Y + (size_t)(m0 + row) * 1024 + n0 + cg * 8) = pack8(st + row * ST_LD + cg * 8); }
}

#define DPPF(v_, ctrl_, rm_, bm_) __int_as_float(__builtin_amdgcn_update_dpp(__float_as_int(v_), __float_as_int(v_), ctrl_, rm_, bm_, false))
DI float readlane_f(float v, int l) { return __int_as_float(__builtin_amdgcn_readlane(__float_as_int(v), l)); }
DI float wave_max_bcast(float v) {
  v = fmaxf(v, DPPF(v, 0x111, 0xf, 0xf)); v = fmaxf(v, DPPF(v, 0x112, 0xf, 0xf)); v = fmaxf(v, DPPF(v, 0x114, 0xf, 0xf)); v = fmaxf(v, DPPF(v, 0x118, 0xf, 0xf));
  v = fmaxf(v, DPPF(v, 0x142, 0xa, 0xf)); v = fmaxf(v, DPPF(v, 0x143, 0xc, 0xf));
  return readlane_f(v, 63);
}
DI void route_token(unsigned char* ws, const float* __restrict__ logit, const float* __restrict__ bias, int tok, int lane) {
  const f32x4 lgv = __builtin_nontemporal_load((const f32x4*)(logit + 4 * lane)); float4 lg; lg.x = lgv[0]; lg.y = lgv[1]; lg.z = lgv[2]; lg.w = lgv[3]; const float4 bi = *(const float4*)(bias + 4 * lane);
  float sv[4] = {sigmoidf_(lg.x), sigmoidf_(lg.y), sigmoidf_(lg.z), sigmoidf_(lg.w)};
  float cv[4] = {sv[0] + bi.x, sv[1] + bi.y, sv[2] + bi.z, sv[3] + bi.w};
  float m1 = fmaxf(fmaxf(cv[0], cv[1]), fmaxf(cv[2], cv[3]));
  float m2;
  { float a = fmaxf(cv[0], cv[1]), bq = fminf(cv[0], cv[1]), c = fmaxf(cv[2], cv[3]), d = fminf(cv[2], cv[3]); m2 = fmaxf(fminf(a, c), fmaxf(bq, d)); }
#define TOP2_MERGE(ctrl_) { const float o1 = DPPF(m1, ctrl_, 0xf, 0xf), o2 = DPPF(m2, ctrl_, 0xf, 0xf); const float n1 = fmaxf(m1, o1), n2 = fmaxf(fminf(m1, o1), fmaxf(m2, o2)); m1 = n1; m2 = n2; }
  TOP2_MERGE(0xB1) TOP2_MERGE(0x4E) TOP2_MERGE(0x141)
#undef TOP2_MERGE
  const float gs = m1 + m2; const int grp = lane >> 3;
  int rank = 0;
#pragma unroll
  for (int g2 = 0; g2 < 8; ++g2) { const float og = readlane_f(gs, g2 * 8); rank += (og > gs || (og == gs && g2 < grp)) ? 1 : 0; }
  const bool keep = rank < 4;
#pragma unroll
  for (int j = 0; j < 4; ++j) if (!keep) cv[j] = NEGF;
  float wsum = 0.f, myw = 0.f; int myidx = 0;
#pragma unroll
  for (int r = 0; r < 8; ++r) {
    float bv = cv[0]; int bj = 0;
#pragma unroll
    for (int j = 1; j < 4; ++j) if (cv[j] > bv) { bv = cv[j]; bj = j; }
    const float vmax = wave_max_bcast(bv);
    const unsigned long long bal = __ballot(bv == vmax);
    const int owner = (int)__builtin_ctzll(bal);
    const int oj = __builtin_amdgcn_readlane(bj, owner), wi = 4 * owner + oj;
    const float sj = (bj == 0) ? sv[0] : (bj == 1) ? sv[1] : (bj == 2) ? sv[2] : sv[3];
    const float ssel = readlane_f(sj, owner);
    { const bool me = lane == owner;
#pragma unroll
      for (int j = 0; j < 4; ++j) cv[j] = (me && bj == j) ? -3e38f : cv[j]; }
    wsum += ssel;
    if (lane == r) { myw = ssel; myidx = wi; }
  }
  if (lane < 8) {
    const float wgt = myw / wsum * 2.5f;
    ((int*)(ws + O_RIDX))[(size_t)tok * 8 + lane] = myidx;
    ((float*)(ws + O_RW))[(size_t)tok * 8 + lane] = wgt;
    const int pos = atomicAdd((int*)(ws + O_CTL) + CW_CNT + myidx * CNT_STRIDE, 1);
    ((int*)(ws + O_LIST))[(size_t)myidx * 32768 + pos] = tok * 8 + lane;
  }
}

DI void moe_offsets(const int* cnt, int* offs, int* stoffs) {
  __syncthreads();
  const int t = threadIdx.x; const int c = cnt[t * CNT_STRIDE];
  offs[t + 1] = c; if (t == 0) offs[0] = 0;
  __syncthreads();
  for (int o = 1; o < 256; o <<= 1) {
    int a = 0; if (t + 1 > o) a = offs[t + 1 - o];
    __syncthreads();
    if (t + 1 > o) offs[t + 1] += a;
    __syncthreads();
  }
  if (t < 8) { int a = 0; for (int j = 0; j < 32; ++j) { stoffs[t * 33 + j] = a; const int e = t + 8 * j; a += (offs[e + 1] - offs[e] + 255) >> 8; } stoffs[t * 33 + 32] = a; }
  __syncthreads();
}
DI int find_le32(const int* arr, int v) { int lo = 0, hi = 31; while (lo < hi) { int mid = (lo + hi + 1) >> 1; if (arr[mid] <= v) lo = mid; else hi = mid - 1; } return lo; }

DI void ph_moe1(PR p, bf16* smem, int* misc, int* ctrs) {
  int* offs = misc + 16; int* stoffs = misc + 280; int* shv = misc;
  moe_offsets((const int*)(p.ws + O_CTL) + CW_CNT, offs, stoffs);
  const int myx = xcc_id(); int off = 0, x, idx;
  constexpr int NSPL = 2, NPER = 4 / NSPL;
  while (shard_next(ctrs, myx, off, [stoffs](int xx) { return stoffs[xx * 33 + 32] * NSPL + 128; }, shv, x, idx)) {
    const int n_routed = stoffs[x * 33 + 32] * NSPL;
    if (idx >= n_routed) { const int i2 = idx - n_routed, g = i2 >> 5, rem = i2 & 31, nt = rem >> 3, mt = x * 32 + g * 8 + (rem & 7); sh1_tile(p, nt * 256 + mt, smem); continue; }
    int tid = threadIdx.x; asm volatile("" : "+v"(tid));
    const int lane = tid & 63, wave = tid >> 6, wm = wave >> 1, wn = wave & 1;
    const int arow = tid >> 2, akc = tid & 3, kg = tid >> 5, n4 = tid & 31;
    const int r = lane & 31, hh = lane >> 5;
    const int aoff = (wm * 128 + r) * 40 + hh * 8;
    const int nb0 = wn * 64 + r, nb1 = nb0 + 32;
    const int boff0 = M2_A_ELEMS + (hh * 128 + (nb0 ^ ((nb0 >> 3) & 3))) * 8, boff1 = M2_A_ELEMS + (hh * 128 + (nb1 ^ ((nb1 >> 3) & 3))) * 8;
    const int j = find_le32(stoffs + x * 33, idx / NSPL), e = x + 8 * j;
    const int me = stoffs[x * 33 + j + 1] - stoffs[x * 33 + j], local = idx - stoffs[x * 33 + j] * NSPL, nt_lo = (local / me) * NPER, mt = local % me;
    const int cnt = offs[e + 1] - offs[e], nvalid = min(256, cnt - mt * 256);
    const int* list = (const int*)(p.ws + O_LIST) + (size_t)e * 32768 + mt * 256;
    const bf16* abase = (const bf16*)(p.ws + O_HHI);
    unsigned ao0, ao1, ao2, ao3;
    { const int r0 = arow < nvalid ? arow : nvalid - 1, r1 = arow + 64 < nvalid ? arow + 64 : nvalid - 1, r2 = arow + 128 < nvalid ? arow + 128 : nvalid - 1, r3 = arow + 192 < nvalid ? arow + 192 : nvalid - 1;
      const int t0 = list[r0], t1 = list[r1], t2 = list[r2], t3 = list[r3];
      ao0 = (unsigned)(t0 >> 3) * 1024u + akc * 8; ao1 = (unsigned)(t1 >> 3) * 1024u + akc * 8; ao2 = (unsigned)(t2 >> 3) * 1024u + akc * 8; ao3 = (unsigned)(t3 >> 3) * 1024u + akc * 8; }
    const long du = (long)(p.w_exp_up - p.w_exp_gate);
    const float* wb = p.w_exp_gate + (size_t)e * 262144 + (long)(((n4 * 4) >> 5) & 1) * du + ((n4 * 4) >> 6) * 32 + ((n4 * 4) & 31) + (size_t)(kg * 4) * 256;
    uint4 ra0, ra1, ra2, ra3; f32x4 rb[4];
#define GLOADX(nt, kt) { const bf16* ab_ = abase + (kt) * 32; ra0 = *(const uint4*)(ab_ + ao0); ra1 = *(const uint4*)(ab_ + ao1); ra2 = *(const uint4*)(ab_ + ao2); ra3 = *(const uint4*)(ab_ + ao3); \
      const float* bp_ = wb + (nt) * 64 + (size_t)((kt) * 32) * 256; _Pragma("unroll") for (int r_ = 0; r_ < 4; ++r_) rb[r_] = *(const f32x4*)(bp_ + r_ * 256); }
#define LSTOREX(buf) { bf16* A_ = smem + (buf) * M2_STAGE_ELEMS; bf16* B_ = A_ + M2_A_ELEMS; const int o_ = arow * 40 + akc * 8; \
      *(uint4*)(A_ + o_) = ra0; *(uint4*)(A_ + o_ + 64 * 40) = ra1; *(uint4*)(A_ + o_ + 128 * 40) = ra2; *(uint4*)(A_ + o_ + 192 * 40) = ra3; \
      _Pragma("unroll") for (int c_ = 0; c_ < 4; ++c_) { uint2 v_; v_.x = pk2(rb[0][c_], rb[1][c_]); v_.y = pk2(rb[2][c_], rb[3][c_]); const int n_ = n4 * 4 + c_; \
        *(uint2*)(B_ + ((kg >> 1) * 128 + (n_ ^ ((n_ >> 3) & 3))) * 8 + (kg & 1) * 4) = v_; } }
    GLOADX(nt_lo, 0); LSTOREX(0); __syncthreads();
    float* st = (float*)smem;
#pragma unroll 1
    for (int nt = nt_lo; nt < nt_lo + NPER; ++nt) {
      f32x16 acc[4][2];
#pragma unroll
      for (int mi = 0; mi < 4; ++mi)
#pragma unroll
        for (int q = 0; q < 16; ++q) { acc[mi][0][q] = 0.f; acc[mi][1][q] = 0.f; }
#pragma unroll 1
      for (int kt = 0; kt < 32; ++kt) {
        if (kt + 1 < 32) GLOADX(nt, kt + 1)
        const bf16* S = smem + (kt & 1) * M2_STAGE_ELEMS;
        if (wm * 128 < nvalid)
#pragma unroll
        for (int ks = 0; ks < 2; ++ks) {
          const bf16x8 b0 = *(const bf16x8*)(S + boff0 + ks * 2 * 128 * 8), b1 = *(const bf16x8*)(S + boff1 + ks * 2 * 128 * 8);
#pragma unroll
          for (int mi = 0; mi < 4; ++mi) { const bf16x8 a = *(const bf16x8*)(S + aoff + mi * 32 * 40 + ks * 16);
            acc[mi][0] = __builtin_amdgcn_mfma_f32_32x32x16_bf16(a, b0, acc[mi][0], 0, 0, 0);
            acc[mi][1] = __builtin_amdgcn_mfma_f32_32x32x16_bf16(a, b1, acc[mi][1], 0, 0, 0); }
          __builtin_amdgcn_sched_barrier(0);
        }
        if (kt + 1 < 32) LSTOREX((kt + 1) & 1);
        __syncthreads();
      }
#pragma unroll
      for (int mi = 0; mi < 4; ++mi) {
        float* bq = st + (wm * 128 + mi * 32 + 4 * (lane >> 5)) * 68 + wn * 32 + (lane & 31);
#pragma unroll
        for (int q = 0; q < 16; ++q) bq[(8 * (q >> 2) + (q & 3)) * 68] = siluf_(acc[mi][0][q]) * acc[mi][1][q]; }
      if (nt + 1 < nt_lo + NPER) GLOADX(nt + 1, 0)
      __syncthreads();
      bf16* dst = (bf16*)(p.ws + O_ACT) + (size_t)(offs[e] + mt * 256) * 256 + nt * 64;
#pragma unroll 2
      for (int jq = 0; jq < 8; ++jq) { const int u = tid + 256 * jq, row = u >> 3, cg = u & 7;
        if (row < nvalid) NT_ST16(pack8(st + row * 68 + cg * 8), dst + (size_t)row * 256 + cg * 8) }
      __syncthreads();
      if (nt + 1 < nt_lo + NPER) { LSTOREX(0); __syncthreads(); }
    }
#undef GLOADX
#undef LSTOREX
  }
}
DI void ph_moe2(PR p, bf16* smem, int* misc, int* ctrs) {
  int* offs = misc + 16; int* stoffs = misc + 280; int* shv = misc;
  int* lasg = (int*)((unsigned char*)smem + 67584); float* lw = (float*)((unsigned char*)smem + 67584 + 1024);
  moe_offsets((const int*)(p.ws + O_CTL) + CW_CNT, offs, stoffs);
  const int tid = threadIdx.x, lane = tid & 63, wave = tid >> 6, wm = wave >> 1, wn = wave & 1;
  const int arow = tid >> 2, akc = tid & 3, kg = tid >> 5, n4 = tid & 31;
  const int r = lane & 31, hh = lane >> 5;
  const int aoff = (wm * 128 + r) * 40 + hh * 8;
  const int nb0 = wn * 64 + r, nb1 = nb0 + 32;
  const int boff0 = M2_A_ELEMS + (hh * 128 + (nb0 ^ ((nb0 >> 3) & 3))) * 8, boff1 = M2_A_ELEMS + (hh * 128 + (nb1 ^ ((nb1 >> 3) & 3))) * 8;
  const int myx = xcc_id(); int off = 0, x, idx;
  constexpr int NSPL = 4, NPER = 8 / NSPL;
  while (shard_next(ctrs, myx, off, [stoffs](int xx) { return stoffs[xx * 33 + 32] * NSPL + 256; }, shv, x, idx)) {
    const int n_routed = stoffs[x * 33 + 32] * NSPL;
    if (idx >= n_routed) { const int i2 = idx - n_routed, g = i2 >> 6, rem = i2 & 63, nt = rem >> 3, mt = x * 32 + g * 8 + (rem & 7); sh2_tile(p, nt * 256 + mt, smem); continue; }
    const int j = find_le32(stoffs + x * 33, idx / NSPL), e = x + 8 * j;
    const int me = stoffs[x * 33 + j + 1] - stoffs[x * 33 + j], local = idx - stoffs[x * 33 + j] * NSPL, nt_lo = (local / me) * NPER, mt = local % me;
    const int cnt = offs[e + 1] - offs[e], nvalid = min(256, cnt - mt * 256);
    { const int rr = tid < nvalid ? tid : 0; const int asg = ((const int*)(p.ws + O_LIST))[(size_t)e * 32768 + mt * 256 + rr]; lasg[tid] = asg; lw[tid] = ((const float*)(p.ws + O_RW))[asg]; }
    const bf16* abase = (const bf16*)(p.ws + O_ACT) + (size_t)(offs[e] + mt * 256) * 256;
    const unsigned ao0 = (unsigned)(arow * 256 + akc * 8), ao1 = ao0 + 64 * 256, ao2 = ao0 + 128 * 256, ao3 = ao0 + 192 * 256;
    const float* wb = p.w_exp_down + (size_t)e * 262144 + n4 * 4 + (size_t)(kg * 4) * 1024;
    uint4 ra0, ra1, ra2, ra3; f32x4 rb[4];
#define GLOADX(nt, kt) { const bf16* ab_ = abase + (kt) * 32; ra0 = *(const uint4*)(ab_ + ao0); ra1 = *(const uint4*)(ab_ + ao1); ra2 = *(const uint4*)(ab_ + ao2); ra3 = *(const uint4*)(ab_ + ao3); \
      const float* bp_ = wb + (nt) * 128 + (size_t)((kt) * 32) * 1024; _Pragma("unroll") for (int r_ = 0; r_ < 4; ++r_) rb[r_] = *(const f32x4*)(bp_ + r_ * 1024); }
#define LSTOREX(buf) { bf16* A_ = smem + (buf) * M2_STAGE_ELEMS; bf16* B_ = A_ + M2_A_ELEMS; const int o_ = arow * 40 + akc * 8; \
      *(uint4*)(A_ + o_) = ra0; *(uint4*)(A_ + o_ + 64 * 40) = ra1; *(uint4*)(A_ + o_ + 128 * 40) = ra2; *(uint4*)(A_ + o_ + 192 * 40) = ra3; \
      _Pragma("unroll") for (int c_ = 0; c_ < 4; ++c_) { uint2 v_; v_.x = pk2(rb[0][c_], rb[1][c_]); v_.y = pk2(rb[2][c_], rb[3][c_]); const int n_ = n4 * 4 + c_; \
        *(uint2*)(B_ + ((kg >> 1) * 128 + (n_ ^ ((n_ >> 3) & 3))) * 8 + (kg & 1) * 4) = v_; } }
    GLOADX(nt_lo, 0); LSTOREX(0); __syncthreads();
    bf16* YK = (bf16*)(p.ws + O_YK);
    float* st = (float*)smem;
#pragma unroll 1
    for (int nt = nt_lo; nt < nt_lo + NPER; ++nt) {
      f32x16 acc[4][2];
#pragma unroll
      for (int mi = 0; mi < 4; ++mi)
#pragma unroll
        for (int q = 0; q < 16; ++q) { acc[mi][0][q] = 0.f; acc[mi][1][q] = 0.f; }
#pragma unroll 1
      for (int kt = 0; kt < 8; ++kt) {
        if (kt + 1 < 8) GLOADX(nt, kt + 1)
        const bf16* S = smem + (kt & 1) * M2_STAGE_ELEMS;
        if (wm * 128 < nvalid)
#pragma unroll
        for (int ks = 0; ks < 2; ++ks) {
          const bf16x8 b0 = *(const bf16x8*)(S + boff0 + ks * 2 * 128 * 8), b1 = *(const bf16x8*)(S + boff1 + ks * 2 * 128 * 8);
#pragma unroll
          for (int mi = 0; mi < 4; ++mi) { const bf16x8 a = *(const bf16x8*)(S + aoff + mi * 32 * 40 + ks * 16);
            acc[mi][0] = __builtin_amdgcn_mfma_f32_32x32x16_bf16(a, b0, acc[mi][0], 0, 0, 0);
            acc[mi][1] = __builtin_amdgcn_mfma_f32_32x32x16_bf16(a, b1, acc[mi][1], 0, 0, 0); }
          __builtin_amdgcn_sched_barrier(0);
        }
        if (kt + 1 < 8) LSTOREX((kt + 1) & 1);
        __syncthreads();
      }
      const int n0 = nt * 128;
#pragma unroll 1
      for (int h = 0; h < 2; ++h) {
        if (wm == h) {
#pragma unroll
          for (int mi = 0; mi < 4; ++mi)
#pragma unroll
            for (int ni = 0; ni < 2; ++ni) { float* bq = st + (mi * 32 + 4 * (lane >> 5)) * ST_LD + wn * 64 + ni * 32 + (lane & 31);
#pragma unroll
              for (int q = 0; q < 16; ++q) bq[(8 * (q >> 2) + (q & 3)) * ST_LD] = acc[mi][ni][q]; }
        }
        if (h == 1 && nt + 1 < nt_lo + NPER) GLOADX(nt + 1, 0)
        __syncthreads();
#pragma unroll 2
        for (int jq = 0; jq < 8; ++jq) { const int u = tid + 256 * jq, row = u >> 4, cg = u & 15, grow = h * 128 + row;
          if (grow < nvalid) { const float w = lw[grow]; const float* s = st + row * ST_LD + cg * 8; const f32x4 a = *(const f32x4*)s, bq = *(const f32x4*)(s + 4);
            uint4 o; o.x = pk2(w * a[0], w * a[1]); o.y = pk2(w * a[2], w * a[3]); o.z = pk2(w * bq[0], w * bq[1]); o.w = pk2(w * bq[2], w * bq[3]);
            { typedef unsigned u32x4_t __attribute__((ext_vector_type(4))); u32x4_t ov = {o.x, o.y, o.z, o.w}; __builtin_nontemporal_store(ov, (u32x4_t*)(YK + (size_t)lasg[grow] * 1024 + n0 + cg * 8)); } } }
        __syncthreads();
      }
      if (nt + 1 < nt_lo + NPER) { LSTOREX(0); __syncthreads(); }
    }
#undef GLOADX
#undef LSTOREX
  }
}

DI void final_row(PR p, int tok, int lane) {
  const int b = tok >> 11;
  const float* mod = (const float*)(p.ws + O_MOD) + b * 6144;
  const float* X1 = (const float*)(p.ws + O_X1) + (size_t)tok * 1024;
  const bf16* YK = (const bf16*)(p.ws + O_YK) + (size_t)tok * 8 * 1024; const bf16* YS = (const bf16*)(p.ws + O_YSH) + (size_t)tok * 1024;
  float4 v[4]; float s = 0.f;
#pragma unroll
  for (int j = 0; j < 4; ++j) {
    const int col = (lane + 64 * j) * 4;
    typedef unsigned u32x2_t __attribute__((ext_vector_type(2)));
    const u32x2_t ysq = __builtin_nontemporal_load((const u32x2_t*)(YS + col));
    float f0 = __uint_as_float(ysq.x << 16), f1 = __uint_as_float(ysq.x & 0xffff0000u), f2 = __uint_as_float(ysq.y << 16), f3 = __uint_as_float(ysq.y & 0xffff0000u);
#pragma unroll
    for (int k = 0; k < 8; ++k) { typedef unsigned u32x2_t __attribute__((ext_vector_type(2))); const u32x2_t yq = __builtin_nontemporal_load((const u32x2_t*)(YK + (size_t)k * 1024 + col)); f0 += __uint_as_float(yq.x << 16); f1 += __uint_as_float(yq.x & 0xffff0000u); f2 += __uint_as_float(yq.y << 16); f3 += __uint_as_float(yq.y & 0xffff0000u); }
    const f32x4 x1v = __builtin_nontemporal_load((const f32x4*)(X1 + col)); float4 x1; x1.x = x1v[0]; x1.y = x1v[1]; x1.z = x1v[2]; x1.w = x1v[3]; const float4 g2 = *(const float4*)(mod + 5120 + col);
    v[j].x = DN_ALPHA * x1.x + g2.x * f0; v[j].y = DN_ALPHA * x1.y + g2.y * f1; v[j].z = DN_ALPHA * x1.z + g2.z * f2; v[j].w = DN_ALPHA * x1.w + g2.w * f3;
    s += (v[j].x + v[j].y) + (v[j].z + v[j].w);
  }
  const float mean = wave_sum(s) * (1.f / 1024.f); float s2 = 0.f;
#pragma unroll
  for (int j = 0; j < 4; ++j) { v[j].x -= mean; v[j].y -= mean; v[j].z -= mean; v[j].w -= mean; s2 += (v[j].x * v[j].x + v[j].y * v[j].y) + (v[j].z * v[j].z + v[j].w * v[j].w); }
  const float rstd = 1.f / sqrtf(wave_sum(s2) * (1.f / 1024.f) + LN_EPS);
#pragma unroll
  for (int j = 0; j < 4; ++j) {
    const int col = (lane + 64 * j) * 4;
    const float4 g = *(const float4*)(p.ln2_g + col), bb = *(const float4*)(p.ln2_b + col);
    float4 o; o.x = v[j].x * rstd * g.x + bb.x; o.y = v[j].y * rstd * g.y + bb.y; o.z = v[j].z * rstd * g.z + bb.z; o.w = v[j].w * rstd * g.w + bb.w;
    { f32x4 ov = {o.x, o.y, o.z, o.w}; __builtin_nontemporal_store(ov, (f32x4*)(p.out + (size_t)tok * 1024 + col)); }
  }
}

__global__ void __launch_bounds__(256, 2) mega(P p_arg) {
  PR p = *(const __attribute__((address_space(4))) P*)__builtin_amdgcn_kernarg_segment_ptr();
  extern __shared__ __attribute__((aligned(16))) unsigned char lds[];
  cg::grid_group grid = cg::this_grid();
  bf16* smem = (bf16*)lds; int* misc = (int*)(lds + MISC_OFF); int* shv = misc;
  int* qc = (int*)(p.ws + O_CTL) + CW_Q;
#define NREP(k) 1
#define QC(k) (qc + (k) + 32 * rep_)
#define SQ(k) ((int*)(p.ws + O_CTL) + 32768 + (k) * 512 + rep_ * 256)
#define PH_BEGIN(k) if (p.ph_lo <= (k) && (k) < p.ph_hi) { int tx_ = threadIdx.x; asm volatile("" : "+v"(tx_)); const int lane = tx_ & 63, wave = tx_ >> 6, gw = blockIdx.x * 4 + wave, NGW = gridDim.x * 4; (void)lane; (void)gw; (void)NGW; \
  for (int rep_ = 0; rep_ < NREP(k); ++rep_) { if (rep_) { xcd_barrier(gbar, myxcc, xst); }
#define PH_STAMP(k)
#define PH_END(k) } if ((k) + 1 < p.ph_hi) { xcd_barrier(gbar, myxcc, xst); PH_STAMP(k) } }
  unsigned* gbar = (unsigned*)(p.ws + O_CTL) + 65536; const unsigned myxcc = (unsigned)__builtin_amdgcn_s_getreg((3 << 11) | 20) & 0xFu;
  volatile unsigned* xst = (volatile unsigned*)(misc + 1000);
  if (threadIdx.x == 0) { xst[0] = 0u; xst[1] = 0u; }
  if (threadIdx.x == 0) (void)xb_add(&gbar[XB_XCNT(myxcc)], 1u);
  PH_STAMP(-1)
  if (p.ph_lo <= 0 && 0 < p.ph_hi) { { const int rep_ = 0; (void)rep_; ph_prologue(p, lds, QC(0), shv); } if (1 < p.ph_hi) { grid.sync(); PH_STAMP(0) } }
  PH_BEGIN(1) ph_u(p); PH_END(1)
  PH_BEGIN(2) ph_inproj(p, smem, SQ(2), shv); PH_END(2)
  PH_BEGIN(3)
    { const int myx = xcc_id(); int off = 0, x, idx;
      while (shard_next(SQ(3), myx, off, [](int) { return 144; }, shv, x, idx)) { const int it = idx * 8 + x;
        if (it < 128) cmp1_tile(p, it, smem); else { const int j = it - 128; idx_item(p, j & 15, 63 - (j >> 4), lds); } } }
  PH_END(3)
  PH_BEGIN(4)
    for (;;) { const int it = sched_next(QC(4), shv); if (it >= 64) break; cmp2_tile(p, it, smem); }
  PH_END(4)
  PH_BEGIN(5)
    { const int myx = xcc_id(); int off = 0, x, idx;
    while (shard_next(SQ(5), myx, off, [](int) { return 768; }, shv, x, idx)) { const int it = idx * 8 + ((x + idx) & 7);
      if (it < 4096) { const int ty = it & 1, j = it >> 1, qt = 63 - (j >> 5), bg = j & 31;
        if (ty == 0) attn_item<0>(p, bg >> 1, bg & 1, qt, smem); else attn_item<1>(p, bg >> 1, bg & 1, qt, smem); }
      else { const int j = it - 4096, qt = j >> 5, bg = j & 31; cmp_item(p, bg >> 1, bg & 1, qt, lds); } } }
  PH_END(5)
  PH_BEGIN(6) { const int myx = xcc_id(); int off = 0, x, idx; while (shard_next(SQ(6), myx, off, [](int) { return 256; }, shv, x, idx)) { const int it = idx * 8 + x; const int qt = 63 - (it >> 5), bg = it & 31; attn_item<2>(p, bg >> 1, bg & 1, qt, smem); } } PH_END(6)
  PH_BEGIN(7) { const int myx = xcc_id(); int off = 0, x, idx; while (shard_next(SQ(7), myx, off, [](int) { return 256; }, shv, x, idx)) { const int g = idx >> 6, rem = idx & 63; merge_tile(p, (rem >> 3) * 256 + x * 32 + g * 8 + (rem & 7), smem); } } PH_END(7)
  PH_BEGIN(8) { const int myx = xcc_id(); int off = 0, x, idx; while (shard_next(SQ(8), myx, off, [](int) { return 128; }, shv, x, idx)) { const int g = idx >> 6, rem = idx & 63; out_tile(p, (rem >> 3) * 128 + x * 16 + g * 8 + (rem & 7), smem); } } PH_END(8)
  PH_BEGIN(9) for (int w = gw; w < T; w += NGW) ln1_row(p, w, lane); PH_END(9)
  PH_BEGIN(10) { const int myx = xcc_id(); int off = 0, x, idx; while (shard_next(SQ(10), myx, off, [](int) { return 64; }, shv, x, idx)) { const int g = idx >> 4, rem = idx & 15; router_tile(p, (rem >> 3) * 256 + x * 32 + g * 8 + (rem & 7), smem); } } PH_END(10)
  PH_BEGIN(11) for (int w = gw; w < T; w += NGW) route_token(p.ws, (const float*)(p.ws + O_LOGITS) + (size_t)w * 256, p.router_bias, w, lane); PH_END(11)
  PH_BEGIN(12) ph_moe1(p, smem, misc, SQ(12)); PH_END(12)
  PH_BEGIN(13) ph_moe2(p, smem, misc, SQ(13)); PH_END(13)
  PH_BEGIN(14) for (int w = gw; w < T; w += NGW) final_row(p, w, lane); PH_END(14)
}

extern "C" void kernel_launch(void* const* d_in, const int* in_sizes, int n_in, void* d_out, int out_size, void* d_ws, size_t ws_size, hipStream_t stream) {
  if (n_in != 27 || ws_size < WS_NEED2) { fprintf(stderr, "kernel_launch: unexpected n_in %d / ws_size %zu (need %zu)\n", n_in, ws_size, (size_t)WS_NEED2); return; }
  static int grid_blocks = 0;
  if (!grid_blocks) {
    int dev = 0, cus = 0, per_cu = 0;
    (void)hipGetDevice(&dev);
    (void)hipDeviceGetAttribute(&cus, hipDeviceAttributeMultiprocessorCount, dev);
    (void)hipFuncSetAttribute((const void*)mega, hipFuncAttributeMaxDynamicSharedMemorySize, LDS_BYTES);
    (void)hipOccupancyMaxActiveBlocksPerMultiprocessor(&per_cu, mega, 256, LDS_BYTES);
    if (per_cu < 1) per_cu = 1;
    grid_blocks = cus * per_cu;
    fprintf(stderr, "kernel_launch: cus %d per_cu %d grid %d\n", cus, per_cu, grid_blocks);
  }
  P p{};
  p.x = (const float*)d_in[0]; p.c = (const float*)d_in[1]; p.pos = (const int*)d_in[2];
  p.w_ada = (const float*)d_in[3]; p.b_ada = (const float*)d_in[4]; p.w_in = (const float*)d_in[5]; p.w_br_a = (const float*)d_in[6]; p.w_br_b = (const float*)d_in[7];
  p.w_out = (const float*)d_in[8]; p.cmp_pos_k = (const float*)d_in[9]; p.cmp_pos_v = (const float*)d_in[10]; p.cmp_k_w1 = (const float*)d_in[11]; p.cmp_k_w2 = (const float*)d_in[12];
  p.cmp_v_w1 = (const float*)d_in[13]; p.cmp_v_w2 = (const float*)d_in[14]; p.ln1_g = (const float*)d_in[15]; p.ln1_b = (const float*)d_in[16]; p.w_router = (const float*)d_in[17];
  p.router_bias = (const float*)d_in[18]; p.w_exp_gate = (const float*)d_in[19]; p.w_exp_up = (const float*)d_in[20]; p.w_exp_down = (const float*)d_in[21];
  p.w_sh_gate = (const float*)d_in[22]; p.w_sh_up = (const float*)d_in[23]; p.w_sh_down = (const float*)d_in[24]; p.ln2_g = (const float*)d_in[25]; p.ln2_b = (const float*)d_in[26];
  p.out = (float*)d_out; p.ws = (unsigned char*)d_ws;
  p.ph_lo = 0; p.ph_hi = NPHASE;
  (void)hipMemsetAsync((char*)d_ws + O_CTL, 0, 1 * MiB, stream);
  void* args[] = {&p};
  hipError_t e = hipLaunchCooperativeKernel((void*)mega, dim3(grid_blocks), dim3(256), args, LDS_BYTES, stream);
  if (e != hipSuccess) fprintf(stderr, "cooperative launch failed: %s (grid %d)\n", hipGetErrorString(e), grid_blocks);
}
```
